# Optimizing an MI355X kernel written in HIP

```python
import jax, jax.numpy as jnp
from jax import lax
import numpy as np

D_MODEL = 1024
BATCH = 8
SEQ = 2048
DEPTH = 1
DEC_BATCH = 8
DEC_SEQ = 4096
PAST_LEN = 128

ATTN_GROUPS = ((128, 1), (512, 4), (2048, 16))
N_GROUPS = 3
ATTN_HEADS_PER_GROUP = 8
ATTN_HEAD_DIM = 64
ATTN_HEADS = N_GROUPS * ATTN_HEADS_PER_GROUP
ATTN_WIDTH = ATTN_HEADS * ATTN_HEAD_DIM
ATTN_OUT = ATTN_HEADS_PER_GROUP * ATTN_HEAD_DIM
ROPE_THETA = 10000.0
NEG = -1e30
DN_HEADS = 8
DN_HEAD_DIM = 128
DN_WIDTH = DN_HEADS * DN_HEAD_DIM
DN_CONV = 3
CHUNK = 64
D_FF = 2816
FFN_CONV = 3
EPS = 1e-6
SPLIT_SIZES = (ATTN_WIDTH, ATTN_WIDTH, ATTN_WIDTH, DN_WIDTH, DN_WIDTH, DN_WIDTH, DN_WIDTH,
               2 * DN_HEADS, 2 * DN_HEADS, D_MODEL, D_MODEL)
IN_COLS = 3 * ATTN_WIDTH + 4 * DN_WIDTH + 4 * DN_HEADS + 2 * D_MODEL
SPLIT_IDX = (ATTN_WIDTH, 2 * ATTN_WIDTH, 3 * ATTN_WIDTH,
             3 * ATTN_WIDTH + DN_WIDTH, 3 * ATTN_WIDTH + 2 * DN_WIDTH, 3 * ATTN_WIDTH + 3 * DN_WIDTH,
             3 * ATTN_WIDTH + 4 * DN_WIDTH, 3 * ATTN_WIDTH + 4 * DN_WIDTH + 2 * DN_HEADS,
             3 * ATTN_WIDTH + 4 * DN_WIDTH + 4 * DN_HEADS,
             3 * ATTN_WIDTH + 4 * DN_WIDTH + 4 * DN_HEADS + D_MODEL)

kernel_name = "hybrid_dilated_attn_gated_deltanet_encoder"

F32 = jnp.float32


def rmsnorm(x, g):
    xf = x.astype(F32)
    y = xf * lax.rsqrt(jnp.mean(xf * xf, axis=-1, keepdims=True) + EPS)
    return (y * g.astype(F32)).astype(x.dtype)


def l2norm(t):
    return t * lax.rsqrt(jnp.sum(t * t, axis=-1, keepdims=True) + EPS)


def rope(t, S):
    dh = t.shape[-1]
    half = dh // 2
    inv = ROPE_THETA ** (-jnp.arange(half, dtype=F32) / half)
    ang = jnp.arange(S, dtype=F32)[:, None] * inv[None, :]
    cos = jnp.cos(ang)[None, :, None, :]
    sin = jnp.sin(ang)[None, :, None, :]
    t1 = t[..., :half].astype(F32)
    t2 = t[..., half:].astype(F32)
    return jnp.concatenate([t1 * cos - t2 * sin, t2 * cos + t1 * sin], axis=-1).astype(t.dtype)


def dwconv_centered(x, w):
    K = w.shape[0]
    p = K // 2
    S = x.shape[1]
    xp = jnp.pad(x, ((0, 0), (p, p), (0, 0)))
    y = xp[:, 0:S] * w[0]
    for j in range(1, K):
        y = y + xp[:, j:j + S] * w[j]
    return y


def banded_window_attention(q, k, v, half):
    Bz, L, H, dh = q.shape
    nb = -(-L // half)
    pad = nb * half - L
    qb = jnp.pad(q, ((0, 0), (0, pad), (0, 0), (0, 0))).reshape(Bz, nb, half, H, dh)

    def windows(t):
        tp = jnp.pad(t, ((0, 0), (half, pad + half), (0, 0), (0, 0))).reshape(Bz, nb + 2, half, H, dh)
        return jnp.concatenate([tp[:, :-2], tp[:, 1:-1], tp[:, 2:]], axis=2)

    kw, vw = windows(k), windows(v)
    s = jnp.einsum('bnqhd,bnkhd->bnhqk', qb, kw).astype(F32) * (dh ** -0.5)
    blk = jnp.arange(nb)[:, None, None] * half
    qpos = blk + jnp.arange(half)[None, :, None]
    kpos = blk - half + jnp.arange(3 * half)[None, None, :]
    valid = (jnp.abs(qpos - kpos) <= half) & (kpos >= 0) & (kpos < L)
    s = jnp.where(valid[None, :, None], s, NEG)
    m = jnp.max(s, axis=-1, keepdims=True)
    p = jnp.exp(s - m)
    den = jnp.sum(p, axis=-1)
    o = jnp.einsum('bnhqk,bnkhd->bnqhd', p, vw.astype(F32)) / jnp.swapaxes(den, 2, 3)[..., None]
    lse = jnp.swapaxes(m[..., 0] + jnp.log(den), 2, 3)
    o = o.reshape(Bz, nb * half, H, dh)[:, :L]
    lse = lse.reshape(Bz, nb * half, H)[:, :L]
    return o, lse


def dilated_window_attention(q, k, v, window, dilation):
    B, S, H, dh = q.shape
    L = S // dilation

    def to_res(t):
        return t.reshape(B, L, dilation, H, dh).transpose(0, 2, 1, 3, 4).reshape(B * dilation, L, H, dh)

    o, lse = banded_window_attention(to_res(q), to_res(k), to_res(v), window // (2 * dilation))
    o = o.reshape(B, dilation, L, H, dh).transpose(0, 2, 1, 3, 4).reshape(B, S, H, dh)
    lse = lse.reshape(B, dilation, L, H).transpose(0, 2, 1, 3).reshape(B, S, H)
    return o, lse


def gated_delta_chunked(q, k, v, g, beta):
    q, k, v, g, beta = (t.astype(F32) for t in (q, k, v, g, beta))
    Z, S, H, dk = q.shape
    dv = v.shape[-1]
    C = CHUNK
    N = S // C
    q = q.reshape(Z, N, C, H, dk)
    k = k.reshape(Z, N, C, H, dk)
    v = v.reshape(Z, N, C, H, dv)
    beta = beta.reshape(Z, N, C, H)
    G = jnp.cumsum(g.reshape(Z, N, C, H), axis=2)
    Gh = jnp.swapaxes(G, 2, 3)
    tril = jnp.tril(jnp.ones((C, C), dtype=bool))
    strict = jnp.tril(jnp.ones((C, C), dtype=bool), k=-1)
    decay = jnp.exp(jnp.where(tril, Gh[..., :, None] - Gh[..., None, :], -jnp.inf))
    kb = k * beta[..., None]
    A = jnp.where(strict, jnp.einsum('znchk,zndhk->znhcd', kb, k) * decay, 0.0)
    eye = jnp.eye(C, dtype=F32)
    T = lax.linalg.triangular_solve(A + eye, jnp.broadcast_to(eye, A.shape), left_side=True, lower=True)
    U = jnp.einsum('znhcd,zndhv->znchv', T, v * beta[..., None])
    W = jnp.einsum('znhcd,zndhk->znchk', T, kb * jnp.exp(G)[..., None])
    qG = q * jnp.exp(G)[..., None]
    P = jnp.einsum('znchk,zndhk->znhcd', q, k) * decay
    kD = k * jnp.exp(G[:, :, -1:] - G)[..., None]
    gl = jnp.exp(G[:, :, -1])
    xs = tuple(jnp.moveaxis(t, 1, 0) for t in (qG, P, U, W, kD, gl))

    def step(state, xs_n):
        qG_n, P_n, U_n, W_n, kD_n, gl_n = xs_n
        v_new = U_n - jnp.einsum('zchk,zhkv->zchv', W_n, state)
        o = jnp.einsum('zchk,zhkv->zchv', qG_n, state) + jnp.einsum('zhcd,zdhv->zchv', P_n, v_new)
        state = state * gl_n[..., None, None] + jnp.einsum('zchk,zchv->zhkv', kD_n, v_new)
        return state, o

    _, o = lax.scan(step, jnp.zeros((Z, H, dk, dv), F32), xs)
    return jnp.moveaxis(o, 0, 1).reshape(Z, S, H, dv)


def token_mixer(h, w_in, conv_qkv_w, a_log, dt_bias, dn_norm_g, w_br_attn, w_br_dn, w_out):
    B, S, _ = h.shape
    proj = h @ w_in
    qa, ka, va, qd, kd, vd, zd, ad, bd, ga, gd = jnp.split(proj, SPLIT_IDX, axis=-1)

    qa = rope(qa.reshape(B, S, ATTN_HEADS, ATTN_HEAD_DIM), S)
    ka = rope(ka.reshape(B, S, ATTN_HEADS, ATTN_HEAD_DIM), S)
    va = va.reshape(B, S, ATTN_HEADS, ATTN_HEAD_DIM)
    outs, lses = [], []
    for gi, (window, dil) in enumerate(ATTN_GROUPS):
        sl = slice(gi * ATTN_HEADS_PER_GROUP, (gi + 1) * ATTN_HEADS_PER_GROUP)
        o, lse = dilated_window_attention(qa[:, :, sl], ka[:, :, sl], va[:, :, sl], window, dil)
        outs.append(o)
        lses.append(lse)
    wts = jax.nn.softmax(jnp.stack(lses, axis=0), axis=0)
    ya = jnp.einsum('gbsh,gbshd->bshd', wts, jnp.stack(outs, axis=0))
    ya = ya.reshape(B, S, ATTN_OUT).astype(h.dtype)

    qkv = jax.nn.silu(dwconv_centered(jnp.concatenate([qd, kd, vd], axis=-1), conv_qkv_w))
    qd, kd, vd = jnp.split(qkv, 3, axis=-1)
    qd = l2norm(qd.reshape(B, S, DN_HEADS, DN_HEAD_DIM).astype(F32)) * (DN_HEAD_DIM ** -0.5)
    kd = l2norm(kd.reshape(B, S, DN_HEADS, DN_HEAD_DIM).astype(F32))
    vd = vd.reshape(B, S, DN_HEADS, DN_HEAD_DIM).astype(F32)
    g = -jnp.exp(a_log.astype(F32)) * jax.nn.softplus(
        ad.reshape(B, S, 2, DN_HEADS).astype(F32) + dt_bias.astype(F32))
    beta = jax.nn.sigmoid(bd.reshape(B, S, 2, DN_HEADS).astype(F32))
    rev = lambda t: jnp.flip(t, axis=1)
    q2 = jnp.concatenate([qd, rev(qd)], axis=0)
    k2 = jnp.concatenate([kd, rev(kd)], axis=0)
    v2 = jnp.concatenate([vd, rev(vd)], axis=0)
    g2 = jnp.concatenate([g[:, :, 0], rev(g[:, :, 1])], axis=0)
    b2 = jnp.concatenate([beta[:, :, 0], rev(beta[:, :, 1])], axis=0)
    o2 = gated_delta_chunked(q2, k2, v2, g2, b2)
    od = o2[:B] + rev(o2[B:])
    z = zd.reshape(B, S, DN_HEADS, DN_HEAD_DIM).astype(F32)
    od = od * lax.rsqrt(jnp.mean(od * od, axis=-1, keepdims=True) + EPS) * dn_norm_g.astype(F32) * jax.nn.silu(z)
    yd = od.reshape(B, S, DN_WIDTH).astype(h.dtype)

    merged = jax.nn.sigmoid(ga) * (ya @ w_br_attn) + jax.nn.sigmoid(gd) * (yd @ w_br_dn)
    return merged @ w_out


def conv_ffn(h, w_up, ffn_conv_w, ffn_conv_b, w_down):
    up = dwconv_centered(h @ w_up, ffn_conv_w) + ffn_conv_b
    val, gate = jnp.split(up, 2, axis=-1)
    return (jax.nn.silu(gate) * val) @ w_down


def block(x, c, w_ada, b_ada, norm1_g, w_in, conv_qkv_w, a_log, dt_bias, dn_norm_g,
          w_br_attn, w_br_dn, w_out, norm2_g, w_up, ffn_conv_w, ffn_conv_b, w_down):
    mod = jax.nn.silu(c) @ w_ada + b_ada
    sh1, sc1, gt1, sh2, sc2, gt2 = (m[:, None, :] for m in jnp.split(mod, 6, axis=-1))
    h = rmsnorm(x, norm1_g) * (1 + sc1) + sh1
    x = x + gt1 * token_mixer(h, w_in, conv_qkv_w, a_log, dt_bias, dn_norm_g, w_br_attn, w_br_dn, w_out)
    h = rmsnorm(x, norm2_g) * (1 + sc2) + sh2
    x = x + gt2 * conv_ffn(h, w_up, ffn_conv_w, ffn_conv_b, w_down)
    return x


def trunk(x, c, w_ada, b_ada, norm1_g, w_in, conv_qkv_w, a_log, dt_bias, dn_norm_g,
          w_br_attn, w_br_dn, w_out, norm2_g, w_up, ffn_conv_w, ffn_conv_b, w_down, norm_f_g):
    for l in range(DEPTH):
        x = block(x, c, w_ada[l], b_ada[l], norm1_g[l], w_in[l], conv_qkv_w[l], a_log[l], dt_bias[l],
                  dn_norm_g[l], w_br_attn[l], w_br_dn[l], w_out[l], norm2_g[l], w_up[l],
                  ffn_conv_w[l], ffn_conv_b[l], w_down[l])
    return rmsnorm(x, norm_f_g)


def setup_inputs(seed: int = 0) -> dict:
    key = jax.random.key(seed)
    ks = jax.random.split(key, 24)
    nrm = lambda k, shape, scale: jax.random.normal(k, shape, F32) * scale
    D = D_MODEL
    dt = jax.random.uniform(ks[10], (DEPTH, 2, DN_HEADS), F32, minval=0.001, maxval=0.1)
    return {
        "x_prompt": nrm(ks[0], (BATCH, SEQ, D), 1.0),
        "x_sample": nrm(ks[1], (DEC_BATCH, DEC_SEQ, D), 1.0),
        "c_prompt": nrm(ks[2], (BATCH, D), 1.0),
        "c_sample": nrm(ks[3], (DEC_BATCH, D), 1.0),
        "w_ada": nrm(ks[4], (DEPTH, D, 6 * D), D ** -0.5),
        "b_ada": nrm(ks[5], (DEPTH, 6 * D), 0.01),
        "norm1_g": 1.0 + nrm(ks[6], (DEPTH, D), 0.01),
        "w_in": nrm(ks[7], (DEPTH, D, IN_COLS), D ** -0.5),
        "conv_qkv_w": nrm(ks[8], (DEPTH, DN_CONV, 3 * DN_WIDTH), DN_CONV ** -0.5),
        "a_log": jnp.log(jax.random.uniform(ks[9], (DEPTH, 2, DN_HEADS), F32, minval=1.0, maxval=16.0)),
        "dt_bias": jnp.log(jnp.expm1(dt)),
        "dn_norm_g": 1.0 + nrm(ks[11], (DEPTH, DN_HEAD_DIM), 0.01),
        "w_br_attn": nrm(ks[12], (DEPTH, ATTN_OUT, D), ATTN_OUT ** -0.5),
        "w_br_dn": nrm(ks[13], (DEPTH, DN_WIDTH, D), DN_WIDTH ** -0.5),
        "w_out": nrm(ks[14], (DEPTH, D, D), D ** -0.5),
        "norm2_g": 1.0 + nrm(ks[15], (DEPTH, D), 0.01),
        "w_up": nrm(ks[16], (DEPTH, D, 2 * D_FF), D ** -0.5),
        "ffn_conv_w": nrm(ks[17], (DEPTH, FFN_CONV, 2 * D_FF), FFN_CONV ** -0.5),
        "ffn_conv_b": nrm(ks[18], (DEPTH, 2 * D_FF), 0.01),
        "w_down": nrm(ks[19], (DEPTH, D_FF, D), D_FF ** -0.5),
        "norm_f_g": 1.0 + nrm(ks[20], (D,), 0.01),
    }


def reference(x_prompt, x_sample, c_prompt, c_sample, w_ada, b_ada, norm1_g, w_in, conv_qkv_w,
              a_log, dt_bias, dn_norm_g, w_br_attn, w_br_dn, w_out, norm2_g, w_up, ffn_conv_w,
              ffn_conv_b, w_down, norm_f_g):
    y_prompt = trunk(x_prompt, c_prompt, w_ada, b_ada, norm1_g, w_in, conv_qkv_w, a_log, dt_bias,
                     dn_norm_g, w_br_attn, w_br_dn, w_out, norm2_g, w_up, ffn_conv_w, ffn_conv_b,
                     w_down, norm_f_g)
    y_sample = trunk(x_sample, c_sample, w_ada, b_ada, norm1_g, w_in, conv_qkv_w, a_log, dt_bias,
                     dn_norm_g, w_br_attn, w_br_dn, w_out, norm2_g, w_up, ffn_conv_w, ffn_conv_b,
                     w_down, norm_f_g)
    return (y_prompt, y_sample)
```

```cpp
#include <hip/hip_runtime.h>
#include <hip/hip_cooperative_groups.h>
#include <cstdio>
namespace cg = cooperative_groups;
namespace pg8 {
#define PG8_LAS __attribute__((address_space(3)))
typedef unsigned short bf16_t;
typedef short bf16x8 __attribute__((ext_vector_type(8)));
typedef float f32x4 __attribute__((ext_vector_type(4)));
typedef unsigned u32x4 __attribute__((ext_vector_type(4)));
constexpr int BM = 256, BK = 64, HALF = 128, HTB = HALF * BK * 2  , STAGE_BYTES = 8 * HTB, NXCD = 8, WGM = 8;

__host__ __device__ __forceinline__ int lds_byte(int r, int c) { const int st = (r >> 4) * 2 + (c >> 5), rr = r & 15, cc = c & 31, ob = rr * 64 + cc * 2; return st * 1024 + (ob ^ (((ob >> 9) & 1) << 5)); }
__host__ __device__ __forceinline__ void stage_rc(int b, int& R, int& C) { const int st = b / 1024, sb = b % 1024, swz = sb ^ (((sb >> 9) & 1) << 5); R = (st >> 1) * 16 + swz / 64; C = (st & 1) * 32 + (swz % 64) / 2; }
__host__ __device__ __forceinline__ int perm32(int rho) { const int n = rho >> 4, i = rho & 15; return 8 * (i >> 2) + 4 * n + (i & 3); }

struct Unit { int pm, pn; };
struct Gemm { const bf16_t* A; const bf16_t* Bt; int M, N, K; };

struct StaticOrder {
    int nM, nN, nwg, G, c;
    __host__ __device__ void init(int M, int N, int G_, int c_) { nM = M / BM; nN = N / BM; nwg = nM * nN; G = G_; c = c_; }
    __host__ __device__ bool next(int i, Unit& u) const {
        const long L = (long)i * G + c; if (L >= nwg) return false;
        int wgid = (int)L; { const int q = nwg / NXCD, r = nwg % NXCD, xcd = wgid % NXCD, off = wgid / NXCD; wgid = (xcd < r ? xcd * (q + 1) : r * (q + 1) + (xcd - r) * q) + off; }
        const int nig = WGM * nN, gid = wgid / nig, fm = gid * WGM, gsz = (nM - fm) < WGM ? (nM - fm) : WGM;
        u.pm = fm + ((wgid % nig) % gsz); u.pn = (wgid % nig) / gsz; return true;
    }
    __device__ __forceinline__ void a_ready(const Unit&) const {}
    __device__ __forceinline__ void done(const Unit&) const {}
};
__device__ __forceinline__ unsigned cvt_pk_bf16(float lo, float hi) { unsigned r; asm volatile("v_cvt_pk_bf16_f32 %0, %1, %2" : "=v"(r) : "v"(lo), "v"(hi)); return r; }
typedef float f32x2 __attribute__((ext_vector_type(2)));
template <class Epi, class Sched>
__device__ __forceinline__ void gemm_phase(PG8_LAS unsigned char* lds, const Gemm g, const Sched& S, const Epi& E) {
    int tid_ = threadIdx.x; asm volatile("" : "+v"(tid_)); const int tid = tid_, wid = __builtin_amdgcn_readfirstlane(tid >> 6), lane = tid & 63, wr = wid >> 2, wc = wid & 3, fr = lane & 15, fq = lane >> 4;
    const int K = g.K, nt = K / BK;
    unsigned voffA[2], voffB[2];
#pragma unroll
    for (int i = 0; i < 2; ++i) { int R, C; stage_rc(tid * 16 + i * 8192, R, C); const int Rb = Epi::PERM ? ((R & ~31) + perm32(R & 31)) : R;
        voffA[i] = (unsigned)(R * K + C) * 2u; voffB[i] = (unsigned)(Rb * K + C) * 2u; }
    const size_t kstep = (size_t)(BK * 2);
    const size_t hstep = (size_t)HALF * K * 2;
    const size_t tstep = 2 * hstep;
    const unsigned ldsw = (unsigned)wid * 1024u;
    const int aoff = lds_byte(wr * 64 + fr, fq * 8), boff = lds_byte(wc * 32 + fr, fq * 8);
#define PG8_SA(b, h) (((b) * 2 + (h)) * HTB)
#define PG8_SB(b, h) ((4 + (b) * 2 + (h)) * HTB)
#define PG8_STAGE(bufoff, gbase, voff) do { _Pragma("unroll") for (int _i = 0; _i < 2; ++_i) \
        __builtin_amdgcn_global_load_lds((const unsigned*)((const char*)(gbase) + (voff)[_i]), (PG8_LAS unsigned*)(lds + (bufoff) + ldsw + _i * 8192), 16, 0, 0); } while (0)
#define PG8_LDA(dst, b, h) do { _Pragma("unroll") for (int m = 0; m < 4; ++m) _Pragma("unroll") for (int k = 0; k < 2; ++k) dst[m][k] = *(const PG8_LAS bf16x8*)(lds + PG8_SA(b, h) + aoff + m * 2048 + k * 1024); } while (0)
#define PG8_LDB(dst, b, h) do { _Pragma("unroll") for (int n = 0; n < 2; ++n) _Pragma("unroll") for (int k = 0; k < 2; ++k) dst[n][k] = *(const PG8_LAS bf16x8*)(lds + PG8_SB(b, h) + boff + n * 2048 + k * 1024); } while (0)
#define PG8_MMA(ai, bj, At, Bt) do { __builtin_amdgcn_s_setprio(1); _Pragma("unroll") for (int m = 0; m < 4; ++m) _Pragma("unroll") for (int n = 0; n < 2; ++n) _Pragma("unroll") for (int k = 0; k < 2; ++k) \
        acc[ai][bj][m][n] = __builtin_amdgcn_mfma_f32_16x16x32_bf16(Bt[n][k], At[m][k], acc[ai][bj][m][n], 0, 0, 0); __builtin_amdgcn_s_setprio(0); } while (0)
#define PG8_WAIT_V(n) asm volatile("s_waitcnt vmcnt(" #n ")" ::: "memory")
#define PG8_WAIT_L(n) asm volatile("s_waitcnt lgkmcnt(" #n ")" ::: "memory")
#define PG8_BAR __builtin_amdgcn_s_barrier()
#define PG8_SCHED __builtin_amdgcn_sched_barrier(0)
    Unit cur, nxt; int ui = 0;
    if (!S.next(0, cur)) return;
    f32x4 acc[2][2][4][2];
#pragma unroll
    for (int a = 0; a < 2; ++a)
#pragma unroll
        for (int b = 0; b < 2; ++b)
#pragma unroll
            for (int m = 0; m < 4; ++m)
#pragma unroll
                for (int n = 0; n < 2; ++n) acc[a][b][m][n] = (f32x4){0.f, 0.f, 0.f, 0.f};
    bf16x8 At[4][2], B0[2][2], B1[2][2];
    const char* cA = (const char*)g.A + (size_t)cur.pm * tstep; const char* cB = (const char*)g.Bt + (size_t)cur.pn * tstep;
    S.a_ready(cur);
    PG8_STAGE(PG8_SB(0, 0), cB, voffB); PG8_STAGE(PG8_SA(0, 0), cA, voffA); PG8_STAGE(PG8_SB(0, 1), cB + hstep, voffB); PG8_STAGE(PG8_SA(0, 1), cA + hstep, voffA);
    if (wr == 1) PG8_BAR;
    PG8_WAIT_V(4); PG8_BAR;
    PG8_STAGE(PG8_SB(1, 0), cB + kstep, voffB); PG8_STAGE(PG8_SA(1, 0), cA + kstep, voffA); PG8_STAGE(PG8_SB(1, 1), cB + hstep + kstep, voffB);
    PG8_WAIT_V(6); PG8_BAR;
    for (;;) {
        const bool has_next = S.next(ui + 1, nxt);
        const char* nA = has_next ? (const char*)g.A + (size_t)nxt.pm * tstep : cA; const char* nB = has_next ? (const char*)g.Bt + (size_t)nxt.pn * tstep : cB;
        for (int t = 0; t < nt; t += 2) {
            const bool last = (t == nt - 2);
            const char* a1 = cA + (size_t)(t + 1) * kstep;
            const char* a2 = last ? nA : cA + (size_t)(t + 2) * kstep; const char* b2 = last ? nB : cB + (size_t)(t + 2) * kstep;
            const char* a3 = a2 + kstep; const char* b3 = b2 + kstep;
            if (last && has_next) S.a_ready(nxt);
            PG8_LDB(B0, 0, 0); PG8_SCHED; PG8_LDA(At, 0, 0); PG8_STAGE(PG8_SA(1, 1), a1 + hstep, voffA);
            PG8_WAIT_L(8); PG8_BAR; PG8_WAIT_L(0); PG8_MMA(0, 0, At, B0); PG8_BAR; PG8_SCHED;
            PG8_LDB(B1, 0, 1); PG8_STAGE(PG8_SB(0, 0), b2, voffB);
            PG8_BAR; PG8_WAIT_L(0); PG8_MMA(0, 1, At, B1); PG8_BAR;
            PG8_LDA(At, 0, 1); PG8_STAGE(PG8_SA(0, 0), a2, voffA);
            PG8_BAR; PG8_WAIT_L(0); PG8_MMA(1, 0, At, B0); PG8_BAR; PG8_SCHED;
            PG8_STAGE(PG8_SB(0, 1), b2 + hstep, voffB);
            PG8_WAIT_V(6); PG8_BAR; PG8_MMA(1, 1, At, B1); PG8_BAR;
            PG8_LDB(B0, 1, 0); PG8_SCHED; PG8_LDA(At, 1, 0); PG8_STAGE(PG8_SA(0, 1), a2 + hstep, voffA);
            PG8_WAIT_L(8); PG8_BAR; PG8_WAIT_L(0); PG8_MMA(0, 0, At, B0); PG8_BAR; PG8_SCHED;
            PG8_LDB(B1, 1, 1); PG8_STAGE(PG8_SB(1, 0), b3, voffB);
            PG8_BAR; PG8_WAIT_L(0); PG8_MMA(0, 1, At, B1); PG8_BAR;
            PG8_LDA(At, 1, 1); PG8_STAGE(PG8_SA(1, 0), a3, voffA);
            PG8_BAR; PG8_WAIT_L(0); PG8_MMA(1, 0, At, B0); PG8_BAR; PG8_SCHED;
            PG8_STAGE(PG8_SB(1, 1), b3 + hstep, voffB);
            PG8_WAIT_V(6); PG8_BAR; PG8_MMA(1, 1, At, B1); PG8_BAR;
        }
        if constexpr (!Epi::AFTER_DRAIN) { E(acc, cur, wr, wc, fr, fq); S.done(cur); }
        if (!has_next) break;
#pragma unroll
        for (int a = 0; a < 2; ++a)
#pragma unroll
            for (int b = 0; b < 2; ++b)
#pragma unroll
                for (int m = 0; m < 4; ++m)
#pragma unroll
                    for (int n = 0; n < 2; ++n) acc[a][b][m][n] = (f32x4){0.f, 0.f, 0.f, 0.f};
        cur = nxt; cA = nA; cB = nB; ++ui;
    }
    PG8_WAIT_V(0);
    if (wr == 0) PG8_BAR;
    PG8_BAR;
    if constexpr (Epi::AFTER_DRAIN) { E.fused(acc, cur, wr, wc, fr, fq, lds, wid, lane); S.done(cur); }
#undef PG8_SA
#undef PG8_SB
#undef PG8_STAGE
#undef PG8_LDA
#undef PG8_LDB
#undef PG8_MMA
#undef PG8_WAIT_V
#undef PG8_WAIT_L
#undef PG8_BAR
#undef PG8_SCHED
}
}

#define LAS __attribute__((address_space(3)))
using pg8::bf16_t; using pg8::bf16x8; using pg8::f32x4; using pg8::u32x4;
typedef unsigned u32x2 __attribute__((ext_vector_type(2)));
typedef float f32x2 __attribute__((ext_vector_type(2)));
typedef short bf16x4 __attribute__((ext_vector_type(4)));

constexpr int DM = 1024, TB = 16384, NPROJ = 11008, DFF = 2816, NUP = 5632;
constexpr int C_QA = 0, C_KA = 1536, C_VA = 3072, C_QD = 4608, C_KD = 5632, C_VD = 6656, C_ZD = 7680, C_GA = 8704, C_GD = 9728, C_AB = 10752;
constexpr float EPSF = 1e-6f;
constexpr int LDS_BYTES = 143360;

constexpr size_t al256(size_t x) { return (x + 255) & ~(size_t)255; }
constexpr size_t WS_CTL = 0;
constexpr size_t WS_MOD = 4096;
constexpr size_t WS_ROPE = WS_MOD + al256((size_t)16 * 6144 * 4);
constexpr size_t WS_WIN = WS_ROPE + (size_t)4096 * 32 * 8;
constexpr size_t WS_WA = WS_WIN + (size_t)NPROJ * 1024 * 2;
constexpr size_t WS_WD = WS_WA + (size_t)1024 * 512 * 2;
constexpr size_t WS_WO = WS_WD + (size_t)1024 * 1024 * 2;
constexpr size_t WS_WUP = WS_WO + (size_t)1024 * 1024 * 2;
constexpr size_t WS_WDN = WS_WUP + (size_t)NUP * 1024 * 2;
constexpr size_t WS_XN = WS_WDN + (size_t)1024 * DFF * 2;
constexpr size_t WS_PROJ = WS_XN + (size_t)TB * 1024 * 2;
constexpr size_t WS_QKVD = WS_PROJ + (size_t)TB * NPROJ * 2;
constexpr size_t WS_TP = WS_QKVD + (size_t)TB * 3072 * 2;
constexpr size_t WS_EG = WS_TP + (size_t)4096 * 16384;
constexpr size_t WS_OD = WS_EG + (size_t)4096 * 512;
constexpr size_t WS_LSE = WS_OD + (size_t)2 * TB * 1024 * 2;
constexpr size_t WS_YA = WS_LSE + (size_t)TB * 24 * 4;
constexpr size_t WS_END = WS_YA + (size_t)TB * 512 * 2;

struct Params {
    const float* x_prompt; const float* x_sample; const float* c_prompt; const float* c_sample;
    const float* w_ada; const float* b_ada; const float* norm1_g; const float* w_in; const float* conv_qkv_w;
    const float* a_log; const float* dt_bias; const float* dn_norm_g; const float* w_br_attn; const float* w_br_dn;
    const float* w_out; const float* norm2_g; const float* w_up; const float* ffn_conv_w; const float* ffn_conv_b;
    const float* w_down; const float* norm_f_g;
    float* out; unsigned char* ws;
    int ph_lo, ph_hi;
};

__constant__ double INVF[32] = {1.0, 0.7498942093324559, 0.5623413251903491, 0.4216965034285822, 0.31622776601683794, 0.23713737056616552, 0.1778279410038923, 0.1333521432163324, 0.1, 0.07498942093324558, 0.05623413251903491, 0.042169650342858224, 0.03162277660168379, 0.023713737056616554, 0.01778279410038923, 0.01333521432163324, 0.01, 0.007498942093324558, 0.005623413251903491, 0.004216965034285823, 0.0031622776601683794, 0.0023713737056616554, 0.0017782794100389228, 0.001333521432163324, 0.001, 0.0007498942093324559, 0.0005623413251903491, 0.00042169650342858224, 0.00031622776601683794, 0.00023713737056616554, 0.00017782794100389227, 0.0001333521432163324};

__device__ __forceinline__ float bf2f(unsigned short b) { return __uint_as_float(((unsigned)b) << 16); }
__device__ __forceinline__ float bflo(unsigned w) { return __uint_as_float(w << 16); }
__device__ __forceinline__ float bfhi(unsigned w) { return __uint_as_float(w & 0xffff0000u); }
__device__ __forceinline__ unsigned pk2(float lo, float hi) { unsigned r; asm("v_cvt_pk_bf16_f32 %0, %1, %2" : "=v"(r) : "v"(lo), "v"(hi)); return r; }
__device__ __forceinline__ unsigned short f2bf(float f) { return (unsigned short)(pk2(f, 0.f) & 0xffffu); }
__device__ __forceinline__ float sigmoidf_(float x) { return 1.0f / (1.0f + __expf(-x)); }
__device__ __forceinline__ float siluf_(float x) { return x / (1.0f + __expf(-x)); }
__device__ __forceinline__ float wave_sum(float v) {
#pragma unroll
    for (int o = 32; o >= 1; o >>= 1) v += __shfl_xor(v, o);
    return v;
}
__device__ __forceinline__ int ltid() { int t = threadIdx.x; asm volatile("" : "+v"(t)); return t; }
struct Batch { int b, L, lgL, nseq; const float* x; float* out; };
__device__ __forceinline__ Batch make_batch(const Params& p, int b) {
    Batch B; B.b = b; B.L = b == 0 ? 2048 : 4096; B.lgL = b == 0 ? 11 : 12; B.nseq = TB >> B.lgL;
    B.x = b == 0 ? p.x_prompt : p.x_sample + (size_t)(b - 1) * TB * DM; B.out = p.out + (size_t)b * TB * DM; return B;
}
__device__ __forceinline__ int cond_index(const Batch& B, int row) { const int s = row >> B.lgL; return B.b == 0 ? s : 8 + (B.b - 1) * 4 + s; }

__device__ __forceinline__ void transpose_tile(const float* __restrict__ src, int Nsrc, bf16_t* __restrict__ dst, int K, int kt, int nt, int mode, LAS float* T) {
    const int tid = ltid();
    const int c4 = (tid & 15) * 4, r0 = tid >> 4;
    const int j = nt * 64 + c4; int sj = j;
    if (mode == 1) sj = (j < 8704) ? j : (j < 10752) ? j + 32 : (j < 10784) ? j - 2048 : -1;
#pragma unroll
    for (int i = 0; i < 2; ++i) {
        const int r = r0 + 32 * i;
        f32x4 v = {0.f, 0.f, 0.f, 0.f};
        if (sj >= 0) v = *(const f32x4*)(src + (size_t)(kt * 64 + r) * Nsrc + sj);
        T[r * 65 + c4 + 0] = v[0]; T[r * 65 + c4 + 1] = v[1]; T[r * 65 + c4 + 2] = v[2]; T[r * 65 + c4 + 3] = v[3];
    }
    __syncthreads();
    const int n = tid >> 3, kp = (tid & 7) * 8;
    u32x4 w;
    w.x = pk2(T[(kp + 0) * 65 + n], T[(kp + 1) * 65 + n]); w.y = pk2(T[(kp + 2) * 65 + n], T[(kp + 3) * 65 + n]);
    w.z = pk2(T[(kp + 4) * 65 + n], T[(kp + 5) * 65 + n]); w.w = pk2(T[(kp + 6) * 65 + n], T[(kp + 7) * 65 + n]);
    *(u32x4*)(dst + (size_t)(nt * 64 + n) * K + kt * 64 + kp) = w;
    __syncthreads();
}

__device__ __forceinline__ void mod_item(const Params& p, int item, LAS unsigned char* L) {
    LAS float* sc = (LAS float*)L;
    LAS float* red = (LAS float*)(L + 65536);
    const int tid = ltid(), lane = tid & 63, wid = tid >> 6;
    for (int e = tid; e < 16384; e += 512) { const int r = e >> 10, k = e & 1023; const float c = r < 8 ? p.c_prompt[r * 1024 + k] : p.c_sample[(r - 8) * 1024 + k]; sc[k * 16 + r] = siluf_(c); }
    __syncthreads();
    const int j = item * 64 + lane;
    float acc[16];
#pragma unroll
    for (int r = 0; r < 16; ++r) acc[r] = 0.f;
    for (int k = wid * 128; k < wid * 128 + 128; ++k) {
        const float w = p.w_ada[(size_t)k * 6144 + j];
#pragma unroll
        for (int q = 0; q < 4; ++q) { const f32x4 s = *(const LAS f32x4*)(sc + k * 16 + 4 * q);
            acc[4 * q + 0] += w * s[0]; acc[4 * q + 1] += w * s[1]; acc[4 * q + 2] += w * s[2]; acc[4 * q + 3] += w * s[3]; }
    }
#pragma unroll
    for (int r = 0; r < 16; ++r) red[(wid * 16 + r) * 64 + lane] = acc[r];
    __syncthreads();
    float* MOD = (float*)(p.ws + WS_MOD);
    for (int e = tid; e < 1024; e += 512) { const int r = e >> 6, l = e & 63; float s = 0.f;
#pragma unroll
        for (int w = 0; w < 8; ++w) s += red[(w * 16 + r) * 64 + l];
        MOD[r * 6144 + item * 64 + l] = s + p.b_ada[item * 64 + l]; }
    __syncthreads();
}

__device__ __forceinline__ void phase0(const Params& p, LAS unsigned char* L) {
    const int G = gridDim.x, bid = blockIdx.x, tid = ltid();
    { f32x2* R = (f32x2*)(p.ws + WS_ROPE);
      for (int e = bid * 512 + tid; e < 4096 * 32; e += G * 512) { const int pos = e >> 5, i = e & 31;
          const double rev = (double)pos * INVF[i] * 0.15915494309189535; const double fr = rev - __builtin_rint(rev);
          f32x2 cs; cs.x = __builtin_amdgcn_cosf((float)fr); cs.y = __builtin_amdgcn_sinf((float)fr); R[e] = cs; } }
    if (bid >= G - 96) mod_item(p, bid - (G - 96), L);
    constexpr int I_IN = 16 * 172, I_A = 8 * 16, I_D = 16 * 16, I_O = 16 * 16, I_UP = 16 * 88, I_DN = 44 * 16;
    constexpr int NIT = I_IN + I_A + I_D + I_O + I_UP + I_DN;
    LAS float* T = (LAS float*)L;
    for (int it = bid; it < NIT; it += G) {
        int r = it;
        if (r < I_IN) { transpose_tile(p.w_in, 10784, (bf16_t*)(p.ws + WS_WIN), 1024, r & 15, r >> 4, 1, T); continue; } r -= I_IN;
        if (r < I_A) { transpose_tile(p.w_br_attn, 1024, (bf16_t*)(p.ws + WS_WA), 512, r & 7, r >> 3, 0, T); continue; } r -= I_A;
        if (r < I_D) { transpose_tile(p.w_br_dn, 1024, (bf16_t*)(p.ws + WS_WD), 1024, r & 15, r >> 4, 0, T); continue; } r -= I_D;
        if (r < I_O) { transpose_tile(p.w_out, 1024, (bf16_t*)(p.ws + WS_WO), 1024, r & 15, r >> 4, 0, T); continue; } r -= I_O;
        if (r < I_UP) { transpose_tile(p.w_up, NUP, (bf16_t*)(p.ws + WS_WUP), 1024, r & 15, r >> 4, 0, T); continue; } r -= I_UP;
        transpose_tile(p.w_down, 1024, (bf16_t*)(p.ws + WS_WDN), DFF, r % 44, r / 44, 0, T);
    }
}

__device__ __forceinline__ void norm_mod_rows(const Params& p, const Batch& B, const float* __restrict__ xin, const float* __restrict__ g, int sh_off, int sc_off, bf16_t* __restrict__ out) {
    const int lane = ltid() & 63, gw = blockIdx.x * 8 + (ltid() >> 6), NGW = gridDim.x * 8;
    const float* MOD = (const float*)(p.ws + WS_MOD);
    f32x4 gv[4];
#pragma unroll
    for (int i = 0; i < 4; ++i) gv[i] = *(const f32x4*)(g + 4 * lane + 256 * i);
    for (int r = gw; r < TB; r += NGW) {
        const float* xr = xin + (size_t)r * DM; const float* mr = MOD + (size_t)cond_index(B, r) * 6144;
        f32x4 v[4]; float ss = 0.f;
#pragma unroll
        for (int i = 0; i < 4; ++i) { v[i] = *(const f32x4*)(xr + 4 * lane + 256 * i); ss += v[i][0] * v[i][0] + v[i][1] * v[i][1] + v[i][2] * v[i][2] + v[i][3] * v[i][3]; }
        const float rs = rsqrtf(wave_sum(ss) * (1.0f / DM) + EPSF);
#pragma unroll
        for (int i = 0; i < 4; ++i) { const f32x4 sc = *(const f32x4*)(mr + sc_off + 4 * lane + 256 * i), sh = *(const f32x4*)(mr + sh_off + 4 * lane + 256 * i);
            const f32x4 y = v[i] * rs * gv[i] * (sc + 1.0f) + sh; u32x2 w; w.x = pk2(y[0], y[1]); w.y = pk2(y[2], y[3]);
            *(u32x2*)(out + (size_t)r * DM + 4 * lane + 256 * i) = w; }
    }
}
__device__ __forceinline__ void final_norm_rows(float* __restrict__ io, const float* __restrict__ g) {
    const int lane = ltid() & 63, gw = blockIdx.x * 8 + (ltid() >> 6), NGW = gridDim.x * 8;
    f32x4 gv[4];
#pragma unroll
    for (int i = 0; i < 4; ++i) gv[i] = *(const f32x4*)(g + 4 * lane + 256 * i);
    for (int r = gw; r < TB; r += NGW) {
        float* xr = io + (size_t)r * DM; f32x4 v[4]; float ss = 0.f;
#pragma unroll
        for (int i = 0; i < 4; ++i) { v[i] = *(const f32x4*)(xr + 4 * lane + 256 * i); ss += v[i][0] * v[i][0] + v[i][1] * v[i][1] + v[i][2] * v[i][2] + v[i][3] * v[i][3]; }
        const float rs = rsqrtf(wave_sum(ss) * (1.0f / DM) + EPSF);
#pragma unroll
        for (int i = 0; i < 4; ++i) *(f32x4*)(xr + 4 * lane + 256 * i) = v[i] * rs * gv[i];
    }
}

struct EpiBf16S {
    static constexpr bool PERM = true, AFTER_DRAIN = false;
    bf16_t* O; int ldc;
    __device__ __forceinline__ void operator()(const f32x4 (&acc)[2][2][4][2], const pg8::Unit& u, int wr, int wc, int fr, int fq) const {
        const int row0 = u.pm * 256 + wr * 64 + fr, col0 = u.pn * 256 + wc * 32 + 8 * fq;
#pragma unroll
        for (int ai = 0; ai < 2; ++ai)
#pragma unroll
            for (int m = 0; m < 4; ++m) { bf16_t* rowp = O + (size_t)(row0 + ai * 128 + m * 16) * ldc + col0;
#pragma unroll
                for (int bj = 0; bj < 2; ++bj) { const f32x4 v0 = acc[ai][bj][m][0], v1 = acc[ai][bj][m][1];
                    u32x4 w; w.x = pk2(v0[0], v0[1]); w.y = pk2(v0[2], v0[3]); w.z = pk2(v1[0], v1[1]); w.w = pk2(v1[2], v1[3]);
                    *(u32x4*)(rowp + bj * 128) = w; } }
    }
};
struct EpiGateA {
    static constexpr bool PERM = false, AFTER_DRAIN = false;
    float* T; const bf16_t* gate; int ldg;
    __device__ __forceinline__ void operator()(const f32x4 (&acc)[2][2][4][2], const pg8::Unit& u, int wr, int wc, int fr, int fq) const {
        const int row0 = u.pm * 256 + wr * 64 + fr, col0 = u.pn * 256 + wc * 32 + 4 * fq;
#pragma unroll
        for (int ai = 0; ai < 2; ++ai)
#pragma unroll
            for (int m = 0; m < 4; ++m) { const int row = row0 + ai * 128 + m * 16;
#pragma unroll
                for (int bj = 0; bj < 2; ++bj)
#pragma unroll
                    for (int n = 0; n < 2; ++n) { const int col = col0 + bj * 128 + n * 16; const u32x2 gw = *(const u32x2*)(gate + (size_t)row * ldg + col);
                        f32x4 o; o[0] = sigmoidf_(bflo(gw.x)) * acc[ai][bj][m][n][0]; o[1] = sigmoidf_(bfhi(gw.x)) * acc[ai][bj][m][n][1];
                        o[2] = sigmoidf_(bflo(gw.y)) * acc[ai][bj][m][n][2]; o[3] = sigmoidf_(bfhi(gw.y)) * acc[ai][bj][m][n][3];
                        *(f32x4*)(T + (size_t)row * DM + col) = o; } }
    }
};
struct EpiGateB {
    static constexpr bool PERM = false, AFTER_DRAIN = false;
    const float* T; const bf16_t* gate; int ldg; bf16_t* O;
    __device__ __forceinline__ void operator()(const f32x4 (&acc)[2][2][4][2], const pg8::Unit& u, int wr, int wc, int fr, int fq) const {
        const int row0 = u.pm * 256 + wr * 64 + fr, col0 = u.pn * 256 + wc * 32 + 4 * fq;
#pragma unroll
        for (int ai = 0; ai < 2; ++ai)
#pragma unroll
            for (int m = 0; m < 4; ++m) { const int row = row0 + ai * 128 + m * 16;
#pragma unroll
                for (int bj = 0; bj < 2; ++bj)
#pragma unroll
                    for (int n = 0; n < 2; ++n) { const int col = col0 + bj * 128 + n * 16; const u32x2 gw = *(const u32x2*)(gate + (size_t)row * ldg + col);
                        const f32x4 t = *(const f32x4*)(T + (size_t)row * DM + col);
                        const float o0 = t[0] + sigmoidf_(bflo(gw.x)) * acc[ai][bj][m][n][0], o1 = t[1] + sigmoidf_(bfhi(gw.x)) * acc[ai][bj][m][n][1];
                        const float o2 = t[2] + sigmoidf_(bflo(gw.y)) * acc[ai][bj][m][n][2], o3 = t[3] + sigmoidf_(bfhi(gw.y)) * acc[ai][bj][m][n][3];
                        u32x2 w; w.x = pk2(o0, o1); w.y = pk2(o2, o3); *(u32x2*)(O + (size_t)row * DM + col) = w; } }
    }
};
struct EpiResid {
    static constexpr bool PERM = false, AFTER_DRAIN = false;
    const float* xin; float* out; const float* gt; int lgL, cbase;
    __device__ __forceinline__ void operator()(const f32x4 (&acc)[2][2][4][2], const pg8::Unit& u, int wr, int wc, int fr, int fq) const {
        const int row0 = u.pm * 256 + wr * 64 + fr, col0 = u.pn * 256 + wc * 32 + 4 * fq;
#pragma unroll
        for (int ai = 0; ai < 2; ++ai)
#pragma unroll
            for (int m = 0; m < 4; ++m) { const int row = row0 + ai * 128 + m * 16; const float* gr = gt + (size_t)(cbase + (row >> lgL)) * 6144;
#pragma unroll
                for (int bj = 0; bj < 2; ++bj)
#pragma unroll
                    for (int n = 0; n < 2; ++n) { const int col = col0 + bj * 128 + n * 16;
                        const f32x4 xv = *(const f32x4*)(xin + (size_t)row * DM + col), gv = *(const f32x4*)(gr + col);
                        *(f32x4*)(out + (size_t)row * DM + col) = xv + gv * acc[ai][bj][m][n]; } }
    }
};

__device__ __forceinline__ float bf_el(const u32x4& a, const u32x4& b, int e) { const unsigned w = (e < 8) ? a[(e >> 1) & 3] : b[(e >> 1) & 3]; return (e & 1) ? bfhi(w) : bflo(w); }

__device__ __forceinline__ void prep_item(const Params& p, const Batch& B, int item, LAS unsigned char* L) {
    const int tid = ltid(), lane = tid & 63, wid = tid >> 6, g = lane >> 4, fr = lane & 15;
    const int NC = B.L >> 6;
    const int h = item & 7, sn = item >> 3, n = sn & (NC - 1), seq = sn >> (B.lgL - 6);
    const int r0 = seq * B.L + n * 64;
    LAS bf16_t* KS = (LAS bf16_t*)L;
    LAS bf16_t* QS = (LAS bf16_t*)(L + 17408);
    LAS float* KK = (LAS float*)(L + 34816);
    LAS float* QK = (LAS float*)(L + 51456);
    LAS float* TT = (LAS float*)(L + 68096);
    LAS float* AA = (LAS float*)(L + 100864);
    LAS float* GS = (LAS float*)(L + 135680);
    const bf16_t* PROJ = (const bf16_t*)(p.ws + WS_PROJ);
    bf16_t* QKVD = (bf16_t*)(p.ws + WS_QKVD);
    {
        const int r = tid >> 3, pc = (tid & 7) * 16; const int row = r0 + r; const int s = n * 64 + r;
        const bool hasp = s > 0, hasn = s < B.L - 1;
#pragma unroll
        for (int mat = 0; mat < 3; ++mat) {
            const int col = mat * 1024 + h * 128 + pc;
            const bf16_t* src = PROJ + (size_t)row * NPROJ + C_QD + col;
            const u32x4 z4 = {0u, 0u, 0u, 0u};
            const u32x4 xc0 = *(const u32x4*)src, xc1 = *(const u32x4*)(src + 8);
            u32x4 xp0 = z4, xp1 = z4, xn0 = z4, xn1 = z4;
            if (hasp) { xp0 = *(const u32x4*)(src - NPROJ); xp1 = *(const u32x4*)(src - NPROJ + 8); }
            if (hasn) { xn0 = *(const u32x4*)(src + NPROJ); xn1 = *(const u32x4*)(src + NPROJ + 8); }
            const float* cw = p.conv_qkv_w + col;
            float y[16]; float ss = 0.f;
#pragma unroll
            for (int q = 0; q < 4; ++q) {
                const f32x4 w0 = *(const f32x4*)(cw + 4 * q), w1 = *(const f32x4*)(cw + 3072 + 4 * q), w2 = *(const f32x4*)(cw + 6144 + 4 * q);
#pragma unroll
                for (int e = 0; e < 4; ++e) { const int ee = 4 * q + e;
                    float v = bf_el(xp0, xp1, ee) * w0[e] + bf_el(xc0, xc1, ee) * w1[e] + bf_el(xn0, xn1, ee) * w2[e];
                    v = siluf_(v); y[ee] = v; ss += v * v; }
            }
            if (mat < 2) {
                ss += __shfl_xor(ss, 1); ss += __shfl_xor(ss, 2); ss += __shfl_xor(ss, 4);
                float sc = rsqrtf(ss + EPSF); if (mat == 0) sc *= 0.08838834764831845f;
#pragma unroll
                for (int e = 0; e < 16; ++e) y[e] *= sc;
            }
            u32x4 o0, o1;
            o0.x = pk2(y[0], y[1]); o0.y = pk2(y[2], y[3]); o0.z = pk2(y[4], y[5]); o0.w = pk2(y[6], y[7]);
            o1.x = pk2(y[8], y[9]); o1.y = pk2(y[10], y[11]); o1.z = pk2(y[12], y[13]); o1.w = pk2(y[14], y[15]);
            bf16_t* dst = QKVD + (size_t)row * 3072 + col;
            *(u32x4*)dst = o0; *(u32x4*)(dst + 8) = o1;
            if (mat == 0) { *(LAS u32x4*)(QS + r * 136 + pc) = o0; *(LAS u32x4*)(QS + r * 136 + pc + 8) = o1; }
            if (mat == 1) { *(LAS u32x4*)(KS + r * 136 + pc) = o0; *(LAS u32x4*)(KS + r * 136 + pc + 8) = o1; }
        }
    }
    __syncthreads();
    {
        const int mat = wid >> 2, ct = wid & 3; const LAS bf16_t* AS = mat ? QS : KS; LAS float* OUT = mat ? QK : KK;
        bf16x8 a[4];
#pragma unroll
        for (int ks = 0; ks < 4; ++ks) a[ks] = *(const LAS bf16x8*)(AS + (16 * ct + fr) * 136 + 32 * ks + 8 * g);
#pragma unroll
        for (int dt = 0; dt < 4; ++dt) {
            f32x4 acc = {0.f, 0.f, 0.f, 0.f};
#pragma unroll
            for (int ks = 0; ks < 4; ++ks) { const bf16x8 b = *(const LAS bf16x8*)(KS + (16 * dt + fr) * 136 + 32 * ks + 8 * g); acc = __builtin_amdgcn_mfma_f32_16x16x32_bf16(a[ks], b, acc, 0, 0, 0); }
#pragma unroll
            for (int j = 0; j < 4; ++j) OUT[(16 * ct + 4 * g + j) * 65 + 16 * dt + fr] = acc[j];
        }
    }
    if (wid < 2) {
        const int dir = wid; const int c = dir ? 63 - lane : lane; const int row = r0 + c;
        const float al = bf2f(PROJ[(size_t)row * NPROJ + C_AB + dir * 8 + h]), be = bf2f(PROJ[(size_t)row * NPROJ + C_AB + 16 + dir * 8 + h]);
        const float xx = al + p.dt_bias[dir * 8 + h]; const float sp = fmaxf(xx, 0.f) + log1pf(__expf(-fabsf(xx)));
        float G = -__expf(p.a_log[dir * 8 + h]) * sp;
#pragma unroll
        for (int o = 1; o < 64; o <<= 1) { const float t = __shfl_up(G, o); if (lane >= o) G += t; }
        const float G63 = __shfl(G, 63);
        GS[dir * 64 + lane] = G; GS[128 + dir * 64 + lane] = sigmoidf_(be);
        const int np = dir ? NC - 1 - n : n; const size_t cid = ((size_t)((seq * 2 + dir) * 8 + h)) * NC + np;
        float* EG = (float*)(p.ws + WS_EG) + cid * 128; EG[lane] = __expf(G); EG[64 + lane] = __expf(G63 - G);
    }
    for (int e = tid; e < 8192; e += 512) TT[e] = 0.f;
    __syncthreads();
    for (int e = tid; e < 8192; e += 512) { const int dir = e >> 12, i = (e >> 6) & 63, j = e & 63; float a = 0.f;
        if (i > j) { const int ci = dir ? 63 - i : i, cj = dir ? 63 - j : j; a = GS[128 + dir * 64 + i] * KK[ci * 65 + cj] * __expf(GS[dir * 64 + i] - GS[dir * 64 + j]); }
        AA[(dir * 64 + i) * 68 + j] = a; }
    __syncthreads();
    if (wid < 2) {
        const int dir = wid; LAS float* Td = TT + dir * 4096; const LAS float* Ad = AA + dir * 64 * 68;
        for (int i = 0; i < 64; ++i) { float acc = (lane == i) ? 1.f : 0.f;
            for (int j = 0; j < i; j += 4) { const f32x4 a = *(const LAS f32x4*)(Ad + i * 68 + j);
                acc -= a[0] * Td[j * 64 + lane] + a[1] * Td[(j + 1) * 64 + lane] + a[2] * Td[(j + 2) * 64 + lane] + a[3] * Td[(j + 3) * 64 + lane]; }
            Td[i * 64 + lane] = acc; }
    }
    __syncthreads();
    {
        bf16_t* TPg = (bf16_t*)(p.ws + WS_TP);
        for (int t = tid; t < 2048; t += 512) { const int which = t >> 10, dir = (t >> 9) & 1, i = (t >> 3) & 63, j0 = (t & 7) * 8;
            const int np = dir ? NC - 1 - n : n; const size_t cid = ((size_t)((seq * 2 + dir) * 8 + h)) * NC + np;
            float v[8];
            if (which == 0) {
#pragma unroll
                for (int e = 0; e < 8; ++e) v[e] = TT[dir * 4096 + i * 64 + j0 + e] * GS[128 + dir * 64 + j0 + e];
            } else { const int ci = dir ? 63 - i : i; const float Gi = GS[dir * 64 + i];
#pragma unroll
                for (int e = 0; e < 8; ++e) { const int j = j0 + e, cj = dir ? 63 - j : j; v[e] = (i >= j) ? QK[ci * 65 + cj] * __expf(Gi - GS[dir * 64 + j]) : 0.f; } }
            u32x4 w; w.x = pk2(v[0], v[1]); w.y = pk2(v[2], v[3]); w.z = pk2(v[4], v[5]); w.w = pk2(v[6], v[7]);
            *(u32x4*)(TPg + cid * 8192 + which * 4096 + i * 64 + j0) = w; }
    }
    __syncthreads();
}

__device__ __forceinline__ bf16x8 pack8(const f32x4& a, const f32x4& b) { u32x4 w; w.x = pk2(a[0], a[1]); w.y = pk2(a[2], a[3]); w.z = pk2(b[0], b[1]); w.w = pk2(b[2], b[3]); return __builtin_bit_cast(bf16x8, w); }
__device__ __forceinline__ bf16x8 permfrag(const LAS bf16_t* base, int row, int stride, int kbase, int g) {
    const u32x2 lo = *(const LAS u32x2*)(base + row * stride + kbase + 4 * g), hi = *(const LAS u32x2*)(base + row * stride + kbase + 16 + 4 * g);
    u32x4 w; w.x = lo.x; w.y = lo.y; w.z = hi.x; w.w = hi.y; return __builtin_bit_cast(bf16x8, w);
}
#define MFMA16(a, b, c) __builtin_amdgcn_mfma_f32_16x16x32_bf16((a), (b), (c), 0, 0, 0)

__device__ __forceinline__ void scan_chain(const Params& p, const Batch& B, int chain, LAS unsigned char* L) {
    const int tid = ltid(), lane = tid & 63, wid = tid >> 6, g = lane >> 4, fr = lane & 15;
    const int NC = B.L >> 6;
    const int h = chain & 7, dir = (chain >> 3) & 1, seq = chain >> 4;
    LAS bf16_t* KS = (LAS bf16_t*)L;
    LAS bf16_t* KT = (LAS bf16_t*)(L + 17408);
    LAS bf16_t* QS = (LAS bf16_t*)(L + 35840);
    LAS bf16_t* VS = (LAS bf16_t*)(L + 53248);
    LAS bf16_t* TS = (LAS bf16_t*)(L + 70656);
    LAS bf16_t* PS = (LAS bf16_t*)(L + 79872);
    LAS float* EGS = (LAS float*)(L + 89088);
    const bf16_t* QKVD = (const bf16_t*)(p.ws + WS_QKVD);
    const bf16_t* TPg = (const bf16_t*)(p.ws + WS_TP);
    const float* EGg = (const float*)(p.ws + WS_EG);
    bf16_t* OD = (bf16_t*)(p.ws + WS_OD) + (size_t)dir * TB * 1024;
    const size_t cid0 = ((size_t)((seq * 2 + dir) * 8 + h)) * NC;
    const int cp = tid >> 3, pc = tid & 7;
    u32x4 rq0, rq1, rk0, rk1, rv0, rv1, rt, rp; float reg_eg = 0.f;
#define SC_LOAD(np_) do { const int tok_ = dir ? (B.L - 1 - ((np_) * 64 + cp)) : ((np_) * 64 + cp); const bf16_t* src_ = QKVD + (size_t)(seq * B.L + tok_) * 3072 + h * 128 + 16 * pc; \
        rq0 = *(const u32x4*)src_; rq1 = *(const u32x4*)(src_ + 8); rk0 = *(const u32x4*)(src_ + 1024); rk1 = *(const u32x4*)(src_ + 1032); rv0 = *(const u32x4*)(src_ + 2048); rv1 = *(const u32x4*)(src_ + 2056); \
        const bf16_t* tp_ = TPg + (cid0 + (np_)) * 8192 + cp * 64 + 8 * pc; rt = *(const u32x4*)tp_; rp = *(const u32x4*)(tp_ + 4096); \
        if (tid < 128) reg_eg = EGg[(cid0 + (np_)) * 128 + tid]; } while (0)
    f32x4 S[8];
#pragma unroll
    for (int i = 0; i < 8; ++i) S[i] = (f32x4){0.f, 0.f, 0.f, 0.f};
    SC_LOAD(0);
    for (int np = 0; np < NC; ++np) {
        *(LAS u32x4*)(QS + cp * 136 + 16 * pc) = rq0; *(LAS u32x4*)(QS + cp * 136 + 16 * pc + 8) = rq1;
        *(LAS u32x4*)(KS + cp * 136 + 16 * pc) = rk0; *(LAS u32x4*)(KS + cp * 136 + 16 * pc + 8) = rk1;
        *(LAS u32x4*)(VS + cp * 136 + 16 * pc) = rv0; *(LAS u32x4*)(VS + cp * 136 + 16 * pc + 8) = rv1;
        *(LAS u32x4*)(TS + cp * 72 + 8 * pc) = rt; *(LAS u32x4*)(PS + cp * 72 + 8 * pc) = rp;
#pragma unroll
        for (int e = 0; e < 8; ++e) { const unsigned w0 = rk0[e >> 1], w1 = rk1[e >> 1];
            KT[(16 * pc + e) * 72 + cp] = (bf16_t)((e & 1) ? (w0 >> 16) : (w0 & 0xffffu));
            KT[(16 * pc + 8 + e) * 72 + cp] = (bf16_t)((e & 1) ? (w1 >> 16) : (w1 & 0xffffu)); }
        if (tid < 128) EGS[tid] = reg_eg;
        __syncthreads();
        if (np + 1 < NC) SC_LOAD(np + 1);
        bf16x8 Sb[4];
#pragma unroll
        for (int ks = 0; ks < 4; ++ks) Sb[ks] = pack8(S[2 * ks], S[2 * ks + 1]);
        f32x4 X[4], Q[4];
#pragma unroll
        for (int ct = 0; ct < 4; ++ct) { X[ct] = (f32x4){0.f, 0.f, 0.f, 0.f}; Q[ct] = (f32x4){0.f, 0.f, 0.f, 0.f};
#pragma unroll
            for (int ks = 0; ks < 4; ++ks) { X[ct] = MFMA16(permfrag(KS, 16 * ct + fr, 136, 32 * ks, g), Sb[ks], X[ct]); Q[ct] = MFMA16(permfrag(QS, 16 * ct + fr, 136, 32 * ks, g), Sb[ks], Q[ct]); } }
        f32x4 EGv[4], R[4];
#pragma unroll
        for (int ct = 0; ct < 4; ++ct) { EGv[ct] = *(const LAS f32x4*)(EGS + 16 * ct + 4 * g);
#pragma unroll
            for (int j = 0; j < 4; ++j) R[ct][j] = bf2f(VS[(16 * ct + 4 * g + j) * 136 + 16 * wid + fr]) - EGv[ct][j] * X[ct][j]; }
        bf16x8 Rb[2]; Rb[0] = pack8(R[0], R[1]); Rb[1] = pack8(R[2], R[3]);
        f32x4 Vn[4];
#pragma unroll
        for (int ct = 0; ct < 4; ++ct) { Vn[ct] = (f32x4){0.f, 0.f, 0.f, 0.f};
#pragma unroll
            for (int k2 = 0; k2 < 2; ++k2) Vn[ct] = MFMA16(permfrag(TS, 16 * ct + fr, 72, 32 * k2, g), Rb[k2], Vn[ct]); }
        bf16x8 Vb[2]; Vb[0] = pack8(Vn[0], Vn[1]); Vb[1] = pack8(Vn[2], Vn[3]);
#pragma unroll
        for (int ct = 0; ct < 4; ++ct) { f32x4 O = EGv[ct] * Q[ct];
#pragma unroll
            for (int k2 = 0; k2 < 2; ++k2) O = MFMA16(permfrag(PS, 16 * ct + fr, 72, 32 * k2, g), Vb[k2], O);
#pragma unroll
            for (int j = 0; j < 4; ++j) { const int c = np * 64 + 16 * ct + 4 * g + j; const int tok = dir ? (B.L - 1 - c) : c;
                OD[(size_t)(seq * B.L + tok) * 1024 + h * 128 + 16 * wid + fr] = f2bf(O[j]); } }
#pragma unroll
        for (int ct = 0; ct < 4; ++ct) { const f32x4 egd = *(const LAS f32x4*)(EGS + 64 + 16 * ct + 4 * g); Vn[ct] = Vn[ct] * egd; }
        Vb[0] = pack8(Vn[0], Vn[1]); Vb[1] = pack8(Vn[2], Vn[3]);
        const float egl = EGS[63];
#pragma unroll
        for (int i = 0; i < 8; ++i) { S[i] = S[i] * egl;
#pragma unroll
            for (int k2 = 0; k2 < 2; ++k2) S[i] = MFMA16(permfrag(KT, 16 * i + fr, 72, 32 * k2, g), Vb[k2], S[i]); }
        __syncthreads();
    }
#undef SC_LOAD
}

__device__ __forceinline__ void attn_item(const Params& p, const Batch& B, int item, LAS unsigned char* L) {
    const int tid = ltid(), lane = tid & 63, wid = tid >> 6, g = lane >> 4, fr = lane & 15;
    const int lgper = B.lgL - 7;
    const int x = item & ((1 << lgper) - 1), sgh = item >> lgper, h = sgh & 7, sg = sgh >> 3, grp = sg % 3, seq = sg / 3;
    const int lgd = 2 * grp, r = x & ((1 << lgd) - 1), pb = x >> lgd, Lr = B.L >> lgd;
    const int mq0 = pb * 128, mk0 = mq0 - 64, hcol = (grp * 8 + h) * 64;
    LAS bf16_t* KL = (LAS bf16_t*)L;
    LAS bf16_t* VT = (LAS bf16_t*)(L + 36864);
    bf16_t* PROJ = (bf16_t*)(p.ws + WS_PROJ);
    const f32x2* ROPE = (const f32x2*)(p.ws + WS_ROPE);
    const size_t rowbase = (size_t)seq * B.L;
    const u32x4 z4 = {0u, 0u, 0u, 0u};
    for (int t = tid; t < 1024; t += 512) { const int kk = t >> 2, pp = t & 3, m = mk0 + kk; u32x4 lo = z4, hi = z4;
        if (m >= 0 && m < Lr) { const int s = (m << lgd) + r; const bf16_t* src = PROJ + (rowbase + s) * NPROJ + C_KA + hcol + 8 * pp;
            const u32x4 a = *(const u32x4*)src, b = *(const u32x4*)(src + 32); const f32x4* rp = (const f32x4*)(ROPE + (size_t)s * 32 + 8 * pp);
#pragma unroll
            for (int q = 0; q < 4; ++q) { const f32x4 cs = rp[q]; const float x1a = bflo(a[q]), x1b = bfhi(a[q]), x2a = bflo(b[q]), x2b = bfhi(b[q]);
                lo[q] = pk2(x1a * cs[0] - x2a * cs[1], x1b * cs[2] - x2b * cs[3]); hi[q] = pk2(x2a * cs[0] + x1a * cs[1], x2b * cs[2] + x1b * cs[3]); } }
        *(LAS u32x4*)(KL + kk * 72 + 8 * pp) = lo; *(LAS u32x4*)(KL + kk * 72 + 32 + 8 * pp) = hi; }
    for (int t = tid; t < 2048; t += 512) { const int kk = t >> 3, p8 = t & 7, m = mk0 + kk; u32x4 a = z4;
        if (m >= 0 && m < Lr) { const int s = (m << lgd) + r; a = *(const u32x4*)(PROJ + (rowbase + s) * NPROJ + C_VA + hcol + 8 * p8); }
#pragma unroll
        for (int e = 0; e < 8; ++e) { const unsigned w = a[e >> 1]; VT[(8 * p8 + e) * 264 + kk] = (bf16_t)((e & 1) ? (w >> 16) : (w & 0xffffu)); } }
    __syncthreads();
    {
        const int mq = mq0 + 16 * wid + fr, sq = (mq << lgd) + r;
        bf16_t* qptr = PROJ + (rowbase + sq) * NPROJ + C_QA + hcol;
        const u32x4 qa = *(const u32x4*)(qptr + 8 * g), qb = *(const u32x4*)(qptr + 32 + 8 * g);
        const f32x4* rp = (const f32x4*)(ROPE + (size_t)sq * 32 + 8 * g);
        u32x4 lo, hi;
#pragma unroll
        for (int q = 0; q < 4; ++q) { const f32x4 cs = rp[q] * 0.125f; const float x1a = bflo(qa[q]), x1b = bfhi(qa[q]), x2a = bflo(qb[q]), x2b = bfhi(qb[q]);
            lo[q] = pk2(x1a * cs[0] - x2a * cs[1], x1b * cs[2] - x2b * cs[3]); hi[q] = pk2(x2a * cs[0] + x1a * cs[1], x2b * cs[2] + x1b * cs[3]); }
        bf16x8 qf[2]; qf[0] = __builtin_bit_cast(bf16x8, lo); qf[1] = __builtin_bit_cast(bf16x8, hi);
        f32x4 st[9]; float mx = -3.0e38f;
#pragma unroll
        for (int t = 0; t < 9; ++t) { f32x4 acc = {0.f, 0.f, 0.f, 0.f};
#pragma unroll
            for (int ks = 0; ks < 2; ++ks) acc = MFMA16(*(const LAS bf16x8*)(KL + (16 * (wid + t) + fr) * 72 + 32 * ks + 8 * g), qf[ks], acc);
#pragma unroll
            for (int j = 0; j < 4; ++j) { const int m = mk0 + 16 * (wid + t) + 4 * g + j; const int dq = mq - m; const bool ok = (dq <= 64) && (dq >= -64) && (m >= 0) && (m < Lr);
                acc[j] = ok ? acc[j] : -1.0e30f; mx = fmaxf(mx, acc[j]); }
            st[t] = acc; }
        mx = fmaxf(mx, __shfl_xor(mx, 16)); mx = fmaxf(mx, __shfl_xor(mx, 32));
        float den = 0.f;
#pragma unroll
        for (int t = 0; t < 9; ++t)
#pragma unroll
            for (int j = 0; j < 4; ++j) { const float e = __expf(st[t][j] - mx); st[t][j] = e; den += e; }
        den += __shfl_xor(den, 16); den += __shfl_xor(den, 32);
        bf16x8 pbf[5];
#pragma unroll
        for (int ks = 0; ks < 4; ++ks) pbf[ks] = pack8(st[2 * ks], st[2 * ks + 1]);
        pbf[4] = pack8(st[8], (f32x4){0.f, 0.f, 0.f, 0.f});
        const float rden = 1.0f / den;
#pragma unroll
        for (int dt = 0; dt < 4; ++dt) { f32x4 o = {0.f, 0.f, 0.f, 0.f};
#pragma unroll
            for (int ks = 0; ks < 5; ++ks) { const LAS bf16_t* vp = VT + (16 * dt + fr) * 264 + 16 * (wid + 2 * ks) + 4 * g;
                const u32x2 vl = *(const LAS u32x2*)vp; u32x2 vh = {0u, 0u}; if (ks < 4) vh = *(const LAS u32x2*)(vp + 16);
                u32x4 w; w.x = vl.x; w.y = vl.y; w.z = vh.x; w.w = vh.y; o = MFMA16(__builtin_bit_cast(bf16x8, w), pbf[ks], o); }
            u32x2 ow; ow.x = pk2(o[0] * rden, o[1] * rden); ow.y = pk2(o[2] * rden, o[3] * rden);
            *(u32x2*)(qptr + 16 * dt + 4 * g) = ow; }
        if (g == 0) ((float*)(p.ws + WS_LSE))[(rowbase + sq) * 24 + grp * 8 + h] = mx + __logf(den);
    }
    __syncthreads();
}

__device__ __forceinline__ void post_mixer(const Params& p) {
    const int lane = ltid() & 63, gw = blockIdx.x * 8 + (ltid() >> 6), NGW = gridDim.x * 8;
    const bf16_t* PROJ = (const bf16_t*)(p.ws + WS_PROJ); const float* LSE = (const float*)(p.ws + WS_LSE);
    const bf16_t* OD0 = (const bf16_t*)(p.ws + WS_OD); const bf16_t* OD1 = OD0 + (size_t)TB * 1024;
    bf16_t* YA = (bf16_t*)(p.ws + WS_YA); bf16_t* YD = (bf16_t*)(p.ws + WS_XN);
    float dg[16];
#pragma unroll
    for (int e = 0; e < 16; ++e) dg[e] = p.dn_norm_g[(16 * lane + e) & 127];
    for (int r = gw; r < TB; r += NGW) {
        { const int hh = lane >> 3; const float l0 = LSE[(size_t)r * 24 + hh], l1 = LSE[(size_t)r * 24 + 8 + hh], l2 = LSE[(size_t)r * 24 + 16 + hh];
          const float mx = fmaxf(l0, fmaxf(l1, l2)); float w0 = __expf(l0 - mx), w1 = __expf(l1 - mx), w2 = __expf(l2 - mx); const float inv = 1.0f / (w0 + w1 + w2); w0 *= inv; w1 *= inv; w2 *= inv;
          const bf16_t* src = PROJ + (size_t)r * NPROJ + C_QA + 8 * lane;
          const u32x4 a = *(const u32x4*)src, b = *(const u32x4*)(src + 512), c = *(const u32x4*)(src + 1024); u32x4 o;
#pragma unroll
          for (int q = 0; q < 4; ++q) o[q] = pk2(w0 * bflo(a[q]) + w1 * bflo(b[q]) + w2 * bflo(c[q]), w0 * bfhi(a[q]) + w1 * bfhi(b[q]) + w2 * bfhi(c[q]));
          *(u32x4*)(YA + (size_t)r * 512 + 8 * lane) = o; }
        { const bf16_t* s0 = OD0 + (size_t)r * 1024 + 16 * lane; const bf16_t* s1 = OD1 + (size_t)r * 1024 + 16 * lane; const bf16_t* zp = PROJ + (size_t)r * NPROJ + C_ZD + 16 * lane;
          const u32x4 a0 = *(const u32x4*)s0, a1 = *(const u32x4*)(s0 + 8), b0 = *(const u32x4*)s1, b1 = *(const u32x4*)(s1 + 8), z0 = *(const u32x4*)zp, z1 = *(const u32x4*)(zp + 8);
          float v[16]; float ss = 0.f;
#pragma unroll
          for (int e = 0; e < 16; ++e) { v[e] = bf_el(a0, a1, e) + bf_el(b0, b1, e); ss += v[e] * v[e]; }
          ss += __shfl_xor(ss, 1); ss += __shfl_xor(ss, 2); ss += __shfl_xor(ss, 4);
          const float rs = rsqrtf(ss * (1.0f / 128.0f) + EPSF);
#pragma unroll
          for (int e = 0; e < 16; ++e) v[e] = v[e] * rs * dg[e] * siluf_(bf_el(z0, z1, e));
          u32x4 o0, o1; o0.x = pk2(v[0], v[1]); o0.y = pk2(v[2], v[3]); o0.z = pk2(v[4], v[5]); o0.w = pk2(v[6], v[7]);
          o1.x = pk2(v[8], v[9]); o1.y = pk2(v[10], v[11]); o1.z = pk2(v[12], v[13]); o1.w = pk2(v[14], v[15]);
          *(u32x4*)(YD + (size_t)r * 1024 + 16 * lane) = o0; *(u32x4*)(YD + (size_t)r * 1024 + 16 * lane + 8) = o1; }
    }
}

__device__ __forceinline__ void conv_act(const Params& p, const Batch& B) {
    const bf16_t* UP = (const bf16_t*)(p.ws + WS_PROJ); bf16_t* ACT = (bf16_t*)(p.ws + WS_PROJ + (size_t)TB * NUP * 2);
    const u32x4 z4 = {0u, 0u, 0u, 0u};
    for (int t = blockIdx.x * 512 + ltid(); t < TB * 352; t += gridDim.x * 512) {
        const int row = t / 352, cg8 = (t - row * 352) * 8; const int s = row & (B.L - 1);
        const bf16_t* src = UP + (size_t)row * NUP + cg8;
        const u32x4 vc = *(const u32x4*)src, gc = *(const u32x4*)(src + DFF);
        u32x4 vp = z4, gp = z4, vn = z4, gn = z4;
        if (s > 0) { vp = *(const u32x4*)(src - NUP); gp = *(const u32x4*)(src - NUP + DFF); }
        if (s < B.L - 1) { vn = *(const u32x4*)(src + NUP); gn = *(const u32x4*)(src + NUP + DFF); }
        float o[8];
#pragma unroll
        for (int q = 0; q < 2; ++q) {
            const f32x4 wv0 = *(const f32x4*)(p.ffn_conv_w + cg8 + 4 * q), wv1 = *(const f32x4*)(p.ffn_conv_w + NUP + cg8 + 4 * q), wv2 = *(const f32x4*)(p.ffn_conv_w + 2 * NUP + cg8 + 4 * q);
            const f32x4 wg0 = *(const f32x4*)(p.ffn_conv_w + DFF + cg8 + 4 * q), wg1 = *(const f32x4*)(p.ffn_conv_w + NUP + DFF + cg8 + 4 * q), wg2 = *(const f32x4*)(p.ffn_conv_w + 2 * NUP + DFF + cg8 + 4 * q);
            const f32x4 bv = *(const f32x4*)(p.ffn_conv_b + cg8 + 4 * q), bg = *(const f32x4*)(p.ffn_conv_b + DFF + cg8 + 4 * q);
#pragma unroll
            for (int e = 0; e < 4; ++e) { const int ee = 4 * q + e;
                const float val = bf_el(vp, z4, ee) * wv0[e] + bf_el(vc, z4, ee) * wv1[e] + bf_el(vn, z4, ee) * wv2[e] + bv[e];
                const float gt = bf_el(gp, z4, ee) * wg0[e] + bf_el(gc, z4, ee) * wg1[e] + bf_el(gn, z4, ee) * wg2[e] + bg[e];
                o[ee] = siluf_(gt) * val; }
        }
        u32x4 w; w.x = pk2(o[0], o[1]); w.y = pk2(o[2], o[3]); w.z = pk2(o[4], o[5]); w.w = pk2(o[6], o[7]);
        *(u32x4*)(ACT + (size_t)row * DFF + cg8) = w;
    }
}

#ifndef EN_P0
#define EN_P0 1
#endif
#ifndef EN_PREP
#define EN_PREP 1
#endif
#ifndef EN_SCAN
#define EN_SCAN 1
#endif
#ifndef EN_ATT
#define EN_ATT 1
#endif
#ifndef EN_POST
#define EN_POST 1
#endif
#ifndef EN_CONV
#define EN_CONV 1
#endif
#ifndef EN_G1
#define EN_G1 1
#endif
#ifndef EN_G2
#define EN_G2 1
#endif
#ifndef EN_G3
#define EN_G3 1
#endif
#ifndef EN_G4
#define EN_G4 1
#endif
#ifndef EN_G5
#define EN_G5 1
#endif
__global__ void __launch_bounds__(512) mega(Params p) {
    extern __shared__ __attribute__((aligned(16))) unsigned char lds_raw[];
    LAS unsigned char* L = (LAS unsigned char*)lds_raw;
    cg::grid_group grid = cg::this_grid();
    const int G = gridDim.x, bid = blockIdx.x, tid = ltid();
    int ph = 0;
#define PHASE_ON (ph >= p.ph_lo && ph < p.ph_hi)
#define SEAM() do { if (ph >= p.ph_lo && ph + 1 < p.ph_hi) grid.sync(); ++ph; } while (0)
    unsigned* ctl = (unsigned*)(p.ws + WS_CTL);
    float* MOD = (float*)(p.ws + WS_MOD);
    bf16_t* XN = (bf16_t*)(p.ws + WS_XN); bf16_t* PROJ = (bf16_t*)(p.ws + WS_PROJ);
    if (EN_P0 && PHASE_ON) phase0(p, L);
    SEAM();
    if (PHASE_ON) { const Batch B0 = make_batch(p, 0); norm_mod_rows(p, B0, B0.x, p.norm1_g, 0, 1024, XN); }
    SEAM();
    for (int b = 0; b < 3; ++b) {
        const Batch B = make_batch(p, b);
        const int cbase = b == 0 ? 0 : 8 + (b - 1) * 4;
        if (EN_G1 && PHASE_ON) { pg8::Gemm g{XN, (const bf16_t*)(p.ws + WS_WIN), TB, NPROJ, 1024}; pg8::StaticOrder S; S.init(TB, NPROJ, G, bid); EpiBf16S E{PROJ, NPROJ}; pg8::gemm_phase<EpiBf16S, pg8::StaticOrder>(L, g, S, E); }
        SEAM();
        if (EN_PREP && PHASE_ON) { const int nit = (TB >> 6) * 8; for (int it = bid; it < nit; it += G) prep_item(p, B, it, L); }
        SEAM();
        if (PHASE_ON) {
            const int nscan = B.nseq * 16, natt = B.nseq * 24 * (B.L >> 7);
            LAS int* slot = (LAS int*)(L + 143360 - 16);
            for (;;) {
                if (tid == 0) *slot = (int)atomicAdd(ctl + 64 * b, 1u);
                __syncthreads();
                const int idx = *slot;
                __syncthreads();
                if (idx >= nscan + natt) break;
                if (idx < nscan) { if (EN_SCAN) scan_chain(p, B, idx, L); } else { if (EN_ATT) attn_item(p, B, idx - nscan, L); }
            }
        }
        SEAM();
        if (EN_POST && PHASE_ON) post_mixer(p);
        SEAM();
        if (EN_G2 && PHASE_ON) {
            float* TMP = (float*)(p.ws + WS_QKVD); bf16_t* MERGED = (bf16_t*)(p.ws + WS_QKVD + (size_t)TB * 1024 * 4);
            { pg8::Gemm g{(const bf16_t*)(p.ws + WS_YA), (const bf16_t*)(p.ws + WS_WA), TB, 1024, 512}; pg8::StaticOrder S; S.init(TB, 1024, G, bid); EpiGateA E{TMP, PROJ + C_GA, NPROJ}; pg8::gemm_phase<EpiGateA, pg8::StaticOrder>(L, g, S, E); }
            { pg8::Gemm g{XN, (const bf16_t*)(p.ws + WS_WD), TB, 1024, 1024}; pg8::StaticOrder S; S.init(TB, 1024, G, bid); EpiGateB E{TMP, PROJ + C_GD, NPROJ, MERGED}; pg8::gemm_phase<EpiGateB, pg8::StaticOrder>(L, g, S, E); }
        }
        SEAM();
        if (EN_G3 && PHASE_ON) { const bf16_t* MERGED = (const bf16_t*)(p.ws + WS_QKVD + (size_t)TB * 1024 * 4);
            pg8::Gemm g{MERGED, (const bf16_t*)(p.ws + WS_WO), TB, 1024, 1024}; pg8::StaticOrder S; S.init(TB, 1024, G, bid); EpiResid E{B.x, B.out, MOD + 2048, B.lgL, cbase}; pg8::gemm_phase<EpiResid, pg8::StaticOrder>(L, g, S, E); }
        SEAM();
        if (PHASE_ON) norm_mod_rows(p, B, B.out, p.norm2_g, 3072, 4096, XN);
        SEAM();
        if (EN_G4 && PHASE_ON) { pg8::Gemm g{XN, (const bf16_t*)(p.ws + WS_WUP), TB, NUP, 1024}; pg8::StaticOrder S; S.init(TB, NUP, G, bid); EpiBf16S E{PROJ, NUP}; pg8::gemm_phase<EpiBf16S, pg8::StaticOrder>(L, g, S, E); }
        SEAM();
        if (EN_CONV && PHASE_ON) conv_act(p, B);
        SEAM();
        if (EN_G5 && PHASE_ON) { pg8::Gemm g{(const bf16_t*)(p.ws + WS_PROJ + (size_t)TB * NUP * 2), (const bf16_t*)(p.ws + WS_WDN), TB, 1024, DFF}; pg8::StaticOrder S; S.init(TB, 1024, G, bid);
            EpiResid E{B.out, B.out, MOD + 5120, B.lgL, cbase}; pg8::gemm_phase<EpiResid, pg8::StaticOrder>(L, g, S, E); }
        SEAM();
        if (PHASE_ON) { final_norm_rows(B.out, p.norm_f_g); if (b < 2) { const Batch Bn = make_batch(p, b + 1); norm_mod_rows(p, Bn, Bn.x, p.norm1_g, 0, 1024, XN); } }
        SEAM();
    }
}
constexpr int N_PHASES = 2 + 3 * 11;

#ifndef MULTI_LAUNCH
#define MULTI_LAUNCH 0
#endif
extern "C" void kernel_launch(void* const* d_in, const int* in_sizes, int n_in, void* d_out, int out_size, void* d_ws, size_t ws_size, hipStream_t stream) {
    static int grid = 0;
    if (grid == 0) {
        if (n_in != 21 || ws_size < WS_END) { fprintf(stderr, "kernel_launch: need 21 inputs and %zu bytes of workspace (got %d, %zu)\n", (size_t)WS_END, n_in, ws_size); grid = -1; return; }
        int dev = 0, cus = 0, per_cu = 0;
        hipGetDevice(&dev); hipDeviceGetAttribute(&cus, hipDeviceAttributeMultiprocessorCount, dev);
        if (hipFuncSetAttribute((const void*)mega, hipFuncAttributeMaxDynamicSharedMemorySize, LDS_BYTES) != hipSuccess) { fprintf(stderr, "kernel_launch: hipFuncSetAttribute failed\n"); grid = -1; return; }
        if (hipOccupancyMaxActiveBlocksPerMultiprocessor(&per_cu, (const void*)mega, 512, LDS_BYTES) != hipSuccess || per_cu < 1) { fprintf(stderr, "kernel_launch: occupancy query says %d blocks/CU\n", per_cu); grid = -1; return; }
        grid = cus;
    }
    if (grid < 0) return;
    hipMemsetAsync((char*)d_ws + WS_CTL, 0, 4096, stream);
    Params p{};
    const float** pp = (const float**)&p;
    for (int i = 0; i < 21; ++i) pp[i] = (const float*)d_in[i];
    p.out = (float*)d_out; p.ws = (unsigned char*)d_ws;
#if MULTI_LAUNCH
    for (int ph = 0; ph < N_PHASES; ++ph) { p.ph_lo = ph; p.ph_hi = ph + 1; hipLaunchKernelGGL(mega, dim3(grid), dim3(512), LDS_BYTES, stream, p); }
#else
    p.ph_lo = 0; p.ph_hi = N_PHASES;
    void* args[] = {&p};
    hipError_t e = hipLaunchCooperativeKernel((const void*)mega, dim3(grid), dim3(512), args, LDS_BYTES, stream);
    if (e != hipSuccess) fprintf(stderr, "cooperative launch failed: %s (grid %d)\n", hipGetErrorString(e), grid);
#endif
}
```

```cpp
#include <hip/hip_runtime.h>
#include <cstdio>
namespace pg8 {
#define PG8_LAS __attribute__((address_space(3)))
typedef unsigned short bf16_t;
typedef short bf16x8 __attribute__((ext_vector_type(8)));
typedef float f32x4 __attribute__((ext_vector_type(4)));
typedef unsigned u32x4 __attribute__((ext_vector_type(4)));
constexpr int BM = 256, BK = 64, HALF = 128, HTB = HALF * BK * 2  , STAGE_BYTES = 8 * HTB, NXCD = 8, WGM = 8;

__host__ __device__ __forceinline__ int lds_byte(int r, int c) { const int st = (r >> 4) * 2 + (c >> 5), rr = r & 15, cc = c & 31, ob = rr * 64 + cc * 2; return st * 1024 + (ob ^ (((ob >> 9) & 1) << 5)); }
__host__ __device__ __forceinline__ void stage_rc(int b, int& R, int& C) { const int st = b / 1024, sb = b % 1024, swz = sb ^ (((sb >> 9) & 1) << 5); R = (st >> 1) * 16 + swz / 64; C = (st & 1) * 32 + (swz % 64) / 2; }
__host__ __device__ __forceinline__ int perm32(int rho) { const int n = rho >> 4, i = rho & 15; return 8 * (i >> 2) + 4 * n + (i & 3); }

struct Unit { int pm, pn; };
struct Gemm { const bf16_t* A; const bf16_t* Bt; int M, N, K; };

struct StaticOrder {
    int nM, nN, nwg, G, c;
    __host__ __device__ void init(int M, int N, int G_, int c_) { nM = M / BM; nN = N / BM; nwg = nM * nN; G = G_; c = c_; }
    __host__ __device__ bool next(int i, Unit& u) const {
        const long L = (long)i * G + c; if (L >= nwg) return false;
        int wgid = (int)L; { const int q = nwg / NXCD, r = nwg % NXCD, xcd = wgid % NXCD, off = wgid / NXCD; wgid = (xcd < r ? xcd * (q + 1) : r * (q + 1) + (xcd - r) * q) + off; }
        const int nig = WGM * nN, gid = wgid / nig, fm = gid * WGM, gsz = (nM - fm) < WGM ? (nM - fm) : WGM;
        u.pm = fm + ((wgid % nig) % gsz); u.pn = (wgid % nig) / gsz; return true;
    }
    __device__ __forceinline__ void a_ready(const Unit&) const {}
    __device__ __forceinline__ void done(const Unit&) const {}
};
__device__ __forceinline__ unsigned cvt_pk_bf16(float lo, float hi) { unsigned r; asm volatile("v_cvt_pk_bf16_f32 %0, %1, %2" : "=v"(r) : "v"(lo), "v"(hi)); return r; }
typedef float f32x2 __attribute__((ext_vector_type(2)));
template <class Epi, class Sched>
__device__ __forceinline__ void gemm_phase(PG8_LAS unsigned char* lds, const Gemm g, const Sched& S, const Epi& E) {
    int tid_ = threadIdx.x; asm volatile("" : "+v"(tid_)); const int tid = tid_, wid = __builtin_amdgcn_readfirstlane(tid >> 6), lane = tid & 63, wr = wid >> 2, wc = wid & 3, fr = lane & 15, fq = lane >> 4;
    const int K = g.K, nt = K / BK;
    unsigned voffA[2], voffB[2];
#pragma unroll
    for (int i = 0; i < 2; ++i) { int R, C; stage_rc(tid * 16 + i * 8192, R, C); const int Rb = Epi::PERM ? ((R & ~31) + perm32(R & 31)) : R;
        voffA[i] = (unsigned)(R * K + C) * 2u; voffB[i] = (unsigned)(Rb * K + C) * 2u; }
    const size_t kstep = (size_t)(BK * 2);
    const size_t hstep = (size_t)HALF * K * 2;
    const size_t tstep = 2 * hstep;
    const unsigned ldsw = (unsigned)wid * 1024u;
    const int aoff = lds_byte(wr * 64 + fr, fq * 8), boff = lds_byte(wc * 32 + fr, fq * 8);
#define PG8_SA(b, h) (((b) * 2 + (h)) * HTB)
#define PG8_SB(b, h) ((4 + (b) * 2 + (h)) * HTB)
#define PG8_STAGE(bufoff, gbase, voff) do { _Pragma("unroll") for (int _i = 0; _i < 2; ++_i) \
        __builtin_amdgcn_global_load_lds((const unsigned*)((const char*)(gbase) + (voff)[_i]), (PG8_LAS unsigned*)(lds + (bufoff) + ldsw + _i * 8192), 16, 0, 0); } while (0)
#define PG8_LDA(dst, b, h) do { _Pragma("unroll") for (int m = 0; m < 4; ++m) _Pragma("unroll") for (int k = 0; k < 2; ++k) dst[m][k] = *(const PG8_LAS bf16x8*)(lds + PG8_SA(b, h) + aoff + m * 2048 + k * 1024); } while (0)
#define PG8_LDB(dst, b, h) do { _Pragma("unroll") for (int n = 0; n < 2; ++n) _Pragma("unroll") for (int k = 0; k < 2; ++k) dst[n][k] = *(const PG8_LAS bf16x8*)(lds + PG8_SB(b, h) + boff + n * 2048 + k * 1024); } while (0)
#define PG8_MMA(ai, bj, At, Bt) do { __builtin_amdgcn_s_setprio(1); _Pragma("unroll") for (int m = 0; m < 4; ++m) _Pragma("unroll") for (int n = 0; n < 2; ++n) _Pragma("unroll") for (int k = 0; k < 2; ++k) \
        acc[ai][bj][m][n] = __builtin_amdgcn_mfma_f32_16x16x32_bf16(Bt[n][k], At[m][k], acc[ai][bj][m][n], 0, 0, 0); __builtin_amdgcn_s_setprio(0); } while (0)
#define PG8_WAIT_V(n) asm volatile("s_waitcnt vmcnt(" #n ")" ::: "memory")
#define PG8_WAIT_L(n) asm volatile("s_waitcnt lgkmcnt(" #n ")" ::: "memory")
#define PG8_BAR __builtin_amdgcn_s_barrier()
#define PG8_SCHED __builtin_amdgcn_sched_barrier(0)
    Unit cur, nxt; int ui = 0;
    if (!S.next(0, cur)) return;
    f32x4 acc[2][2][4][2];
#pragma unroll
    for (int a = 0; a < 2; ++a)
#pragma unroll
        for (int b = 0; b < 2; ++b)
#pragma unroll
            for (int m = 0; m < 4; ++m)
#pragma unroll
                for (int n = 0; n < 2; ++n) acc[a][b][m][n] = (f32x4){0.f, 0.f, 0.f, 0.f};
    bf16x8 At[4][2], B0[2][2], B1[2][2];
    const char* cA = (const char*)g.A + (size_t)cur.pm * tstep; const char* cB = (const char*)g.Bt + (size_t)cur.pn * tstep;
    S.a_ready(cur);
    PG8_STAGE(PG8_SB(0, 0), cB, voffB); PG8_STAGE(PG8_SA(0, 0), cA, voffA); PG8_STAGE(PG8_SB(0, 1), cB + hstep, voffB); PG8_STAGE(PG8_SA(0, 1), cA + hstep, voffA);
    if (wr == 1) PG8_BAR;
    PG8_WAIT_V(4); PG8_BAR;
    PG8_STAGE(PG8_SB(1, 0), cB + kstep, voffB); PG8_STAGE(PG8_SA(1, 0), cA + kstep, voffA); PG8_STAGE(PG8_SB(1, 1), cB + hstep + kstep, voffB);
    PG8_WAIT_V(6); PG8_BAR;
    for (;;) {
        const bool has_next = S.next(ui + 1, nxt);
        const char* nA = has_next ? (const char*)g.A + (size_t)nxt.pm * tstep : cA; const char* nB = has_next ? (const char*)g.Bt + (size_t)nxt.pn * tstep : cB;
        int t = 0;
#pragma unroll
        for (int seg = 0; seg < (Epi::KHOOK > 0 ? 2 : 1); ++seg) {
        const int tend = (Epi::KHOOK > 0 && seg == 0) ? Epi::KHOOK : nt;
        for (; t < tend; t += 2) {
            const bool last = (t == nt - 2);
            const char* a1 = cA + (size_t)(t + 1) * kstep;
            const char* a2 = last ? nA : cA + (size_t)(t + 2) * kstep; const char* b2 = last ? nB : cB + (size_t)(t + 2) * kstep;
            const char* a3 = a2 + kstep; const char* b3 = b2 + kstep;
            if (last && has_next) S.a_ready(nxt);
            PG8_LDB(B0, 0, 0); PG8_SCHED; PG8_LDA(At, 0, 0); PG8_STAGE(PG8_SA(1, 1), a1 + hstep, voffA);
            PG8_WAIT_L(8); PG8_BAR; PG8_WAIT_L(0); PG8_MMA(0, 0, At, B0); PG8_BAR; PG8_SCHED;
            PG8_LDB(B1, 0, 1); PG8_STAGE(PG8_SB(0, 0), b2, voffB);
            PG8_BAR; PG8_WAIT_L(0); PG8_MMA(0, 1, At, B1); PG8_BAR;
            PG8_LDA(At, 0, 1); PG8_STAGE(PG8_SA(0, 0), a2, voffA);
            PG8_BAR; PG8_WAIT_L(0); PG8_MMA(1, 0, At, B0); PG8_BAR; PG8_SCHED;
            PG8_STAGE(PG8_SB(0, 1), b2 + hstep, voffB);
            PG8_WAIT_V(6); PG8_BAR; PG8_MMA(1, 1, At, B1); PG8_BAR;
            PG8_LDB(B0, 1, 0); PG8_SCHED; PG8_LDA(At, 1, 0); PG8_STAGE(PG8_SA(0, 1), a2 + hstep, voffA);
            PG8_WAIT_L(8); PG8_BAR; PG8_WAIT_L(0); PG8_MMA(0, 0, At, B0); PG8_BAR; PG8_SCHED;
            PG8_LDB(B1, 1, 1); PG8_STAGE(PG8_SB(1, 0), b3, voffB);
            PG8_BAR; PG8_WAIT_L(0); PG8_MMA(0, 1, At, B1); PG8_BAR;
            PG8_LDA(At, 1, 1); PG8_STAGE(PG8_SA(1, 0), a3, voffA);
            PG8_BAR; PG8_WAIT_L(0); PG8_MMA(1, 0, At, B0); PG8_BAR; PG8_SCHED;
            PG8_STAGE(PG8_SB(1, 1), b3 + hstep, voffB);
            PG8_WAIT_V(6); PG8_BAR; PG8_MMA(1, 1, At, B1); PG8_BAR;
        }
        if constexpr (Epi::KHOOK > 0) { if (seg == 0) E.mid(acc, cur, wr, wc, fr, fq); }
        }
        if constexpr (!Epi::AFTER_DRAIN) { E(acc, cur, wr, wc, fr, fq); S.done(cur); }
        if (!has_next) break;
#pragma unroll
        for (int a = 0; a < 2; ++a)
#pragma unroll
            for (int b = 0; b < 2; ++b)
#pragma unroll
                for (int m = 0; m < 4; ++m)
#pragma unroll
                    for (int n = 0; n < 2; ++n) acc[a][b][m][n] = (f32x4){0.f, 0.f, 0.f, 0.f};
        cur = nxt; cA = nA; cB = nB; ++ui;
    }
    PG8_WAIT_V(0);
    if (wr == 0) PG8_BAR;
    PG8_BAR;
    if constexpr (Epi::AFTER_DRAIN) { E.fused(acc, cur, wr, wc, fr, fq, lds, wid, lane); S.done(cur); }
#undef PG8_SA
#undef PG8_SB
#undef PG8_STAGE
#undef PG8_LDA
#undef PG8_LDB
#undef PG8_MMA
#undef PG8_WAIT_V
#undef PG8_WAIT_L
#undef PG8_BAR
#undef PG8_SCHED
}
}

#define LAS __attribute__((address_space(3)))
using pg8::bf16_t; using pg8::bf16x8; using pg8::f32x4; using pg8::u32x4;
typedef unsigned u32x2 __attribute__((ext_vector_type(2)));
typedef float f32x2 __attribute__((ext_vector_type(2)));
typedef short bf16x4 __attribute__((ext_vector_type(4)));

constexpr int DM = 1024, TB = 16384, NPROJ = 11008, DFF = 2816, NUP = 5632;
constexpr int C_QA = 0, C_KA = 1536, C_VA = 3072, C_QD = 4608, C_KD = 5632, C_VD = 6656, C_ZD = 7680, C_GA = 8704, C_GD = 9728, C_AB = 10752;
constexpr float EPSF = 1e-6f;
constexpr int LDS_BYTES = 143360;

constexpr size_t al256(size_t x) { return (x + 255) & ~(size_t)255; }
constexpr size_t WS_CTL = 0;
constexpr size_t WS_MOD = 20480;
constexpr size_t WS_ROPE = WS_MOD + al256((size_t)16 * 6144 * 4);
constexpr size_t WS_WIN = WS_ROPE + (size_t)4096 * 32 * 8;
constexpr size_t WS_WA = WS_WIN + (size_t)NPROJ * 1024 * 2;
constexpr size_t WS_WD = WS_WA + (size_t)1024 * 512 * 2;
constexpr size_t WS_WO = WS_WD + (size_t)1024 * 1024 * 2;
constexpr size_t WS_WUP = WS_WO + (size_t)1024 * 1024 * 2;
constexpr size_t WS_WDN = WS_WUP + (size_t)NUP * 1024 * 2;
constexpr size_t WS_XN = WS_WDN + (size_t)1024 * DFF * 2;
constexpr size_t WS_PROJ = WS_XN + (size_t)TB * 1024 * 2;
constexpr size_t WS_QKVD = WS_PROJ + (size_t)TB * NPROJ * 2;
constexpr size_t WS_TP = WS_QKVD + (size_t)TB * 3072 * 2;
constexpr size_t WS_EG = WS_TP + (size_t)4096 * 16384;
constexpr size_t WS_OD = WS_EG + (size_t)4096 * 512;
constexpr size_t WS_LSE = WS_OD + (size_t)2 * TB * 1024 * 2;
constexpr size_t WS_END = WS_LSE + (size_t)TB * 24 * 4;
static_assert(WS_END <= ((size_t)700 << 20), "workspace");

struct Params {
    const float* x_prompt; const float* x_sample; const float* c_prompt; const float* c_sample;
    const float* w_ada; const float* b_ada; const float* norm1_g; const float* w_in; const float* conv_qkv_w;
    const float* a_log; const float* dt_bias; const float* dn_norm_g; const float* w_br_attn; const float* w_br_dn;
    const float* w_out; const float* norm2_g; const float* w_up; const float* ffn_conv_w; const float* ffn_conv_b;
    const float* w_down; const float* norm_f_g;
    float* out; unsigned char* ws;
    int ph_lo, ph_hi;
};

__constant__ double INVF[32] = {1.0, 0.7498942093324559, 0.5623413251903491, 0.4216965034285822, 0.31622776601683794, 0.23713737056616552, 0.1778279410038923, 0.1333521432163324, 0.1, 0.07498942093324558, 0.05623413251903491, 0.042169650342858224, 0.03162277660168379, 0.023713737056616554, 0.01778279410038923, 0.01333521432163324, 0.01, 0.007498942093324558, 0.005623413251903491, 0.004216965034285823, 0.0031622776601683794, 0.0023713737056616554, 0.0017782794100389228, 0.001333521432163324, 0.001, 0.0007498942093324559, 0.0005623413251903491, 0.00042169650342858224, 0.00031622776601683794, 0.00023713737056616554, 0.00017782794100389227, 0.0001333521432163324};

__device__ __forceinline__ float bf2f(unsigned short b) { return __uint_as_float(((unsigned)b) << 16); }
__device__ __forceinline__ float bflo(unsigned w) { return __uint_as_float(w << 16); }
__device__ __forceinline__ float bfhi(unsigned w) { return __uint_as_float(w & 0xffff0000u); }
__device__ __forceinline__ unsigned pk2(float lo, float hi) { unsigned r; asm("v_cvt_pk_bf16_f32 %0, %1, %2" : "=v"(r) : "v"(lo), "v"(hi)); return r; }
__device__ __forceinline__ unsigned short f2bf(float f) { return (unsigned short)(pk2(f, 0.f) & 0xffffu); }
__device__ __forceinline__ float sigmoidf_(float x) { return 1.0f / (1.0f + __expf(-x)); }
__device__ __forceinline__ float siluf_(float x) { return x / (1.0f + __expf(-x)); }
__device__ __forceinline__ float wave_sum(float v) {
#pragma unroll
    for (int o = 32; o >= 1; o >>= 1) v += __shfl_xor(v, o);
    return v;
}
__device__ __forceinline__ int ltid() { int t = threadIdx.x; asm volatile("" : "+v"(t)); return t; }
struct Batch { int b, L, lgL, nseq; const float* x; float* out; };
__device__ __forceinline__ Batch make_batch(const Params& p, int b) {
    Batch B; B.b = b; B.L = b == 0 ? 2048 : 4096; B.lgL = b == 0 ? 11 : 12; B.nseq = TB >> B.lgL;
    B.x = b == 0 ? p.x_prompt : p.x_sample + (size_t)(b - 1) * TB * DM; B.out = p.out + (size_t)b * TB * DM; return B;
}
__device__ __forceinline__ int cond_index(const Batch& B, int row) { const int s = row >> B.lgL; return B.b == 0 ? s : 8 + (B.b - 1) * 4 + s; }

__device__ __forceinline__ float bf_el8(const u32x4& a, int e) { const unsigned w = a[(e >> 1) & 3]; return (e & 1) ? bfhi(w) : bflo(w); }
__device__ __forceinline__ void transpose_tile(const float* __restrict__ src, int Nsrc, bf16_t* __restrict__ dst, int K, int kt, int nt, int mode, LAS float* T, int koff = 0) {
    const int tid = ltid();
    const int c4 = (tid & 15) * 4, r0 = tid >> 4;
    const int j = nt * 64 + c4; int sj = j;
    if (mode == 1) sj = (j < 8704) ? j : (j < 10752) ? j + 32 : (j < 10784) ? j - 2048 : -1;
    if (mode == 2) { const int pn = j >> 8, jj = j & 255; sj = jj < 128 ? 128 * pn + jj : DFF + 128 * pn + (jj - 128); }
#pragma unroll
    for (int i = 0; i < 2; ++i) {
        const int r = r0 + 32 * i;
        f32x4 v = {0.f, 0.f, 0.f, 0.f};
        if (sj >= 0) v = *(const f32x4*)(src + (size_t)(kt * 64 + r) * Nsrc + sj);
        T[r * 65 + c4 + 0] = v[0]; T[r * 65 + c4 + 1] = v[1]; T[r * 65 + c4 + 2] = v[2]; T[r * 65 + c4 + 3] = v[3];
    }
    __syncthreads();
    const int n = tid >> 3, kp = (tid & 7) * 8;
    u32x4 w;
    w.x = pk2(T[(kp + 0) * 65 + n], T[(kp + 1) * 65 + n]); w.y = pk2(T[(kp + 2) * 65 + n], T[(kp + 3) * 65 + n]);
    w.z = pk2(T[(kp + 4) * 65 + n], T[(kp + 5) * 65 + n]); w.w = pk2(T[(kp + 6) * 65 + n], T[(kp + 7) * 65 + n]);
    *(u32x4*)(dst + (size_t)(nt * 64 + n) * K + koff + kt * 64 + kp) = w;
    __syncthreads();
}

__device__ __forceinline__ void mod_item(const Params& p, int item, LAS unsigned char* L) {
    LAS float* sc = (LAS float*)L;
    LAS float* red = (LAS float*)(L + 65536);
    const int tid = ltid(), lane = tid & 63, wid = tid >> 6;
    for (int e = tid; e < 16384; e += 512) { const int r = e >> 10, k = e & 1023; const float c = r < 8 ? p.c_prompt[r * 1024 + k] : p.c_sample[(r - 8) * 1024 + k]; sc[k * 16 + r] = siluf_(c); }
    __syncthreads();
    const int j = item * 64 + lane;
    float acc[16];
#pragma unroll
    for (int r = 0; r < 16; ++r) acc[r] = 0.f;
    for (int k = wid * 128; k < wid * 128 + 128; ++k) {
        const float w = p.w_ada[(size_t)k * 6144 + j];
#pragma unroll
        for (int q = 0; q < 4; ++q) { const f32x4 s = *(const LAS f32x4*)(sc + k * 16 + 4 * q);
            acc[4 * q + 0] += w * s[0]; acc[4 * q + 1] += w * s[1]; acc[4 * q + 2] += w * s[2]; acc[4 * q + 3] += w * s[3]; }
    }
#pragma unroll
    for (int r = 0; r < 16; ++r) red[(wid * 16 + r) * 64 + lane] = acc[r];
    __syncthreads();
    float* MOD = (float*)(p.ws + WS_MOD);
    for (int e = tid; e < 1024; e += 512) { const int r = e >> 6, l = e & 63; float s = 0.f;
#pragma unroll
        for (int w = 0; w < 8; ++w) s += red[(w * 16 + r) * 64 + l];
        MOD[r * 6144 + item * 64 + l] = s + p.b_ada[item * 64 + l]; }
    __syncthreads();
}

__device__ __forceinline__ void phase0(const Params& p, LAS unsigned char* L) {
    const int G = gridDim.x, bid = blockIdx.x, tid = ltid();
    { f32x2* R = (f32x2*)(p.ws + WS_ROPE);
      for (int e = bid * 512 + tid; e < 4096 * 32; e += G * 512) { const int pos = e >> 5, i = e & 31;
          const double rev = (double)pos * INVF[i] * 0.15915494309189535; const double fr = rev - __builtin_rint(rev);
          f32x2 cs; cs.x = __builtin_amdgcn_cosf((float)fr); cs.y = __builtin_amdgcn_sinf((float)fr); R[e] = cs; } }
    if (bid >= G - 96) mod_item(p, bid - (G - 96), L);
    constexpr int I_IN = 16 * 172, I_A = 8 * 16, I_D = 16 * 16, I_O = 16 * 16, I_UP = 16 * 88, I_DN = 44 * 16;
    constexpr int NIT = I_IN + I_A + I_D + I_O + I_UP + I_DN;
    LAS float* T = (LAS float*)L;
    for (int it = bid; it < NIT; it += G) {
        int r = it;
        if (r < I_IN) { transpose_tile(p.w_in, 10784, (bf16_t*)(p.ws + WS_WIN), 1024, r & 15, r >> 4, 1, T); continue; } r -= I_IN;
        if (r < I_A) { transpose_tile(p.w_br_attn, 1024, (bf16_t*)(p.ws + WS_WA), 1536, r & 7, r >> 3, 0, T, 0); continue; } r -= I_A;
        if (r < I_D) { transpose_tile(p.w_br_dn, 1024, (bf16_t*)(p.ws + WS_WA), 1536, r & 15, r >> 4, 0, T, 512); continue; } r -= I_D;
        if (r < I_O) { transpose_tile(p.w_out, 1024, (bf16_t*)(p.ws + WS_WO), 1024, r & 15, r >> 4, 0, T); continue; } r -= I_O;
        if (r < I_UP) { transpose_tile(p.w_up, NUP, (bf16_t*)(p.ws + WS_WUP), 1024, r & 15, r >> 4, 2, T); continue; } r -= I_UP;
        transpose_tile(p.w_down, 1024, (bf16_t*)(p.ws + WS_WDN), DFF, r % 44, r / 44, 0, T);
    }
}

__device__ __forceinline__ void norm_mod_rows(const Params& p, const Batch& B, const float* __restrict__ xin, const float* __restrict__ g, int sh_off, int sc_off, bf16_t* __restrict__ out) {
    const int lane = ltid() & 63, gw = blockIdx.x * 8 + (ltid() >> 6), NGW = gridDim.x * 8;
    const float* MOD = (const float*)(p.ws + WS_MOD);
    f32x4 gv[4];
#pragma unroll
    for (int i = 0; i < 4; ++i) gv[i] = *(const f32x4*)(g + 4 * lane + 256 * i);
    for (int r = gw; r < TB; r += 2 * NGW) {
        const int r1 = r + NGW; const bool has1 = r1 < TB; const int rb = has1 ? r1 : r;
        const float* xa = xin + (size_t)r * DM; const float* xb = xin + (size_t)rb * DM;
        f32x4 va[4], vb[4]; float sa = 0.f, sb = 0.f;
#pragma unroll
        for (int i = 0; i < 4; ++i) { va[i] = *(const f32x4*)(xa + 4 * lane + 256 * i); vb[i] = *(const f32x4*)(xb + 4 * lane + 256 * i); }
#pragma unroll
        for (int i = 0; i < 4; ++i) { sa += va[i][0] * va[i][0] + va[i][1] * va[i][1] + va[i][2] * va[i][2] + va[i][3] * va[i][3]; sb += vb[i][0] * vb[i][0] + vb[i][1] * vb[i][1] + vb[i][2] * vb[i][2] + vb[i][3] * vb[i][3]; }
        const float rsa = rsqrtf(wave_sum(sa) * (1.0f / DM) + EPSF), rsb = rsqrtf(wave_sum(sb) * (1.0f / DM) + EPSF);
        const float* ma = MOD + (size_t)cond_index(B, r) * 6144; const float* mb = MOD + (size_t)cond_index(B, rb) * 6144;
#pragma unroll
        for (int i = 0; i < 4; ++i) { const f32x4 sc = *(const f32x4*)(ma + sc_off + 4 * lane + 256 * i), sh = *(const f32x4*)(ma + sh_off + 4 * lane + 256 * i);
            const f32x4 y = va[i] * rsa * gv[i] * (sc + 1.0f) + sh; u32x2 w; w.x = pk2(y[0], y[1]); w.y = pk2(y[2], y[3]);
            *(u32x2*)(out + (size_t)r * DM + 4 * lane + 256 * i) = w; }
        if (has1) {
#pragma unroll
            for (int i = 0; i < 4; ++i) { const f32x4 sc = *(const f32x4*)(mb + sc_off + 4 * lane + 256 * i), sh = *(const f32x4*)(mb + sh_off + 4 * lane + 256 * i);
                const f32x4 y = vb[i] * rsb * gv[i] * (sc + 1.0f) + sh; u32x2 w; w.x = pk2(y[0], y[1]); w.y = pk2(y[2], y[3]);
                *(u32x2*)(out + (size_t)r1 * DM + 4 * lane + 256 * i) = w; } }
    }
}
__device__ __forceinline__ void final_norm_rows(float* __restrict__ io, const float* __restrict__ g) {
    const int lane = ltid() & 63, gw = blockIdx.x * 8 + (ltid() >> 6), NGW = gridDim.x * 8;
    f32x4 gv[4];
#pragma unroll
    for (int i = 0; i < 4; ++i) gv[i] = *(const f32x4*)(g + 4 * lane + 256 * i);
    for (int r = gw; r < TB; r += 2 * NGW) {
        const int r1 = r + NGW; const bool has1 = r1 < TB; const int rb = has1 ? r1 : r;
        float* xa = io + (size_t)r * DM; float* xb = io + (size_t)rb * DM; f32x4 va[4], vb[4]; float sa = 0.f, sb = 0.f;
#pragma unroll
        for (int i = 0; i < 4; ++i) { va[i] = *(const f32x4*)(xa + 4 * lane + 256 * i); vb[i] = *(const f32x4*)(xb + 4 * lane + 256 * i); }
#pragma unroll
        for (int i = 0; i < 4; ++i) { sa += va[i][0] * va[i][0] + va[i][1] * va[i][1] + va[i][2] * va[i][2] + va[i][3] * va[i][3]; sb += vb[i][0] * vb[i][0] + vb[i][1] * vb[i][1] + vb[i][2] * vb[i][2] + vb[i][3] * vb[i][3]; }
        const float rsa = rsqrtf(wave_sum(sa) * (1.0f / DM) + EPSF), rsb = rsqrtf(wave_sum(sb) * (1.0f / DM) + EPSF);
#pragma unroll
        for (int i = 0; i < 4; ++i) *(f32x4*)(xa + 4 * lane + 256 * i) = va[i] * rsa * gv[i];
        if (has1) {
#pragma unroll
            for (int i = 0; i < 4; ++i) *(f32x4*)(xb + 4 * lane + 256 * i) = vb[i] * rsb * gv[i]; }
    }
}

struct EpiBf16S {
    static constexpr bool PERM = true, AFTER_DRAIN = false; static constexpr int KHOOK = 0;
    bf16_t* O; int ldc;
    __device__ __forceinline__ void operator()(const f32x4 (&acc)[2][2][4][2], const pg8::Unit& u, int wr, int wc, int fr, int fq) const {
        const int row0 = u.pm * 256 + wr * 64 + fr, col0 = u.pn * 256 + wc * 32 + 8 * fq;
#pragma unroll
        for (int ai = 0; ai < 2; ++ai)
#pragma unroll
            for (int m = 0; m < 4; ++m) { bf16_t* rowp = O + (size_t)(row0 + ai * 128 + m * 16) * ldc + col0;
#pragma unroll
                for (int bj = 0; bj < 2; ++bj) { const f32x4 v0 = acc[ai][bj][m][0], v1 = acc[ai][bj][m][1];
                    u32x4 w; w.x = pk2(v0[0], v0[1]); w.y = pk2(v0[2], v0[3]); w.z = pk2(v1[0], v1[1]); w.w = pk2(v1[2], v1[3]);
                    *(u32x4*)(rowp + bj * 128) = w; } }
    }
};
struct EpiMerge {
    static constexpr bool PERM = true, AFTER_DRAIN = false; static constexpr int KHOOK = 8;
    const bf16_t* ga; const bf16_t* gd; int ldg; bf16_t* O;
    __device__ __forceinline__ void mid(f32x4 (&acc)[2][2][4][2], const pg8::Unit& u, int wr, int wc, int fr, int fq) const {
        const int row0 = u.pm * 256 + wr * 64 + fr, col0 = u.pn * 256 + wc * 32 + 8 * fq;
        size_t ro = (size_t)row0 * ldg + col0;
#pragma unroll
        for (int ai = 0; ai < 2; ++ai) {
#pragma unroll
            for (int m = 0; m < 4; ++m) {
#pragma unroll
                for (int bj = 0; bj < 2; ++bj) { const u32x4 a = *(const u32x4*)(ga + ro + bj * 128), d = *(const u32x4*)(gd + ro + bj * 128);
#pragma unroll
                    for (int q = 0; q < 4; ++q) { const float r0 = (1.0f + __expf(-bflo(d[q]))) * __builtin_amdgcn_rcpf(1.0f + __expf(-bflo(a[q]))), r1 = (1.0f + __expf(-bfhi(d[q]))) * __builtin_amdgcn_rcpf(1.0f + __expf(-bfhi(a[q])));
                        acc[ai][bj][m][q >> 1][2 * (q & 1)] *= r0; acc[ai][bj][m][q >> 1][2 * (q & 1) + 1] *= r1; }
                    asm volatile("" : "+v"(ro) :: "memory"); }
                ro += (size_t)16 * ldg; }
            ro += (size_t)64 * ldg; }
    }
    __device__ __forceinline__ void operator()(const f32x4 (&acc)[2][2][4][2], const pg8::Unit& u, int wr, int wc, int fr, int fq) const {
        const int row0 = u.pm * 256 + wr * 64 + fr, col0 = u.pn * 256 + wc * 32 + 8 * fq;
#pragma unroll
        for (int ai = 0; ai < 2; ++ai)
#pragma unroll
            for (int m = 0; m < 4; ++m) { const int row = row0 + ai * 128 + m * 16;
#pragma unroll
                for (int bj = 0; bj < 2; ++bj) { const u32x4 d = *(const u32x4*)(gd + (size_t)row * ldg + col0 + bj * 128); const f32x4 v0 = acc[ai][bj][m][0], v1 = acc[ai][bj][m][1];
                    u32x4 w; w.x = pk2(v0[0] * sigmoidf_(bflo(d.x)), v0[1] * sigmoidf_(bfhi(d.x))); w.y = pk2(v0[2] * sigmoidf_(bflo(d.y)), v0[3] * sigmoidf_(bfhi(d.y)));
                    w.z = pk2(v1[0] * sigmoidf_(bflo(d.z)), v1[1] * sigmoidf_(bfhi(d.z))); w.w = pk2(v1[2] * sigmoidf_(bflo(d.w)), v1[3] * sigmoidf_(bfhi(d.w)));
                    *(u32x4*)(O + (size_t)row * DM + col0 + bj * 128) = w; }
                asm volatile("" ::: "memory"); }
    }
};
struct OneUnit {
    pg8::Unit u0;
    __device__ __forceinline__ bool next(int i, pg8::Unit& u) const { if (i != 0) return false; u = u0; return true; }
    __device__ __forceinline__ void a_ready(const pg8::Unit&) const {}
    __device__ __forceinline__ void done(const pg8::Unit&) const {}
};
struct EpiConvFfn {
    static constexpr bool PERM = false, AFTER_DRAIN = true; static constexpr int KHOOK = 0;
    bf16_t* ACT; const float* cw; const float* cb; int rowstart, Lseq;
    __device__ __forceinline__ void fused(f32x4 (&acc)[2][2][4][2], const pg8::Unit& u, int wr, int wc, int fr, int fq, LAS unsigned char* lds, int wid, int lane) const {
        LAS bf16_t* T = (LAS bf16_t*)lds;
        LAS float* W = (LAS float*)(lds + 135168);
        const int tid = wid * 64 + lane;
        for (int e = tid; e < 1024; e += 512) { const int k = e >> 7, c = e & 127, cg_ = 128 * u.pn + c; float v;
            if (k < 3) v = cw[k * NUP + cg_]; else if (k < 6) v = cw[(k - 3) * NUP + DFF + cg_]; else if (k == 6) v = cb[cg_]; else v = cb[DFF + cg_];
            W[e] = v; }
#pragma unroll
        for (int ai = 0; ai < 2; ++ai)
#pragma unroll
            for (int m = 0; m < 4; ++m) { const int row = ai * 128 + wr * 64 + m * 16 + fr;
#pragma unroll
                for (int bj = 0; bj < 2; ++bj)
#pragma unroll
                    for (int n = 0; n < 2; ++n) { const int col = bj * 128 + wc * 32 + n * 16 + 4 * fq; const f32x4 v = acc[ai][bj][m][n];
                        u32x2 w; w.x = pk2(v[0], v[1]); w.y = pk2(v[2], v[3]); *(LAS u32x2*)(T + row * 264 + col) = w; } }
        __syncthreads();
        const u32x4 z4 = {0u, 0u, 0u, 0u};
#pragma unroll 1
        for (int i = 0; i < 8; ++i) { const int t = tid + 512 * i; if (t >= 4064) break;
            const int r = 1 + (t >> 4), c8 = (t & 15) * 8, grow = rowstart + r; if (grow < 0 || grow >= TB) continue;
            const int s_ = grow & (Lseq - 1);
            const LAS bf16_t* tp = T + r * 264 + c8;
            u32x4 vp = *(const LAS u32x4*)(tp - 264), vc = *(const LAS u32x4*)tp, vn = *(const LAS u32x4*)(tp + 264);
            u32x4 gp = *(const LAS u32x4*)(tp - 264 + 128), gc = *(const LAS u32x4*)(tp + 128), gn = *(const LAS u32x4*)(tp + 264 + 128);
            if (s_ == 0) { vp = z4; gp = z4; }
            if (s_ == Lseq - 1) { vn = z4; gn = z4; }
            float o[8];
#pragma unroll
            for (int q = 0; q < 2; ++q) { const f32x4 wv0 = *(const LAS f32x4*)(W + c8 + 4 * q), wv1 = *(const LAS f32x4*)(W + 128 + c8 + 4 * q), wv2 = *(const LAS f32x4*)(W + 256 + c8 + 4 * q);
                const f32x4 wg0 = *(const LAS f32x4*)(W + 384 + c8 + 4 * q), wg1 = *(const LAS f32x4*)(W + 512 + c8 + 4 * q), wg2 = *(const LAS f32x4*)(W + 640 + c8 + 4 * q);
                const f32x4 bv = *(const LAS f32x4*)(W + 768 + c8 + 4 * q), bg = *(const LAS f32x4*)(W + 896 + c8 + 4 * q);
#pragma unroll
                for (int k = 0; k < 4; ++k) { const int e = 4 * q + k;
                    const float val = bf_el8(vp, e) * wv0[k] + bf_el8(vc, e) * wv1[k] + bf_el8(vn, e) * wv2[k] + bv[k];
                    const float gt = bf_el8(gp, e) * wg0[k] + bf_el8(gc, e) * wg1[k] + bf_el8(gn, e) * wg2[k] + bg[k];
                    o[e] = siluf_(gt) * val; } }
            u32x4 w; w.x = pk2(o[0], o[1]); w.y = pk2(o[2], o[3]); w.z = pk2(o[4], o[5]); w.w = pk2(o[6], o[7]);
            *(u32x4*)(ACT + (size_t)grow * DFF + 128 * u.pn + c8) = w; }
        __syncthreads();
    }
};
struct EpiResid {
    static constexpr bool PERM = false, AFTER_DRAIN = false; static constexpr int KHOOK = 0;
    const float* xin; float* out; const float* gt; int lgL, cbase;
    __device__ __forceinline__ void operator()(const f32x4 (&acc)[2][2][4][2], const pg8::Unit& u, int wr, int wc, int fr, int fq) const {
        const int row0 = u.pm * 256 + wr * 64 + fr, col0 = u.pn * 256 + wc * 32 + 4 * fq;
#pragma unroll
        for (int ai = 0; ai < 2; ++ai)
#pragma unroll
            for (int m = 0; m < 4; ++m) { const int row = row0 + ai * 128 + m * 16; const float* gr = gt + (size_t)(cbase + (row >> lgL)) * 6144;
#pragma unroll
                for (int bj = 0; bj < 2; ++bj)
#pragma unroll
                    for (int n = 0; n < 2; ++n) { const int col = col0 + bj * 128 + n * 16;
                        const f32x4 xv = *(const f32x4*)(xin + (size_t)row * DM + col), gv = *(const f32x4*)(gr + col);
                        *(f32x4*)(out + (size_t)row * DM + col) = xv + gv * acc[ai][bj][m][n]; } }
    }
};

__device__ __forceinline__ bf16x8 permfrag_sw(const LAS bf16_t* base, int row, int stride, int kbase, int g, int sw) {
    const u32x2 lo = *(const LAS u32x2*)(base + row * stride + ((kbase + 4 * g) ^ sw)), hi = *(const LAS u32x2*)(base + row * stride + ((kbase + 16 + 4 * g) ^ sw));
    u32x4 w; w.x = lo.x; w.y = lo.y; w.z = hi.x; w.w = hi.y; return __builtin_bit_cast(bf16x8, w);
}
#define MFMA16(a, b, c) __builtin_amdgcn_mfma_f32_16x16x32_bf16((a), (b), (c), 0, 0, 0)
__device__ __forceinline__ float bf_el(const u32x4& a, const u32x4& b, int e) { const unsigned w = (e < 8) ? a[(e >> 1) & 3] : b[(e >> 1) & 3]; return (e & 1) ? bfhi(w) : bflo(w); }

__device__ __forceinline__ void prep_item(const Params& p, const Batch& B, int item, LAS unsigned char* L) {
    const int tid = ltid(), lane = tid & 63, wid = tid >> 6, g = lane >> 4, fr = lane & 15;
    const int NC = B.L >> 6;
    const int hp = item & 3, sn = item >> 2, n = sn & (NC - 1), seq = sn >> (B.lgL - 6);
    const int r0 = seq * B.L + n * 64;
    LAS bf16_t* KS = (LAS bf16_t*)L;
    LAS bf16_t* QS = (LAS bf16_t*)(L + 34816);
    LAS float* AA = (LAS float*)L;
    LAS float* KK = (LAS float*)(L + 69632);
    LAS float* QK = (LAS float*)(L + 102912);
    LAS float* GS = (LAS float*)(L + 136192);
    const bf16_t* PROJ = (const bf16_t*)(p.ws + WS_PROJ);
    bf16_t* QKVD = (bf16_t*)(p.ws + WS_QKVD);
    LAS float* CW = (LAS float*)(L + 69632);
    for (int e = tid; e < 2304; e += 512) { const int hh = e / 1152, rem = e - hh * 1152, mat = rem / 384, rem2 = rem - mat * 384, tap = rem2 >> 7, c = rem2 & 127;
        CW[e] = p.conv_qkv_w[tap * 3072 + mat * 1024 + (hp * 2 + hh) * 128 + c]; }
    float al_pre = 0.f, be_pre = 0.f;
    if (wid < 4) { const int hh = wid >> 1, dir = wid & 1, h = hp * 2 + hh; const int c = dir ? 63 - lane : lane; const int row = r0 + c;
        al_pre = bf2f(PROJ[(size_t)row * NPROJ + C_AB + dir * 8 + h]); be_pre = bf2f(PROJ[(size_t)row * NPROJ + C_AB + 16 + dir * 8 + h]); }
    __syncthreads();
    {
        const int r = tid >> 3, pc = (tid & 7) * 16; const int row = r0 + r; const int s = n * 64 + r;
        const bool hasp = s > 0, hasn = s < B.L - 1;
        const u32x4 z4 = {0u, 0u, 0u, 0u};
#pragma unroll
        for (int hh = 0; hh < 2; ++hh) {
            const int h = hp * 2 + hh;
            u32x4 xc[3][2], xp[3][2], xn[3][2];
#pragma unroll
            for (int mat = 0; mat < 3; ++mat) { const bf16_t* src = PROJ + (size_t)row * NPROJ + C_QD + mat * 1024 + h * 128 + pc;
                xc[mat][0] = *(const u32x4*)src; xc[mat][1] = *(const u32x4*)(src + 8); xp[mat][0] = z4; xp[mat][1] = z4; xn[mat][0] = z4; xn[mat][1] = z4;
                if (hasp) { xp[mat][0] = *(const u32x4*)(src - NPROJ); xp[mat][1] = *(const u32x4*)(src - NPROJ + 8); }
                if (hasn) { xn[mat][0] = *(const u32x4*)(src + NPROJ); xn[mat][1] = *(const u32x4*)(src + NPROJ + 8); } }
#pragma unroll
            for (int mat = 0; mat < 3; ++mat) {
                const int col = mat * 1024 + h * 128 + pc;
                const LAS float* cw = CW + (hh * 3 + mat) * 384 + pc;
                float y[16]; float ss = 0.f;
#pragma unroll
                for (int q = 0; q < 4; ++q) {
                    const f32x4 w0 = *(const LAS f32x4*)(cw + 4 * q), w1 = *(const LAS f32x4*)(cw + 128 + 4 * q), w2 = *(const LAS f32x4*)(cw + 256 + 4 * q);
#pragma unroll
                    for (int e = 0; e < 4; ++e) { const int ee = 4 * q + e;
                        float v = bf_el(xp[mat][0], xp[mat][1], ee) * w0[e] + bf_el(xc[mat][0], xc[mat][1], ee) * w1[e] + bf_el(xn[mat][0], xn[mat][1], ee) * w2[e];
                        v = siluf_(v); y[ee] = v; ss += v * v; }
                }
                if (mat < 2) {
                    ss += __shfl_xor(ss, 1); ss += __shfl_xor(ss, 2); ss += __shfl_xor(ss, 4);
                    float sc = rsqrtf(ss + EPSF); if (mat == 0) sc *= 0.08838834764831845f;
#pragma unroll
                    for (int e = 0; e < 16; ++e) y[e] *= sc;
                }
                u32x4 o0, o1;
                o0.x = pk2(y[0], y[1]); o0.y = pk2(y[2], y[3]); o0.z = pk2(y[4], y[5]); o0.w = pk2(y[6], y[7]);
                o1.x = pk2(y[8], y[9]); o1.y = pk2(y[10], y[11]); o1.z = pk2(y[12], y[13]); o1.w = pk2(y[14], y[15]);
                bf16_t* dst = QKVD + (size_t)row * 3072 + col;
                *(u32x4*)dst = o0; *(u32x4*)(dst + 8) = o1;
                if (mat == 0) { *(LAS u32x4*)(QS + (hh * 64 + r) * 136 + pc) = o0; *(LAS u32x4*)(QS + (hh * 64 + r) * 136 + pc + 8) = o1; }
                if (mat == 1) { *(LAS u32x4*)(KS + (hh * 64 + r) * 136 + pc) = o0; *(LAS u32x4*)(KS + (hh * 64 + r) * 136 + pc + 8) = o1; }
            }
        }
    }
    __syncthreads();
    {
        const int hh = wid >> 2, ct = wid & 3; const LAS bf16_t* Kh = KS + hh * 64 * 136; const LAS bf16_t* Qh = QS + hh * 64 * 136;
        bf16x8 ak[4], aq[4];
#pragma unroll
        for (int ks = 0; ks < 4; ++ks) { ak[ks] = *(const LAS bf16x8*)(Kh + (16 * ct + fr) * 136 + 32 * ks + 8 * g); aq[ks] = *(const LAS bf16x8*)(Qh + (16 * ct + fr) * 136 + 32 * ks + 8 * g); }
#pragma unroll
        for (int dt = 0; dt < 4; ++dt) {
            f32x4 c0 = {0.f, 0.f, 0.f, 0.f}, c1 = {0.f, 0.f, 0.f, 0.f};
#pragma unroll
            for (int ks = 0; ks < 4; ++ks) { const bf16x8 b = *(const LAS bf16x8*)(Kh + (16 * dt + fr) * 136 + 32 * ks + 8 * g); c0 = MFMA16(ak[ks], b, c0); c1 = MFMA16(aq[ks], b, c1); }
#pragma unroll
            for (int j = 0; j < 4; ++j) { KK[hh * 4160 + (16 * ct + 4 * g + j) * 65 + 16 * dt + fr] = c0[j]; QK[hh * 4160 + (16 * ct + 4 * g + j) * 65 + 16 * dt + fr] = c1[j]; }
        }
    }
    if (wid < 4) {
        const int hh = wid >> 1, dir = wid & 1, h = hp * 2 + hh; const int c = dir ? 63 - lane : lane; const int row = r0 + c;
        const float al = al_pre, be = be_pre; (void)row;
        const float xx = al + p.dt_bias[dir * 8 + h]; const float sp = fmaxf(xx, 0.f) + log1pf(__expf(-fabsf(xx)));
        float G = -__expf(p.a_log[dir * 8 + h]) * sp;
#pragma unroll
        for (int o = 1; o < 64; o <<= 1) { const float t = __shfl_up(G, o); if (lane >= o) G += t; }
        const float G63 = __shfl(G, 63);
        GS[wid * 128 + lane] = G; GS[wid * 128 + 64 + lane] = sigmoidf_(be);
        const int np = dir ? NC - 1 - n : n; const size_t cid = ((size_t)((seq * 2 + dir) * 8 + h)) * NC + np;
        float* EG = (float*)(p.ws + WS_EG) + cid * 128; EG[lane] = __expf(G); EG[64 + lane] = __expf(G63 - G);
    }
    __syncthreads();
    for (int e = tid; e < 16384; e += 512) { const int sv = e >> 12, hh = sv >> 1, dir = sv & 1, j = (e >> 6) & 63, i = e & 63; float a = 0.f;
        if (i > j) { const int ci = dir ? 63 - i : i, cj = dir ? 63 - j : j; a = GS[sv * 128 + 64 + i] * KK[hh * 4160 + ci * 65 + cj] * __expf(GS[sv * 128 + i] - GS[sv * 128 + j]); }
        AA[(sv * 64 + j) * 68 + i] = a; }
    __syncthreads();
    if (wid < 4) {
        const int sv = wid, hh = sv >> 1, dir = sv & 1, h = hp * 2 + hh; const LAS float* Ad = AA + sv * 64 * 68;
        float acc[64];
#pragma unroll
        for (int i = 0; i < 64; ++i) acc[i] = (lane == i) ? 1.f : 0.f;
#pragma unroll
        for (int j = 0; j < 63; ++j) { const float tj = acc[j];
#pragma unroll
            for (int i4 = ((j + 1) & ~3); i4 < 64; i4 += 4) { const f32x4 a = *(const LAS f32x4*)(Ad + j * 68 + i4);
#pragma unroll
                for (int e = 0; e < 4; ++e) if (i4 + e > j) acc[i4 + e] -= a[e] * tj; } }
        const int np = dir ? NC - 1 - n : n; const size_t cid = ((size_t)((seq * 2 + dir) * 8 + h)) * NC + np;
        bf16_t* Tg = (bf16_t*)(p.ws + WS_TP) + cid * 8192; const float bl = GS[sv * 128 + 64 + lane];
#pragma unroll
        for (int i = 0; i < 64; ++i) Tg[i * 64 + lane] = f2bf(acc[i] * bl);
    } else {
        bf16_t* TPg = (bf16_t*)(p.ws + WS_TP);
        for (int t = tid - 256; t < 2048; t += 256) { const int sv = t >> 9, hh = sv >> 1, dir = sv & 1, h = hp * 2 + hh, i = (t >> 3) & 63, j0 = (t & 7) * 8;
            const int np = dir ? NC - 1 - n : n; const size_t cid = ((size_t)((seq * 2 + dir) * 8 + h)) * NC + np;
            float v[8]; const int ci = dir ? 63 - i : i; const float Gi = GS[sv * 128 + i];
#pragma unroll
            for (int e = 0; e < 8; ++e) { const int j = j0 + e, cj = dir ? 63 - j : j; v[e] = (i >= j) ? QK[hh * 4160 + ci * 65 + cj] * __expf(Gi - GS[sv * 128 + j]) : 0.f; }
            u32x4 w; w.x = pk2(v[0], v[1]); w.y = pk2(v[2], v[3]); w.z = pk2(v[4], v[5]); w.w = pk2(v[6], v[7]);
            *(u32x4*)(TPg + cid * 8192 + 4096 + i * 64 + j0) = w; }
    }
    __syncthreads();
}

__device__ __forceinline__ bf16x8 pack8(const f32x4& a, const f32x4& b) { u32x4 w; w.x = pk2(a[0], a[1]); w.y = pk2(a[2], a[3]); w.z = pk2(b[0], b[1]); w.w = pk2(b[2], b[3]); return __builtin_bit_cast(bf16x8, w); }
__device__ __forceinline__ bf16x8 permfrag(const LAS bf16_t* base, int row, int stride, int kbase, int g) {
    const u32x2 lo = *(const LAS u32x2*)(base + row * stride + kbase + 4 * g), hi = *(const LAS u32x2*)(base + row * stride + kbase + 16 + 4 * g);
    u32x4 w; w.x = lo.x; w.y = lo.y; w.z = hi.x; w.w = hi.y; return __builtin_bit_cast(bf16x8, w);
}

__device__ __forceinline__ void scan_chain(const Params& p, const Batch& B, int chain, int vs, int lgVS, LAS unsigned char* L) {
    const int tid = ltid(), lane = tid & 63, wid = tid >> 6, g = lane >> 4, fr = lane & 15;
    const int NC = B.L >> 6;
    const int h = chain & 7, dir = (chain >> 3) & 1, seq = chain >> 4;
    LAS bf16_t* KS = (LAS bf16_t*)L;
    LAS bf16_t* KT = (LAS bf16_t*)(L + 17408);
    LAS bf16_t* QS = (LAS bf16_t*)(L + 35840);
    LAS bf16_t* VS = (LAS bf16_t*)(L + 53248);
    LAS bf16_t* TS = (LAS bf16_t*)(L + 70656);
    LAS bf16_t* PS = (LAS bf16_t*)(L + 79872);
    LAS float* EGS = (LAS float*)(L + 89088);
    LAS bf16_t* OS = (LAS bf16_t*)(L + 89600);
    const bf16_t* QKVD = (const bf16_t*)(p.ws + WS_QKVD);
    const bf16_t* TPg = (const bf16_t*)(p.ws + WS_TP);
    const float* EGg = (const float*)(p.ws + WS_EG);
    bf16_t* OD = (bf16_t*)(p.ws + WS_OD) + (size_t)dir * TB * 1024;
    const size_t cid0 = ((size_t)((seq * 2 + dir) * 8 + h)) * NC;
    const int cp = tid >> 3, pc = tid & 7;
    u32x4 rq0, rq1, rk0, rk1, rv0, rv1, rt, rp; float reg_eg = 0.f;
#define SC_LOAD(np_) do { const int tok_ = dir ? (B.L - 1 - ((np_) * 64 + cp)) : ((np_) * 64 + cp); const bf16_t* src_ = QKVD + (size_t)(seq * B.L + tok_) * 3072 + h * 128 + 16 * pc; \
        rq0 = *(const u32x4*)src_; rq1 = *(const u32x4*)(src_ + 8); rk0 = *(const u32x4*)(src_ + 1024); rk1 = *(const u32x4*)(src_ + 1032); rv0 = *(const u32x4*)(src_ + 2048); rv1 = *(const u32x4*)(src_ + 2056); \
        const bf16_t* tp_ = TPg + (cid0 + (np_)) * 8192 + cp * 64 + 8 * pc; rt = *(const u32x4*)tp_; rp = *(const u32x4*)(tp_ + 4096); \
        if (tid < 128) reg_eg = EGg[(cid0 + (np_)) * 128 + tid]; } while (0)
    if (__builtin_amdgcn_readfirstlane(wid) < (8 >> lgVS)) {
    f32x4 S[8];
#pragma unroll
    for (int i = 0; i < 8; ++i) S[i] = (f32x4){0.f, 0.f, 0.f, 0.f};
    SC_LOAD(0);
    for (int np = 0; np < NC; ++np) {
        *(LAS u32x4*)(QS + cp * 136 + 16 * pc) = rq0; *(LAS u32x4*)(QS + cp * 136 + 16 * pc + 8) = rq1;
        *(LAS u32x4*)(KS + cp * 136 + 16 * pc) = rk0; *(LAS u32x4*)(KS + cp * 136 + 16 * pc + 8) = rk1;
        *(LAS u32x4*)(VS + cp * 136 + 16 * pc) = rv0; *(LAS u32x4*)(VS + cp * 136 + 16 * pc + 8) = rv1;
        *(LAS u32x4*)(TS + cp * 72 + 8 * pc) = rt; *(LAS u32x4*)(PS + cp * 72 + 8 * pc) = rp;
#pragma unroll
        for (int e = 0; e < 8; ++e) { const unsigned w0 = rk0[e >> 1], w1 = rk1[e >> 1];
            KT[(16 * pc + e) * 72 + cp] = (bf16_t)((e & 1) ? (w0 >> 16) : (w0 & 0xffffu));
            KT[(16 * pc + 8 + e) * 72 + cp] = (bf16_t)((e & 1) ? (w1 >> 16) : (w1 & 0xffffu)); }
        if (tid < 128) EGS[tid] = reg_eg;
        __syncthreads();
        if (np + 1 < NC) SC_LOAD(np + 1);
        if (np > 0 && (pc >> (3 - lgVS)) == vs) { const LAS bf16_t* os = OS + ((np - 1) & 1) * 8704 + cp * 136 + 16 * pc; const u32x4 o0 = *(const LAS u32x4*)os, o1 = *(const LAS u32x4*)(os + 8);
            const int c_ = (np - 1) * 64 + cp; const int tok_ = dir ? (B.L - 1 - c_) : c_; bf16_t* dst = OD + (size_t)(seq * B.L + tok_) * 1024 + h * 128 + 16 * pc;
            *(u32x4*)dst = o0; *(u32x4*)(dst + 8) = o1; }
        const int vcol = vs * (128 >> lgVS) + 16 * wid;
#define SCHED_FENCE() __builtin_amdgcn_sched_barrier(0)
        bf16x8 Sb[4];
#pragma unroll
        for (int ks = 0; ks < 4; ++ks) Sb[ks] = pack8(S[2 * ks], S[2 * ks + 1]);
        f32x4 X[4], Q[4];
#pragma unroll
        for (int ct = 0; ct < 4; ++ct) { X[ct] = (f32x4){0.f, 0.f, 0.f, 0.f}; Q[ct] = (f32x4){0.f, 0.f, 0.f, 0.f}; }
        bf16x8 fk[2][4], fq[2][4], ft[2][4];
#pragma unroll
        for (int ct = 0; ct < 4; ++ct) { fk[0][ct] = permfrag(KS, 16 * ct + fr, 136, 0, g); fq[0][ct] = permfrag(QS, 16 * ct + fr, 136, 0, g); }
        SCHED_FENCE();
#pragma unroll
        for (int ks = 0; ks < 4; ++ks) {
            if (ks < 3) {
#pragma unroll
                for (int ct = 0; ct < 4; ++ct) { fk[(ks + 1) & 1][ct] = permfrag(KS, 16 * ct + fr, 136, 32 * (ks + 1), g); fq[(ks + 1) & 1][ct] = permfrag(QS, 16 * ct + fr, 136, 32 * (ks + 1), g); }
            } else {
#pragma unroll
                for (int ct = 0; ct < 4; ++ct) { ft[0][ct] = permfrag(TS, 16 * ct + fr, 72, 0, g); ft[1][ct] = permfrag(TS, 16 * ct + fr, 72, 32, g); }
            }
            SCHED_FENCE();
#pragma unroll
            for (int ct = 0; ct < 4; ++ct) { X[ct] = MFMA16(fk[ks & 1][ct], Sb[ks], X[ct]); Q[ct] = MFMA16(fq[ks & 1][ct], Sb[ks], Q[ct]); }
            SCHED_FENCE();
        }
        f32x4 EGv[4], R[4];
#pragma unroll
        for (int ct = 0; ct < 4; ++ct) { EGv[ct] = *(const LAS f32x4*)(EGS + 16 * ct + 4 * g);
#pragma unroll
            for (int j = 0; j < 4; ++j) { const unsigned w = *(const LAS unsigned*)(VS + (16 * ct + 4 * g + j) * 136 + vcol + (fr & ~1)); R[ct][j] = (fr & 1) ? bfhi(w) : bflo(w); } }
        bf16x8 fp[2][4];
#pragma unroll
        for (int ct = 0; ct < 4; ++ct) { fp[0][ct] = permfrag(PS, 16 * ct + fr, 72, 0, g); fp[1][ct] = permfrag(PS, 16 * ct + fr, 72, 32, g); }
        SCHED_FENCE();
#pragma unroll
        for (int ct = 0; ct < 4; ++ct) R[ct] = R[ct] - EGv[ct] * X[ct];
        bf16x8 Rb[2]; Rb[0] = pack8(R[0], R[1]); Rb[1] = pack8(R[2], R[3]);
        f32x4 Vn[4];
#pragma unroll
        for (int ct = 0; ct < 4; ++ct) Vn[ct] = (f32x4){0.f, 0.f, 0.f, 0.f};
#pragma unroll
        for (int k2 = 0; k2 < 2; ++k2)
#pragma unroll
            for (int ct = 0; ct < 4; ++ct) Vn[ct] = MFMA16(ft[k2][ct], Rb[k2], Vn[ct]);
        bf16x8 fkt[2][8];
#pragma unroll
        for (int i = 0; i < 8; ++i) fkt[0][i] = permfrag(KT, 16 * i + fr, 72, 0, g);
        SCHED_FENCE();
        bf16x8 Vb[2]; Vb[0] = pack8(Vn[0], Vn[1]); Vb[1] = pack8(Vn[2], Vn[3]);
        f32x4 O[4];
#pragma unroll
        for (int ct = 0; ct < 4; ++ct) O[ct] = EGv[ct] * Q[ct];
#pragma unroll
        for (int k2 = 0; k2 < 2; ++k2)
#pragma unroll
            for (int ct = 0; ct < 4; ++ct) O[ct] = MFMA16(fp[k2][ct], Vb[k2], O[ct]);
#pragma unroll
        for (int i = 0; i < 8; ++i) fkt[1][i] = permfrag(KT, 16 * i + fr, 72, 32, g);
        SCHED_FENCE();
#pragma unroll
        for (int ct = 0; ct < 4; ++ct) { const f32x4 egd = *(const LAS f32x4*)(EGS + 64 + 16 * ct + 4 * g); Vn[ct] = Vn[ct] * egd; }
        Vb[0] = pack8(Vn[0], Vn[1]); Vb[1] = pack8(Vn[2], Vn[3]);
        const float egl = EGS[63];
#pragma unroll
        for (int i = 0; i < 8; ++i) S[i] = S[i] * egl;
#pragma unroll
        for (int k2 = 0; k2 < 2; ++k2)
#pragma unroll
            for (int i = 0; i < 8; ++i) S[i] = MFMA16(fkt[k2][i], Vb[k2], S[i]);
#pragma unroll
        for (int ct = 0; ct < 4; ++ct)
#pragma unroll
            for (int j = 0; j < 4; ++j) OS[(np & 1) * 8704 + (16 * ct + 4 * g + j) * 136 + vcol + fr] = f2bf(O[ct][j]);
#undef SCHED_FENCE
        __syncthreads();
    }
    } else {
    SC_LOAD(0);
    for (int np = 0; np < NC; ++np) {
        *(LAS u32x4*)(QS + cp * 136 + 16 * pc) = rq0; *(LAS u32x4*)(QS + cp * 136 + 16 * pc + 8) = rq1;
        *(LAS u32x4*)(KS + cp * 136 + 16 * pc) = rk0; *(LAS u32x4*)(KS + cp * 136 + 16 * pc + 8) = rk1;
        *(LAS u32x4*)(VS + cp * 136 + 16 * pc) = rv0; *(LAS u32x4*)(VS + cp * 136 + 16 * pc + 8) = rv1;
        *(LAS u32x4*)(TS + cp * 72 + 8 * pc) = rt; *(LAS u32x4*)(PS + cp * 72 + 8 * pc) = rp;
#pragma unroll
        for (int e = 0; e < 8; ++e) { const unsigned w0 = rk0[e >> 1], w1 = rk1[e >> 1];
            KT[(16 * pc + e) * 72 + cp] = (bf16_t)((e & 1) ? (w0 >> 16) : (w0 & 0xffffu));
            KT[(16 * pc + 8 + e) * 72 + cp] = (bf16_t)((e & 1) ? (w1 >> 16) : (w1 & 0xffffu)); }
        if (tid < 128) EGS[tid] = reg_eg;
        __syncthreads();
        if (np + 1 < NC) SC_LOAD(np + 1);
        if (np > 0 && (pc >> (3 - lgVS)) == vs) { const LAS bf16_t* os = OS + ((np - 1) & 1) * 8704 + cp * 136 + 16 * pc; const u32x4 o0 = *(const LAS u32x4*)os, o1 = *(const LAS u32x4*)(os + 8);
            const int c_ = (np - 1) * 64 + cp; const int tok_ = dir ? (B.L - 1 - c_) : c_; bf16_t* dst = OD + (size_t)(seq * B.L + tok_) * 1024 + h * 128 + 16 * pc;
            *(u32x4*)dst = o0; *(u32x4*)(dst + 8) = o1; }
        __syncthreads();
    }
    }
    if ((pc >> (3 - lgVS)) == vs) { const LAS bf16_t* os = OS + ((NC - 1) & 1) * 8704 + cp * 136 + 16 * pc; const u32x4 o0 = *(const LAS u32x4*)os, o1 = *(const LAS u32x4*)(os + 8);
      const int c_ = (NC - 1) * 64 + cp; const int tok_ = dir ? (B.L - 1 - c_) : c_; bf16_t* dst = OD + (size_t)(seq * B.L + tok_) * 1024 + h * 128 + 16 * pc;
      *(u32x4*)dst = o0; *(u32x4*)(dst + 8) = o1; }
    __syncthreads();
#undef SC_LOAD
}

__device__ __forceinline__ void attn_item(const Params& p, const Batch& B, int item, LAS unsigned char* L) {
    const int tid = ltid(), lane = tid & 63, wid = tid >> 6, g = lane >> 4, fr = lane & 15;
    const int lgper = B.lgL - 7;
    const int x = item & ((1 << lgper) - 1), sgh = item >> lgper, h = sgh & 7, sg = sgh >> 3, grp = sg % 3, seq = sg / 3;
    const int lgd = 2 * grp, r = x & ((1 << lgd) - 1), pb = x >> lgd, Lr = B.L >> lgd;
    const int mq0 = pb * 128, mk0 = mq0 - 64, hcol = (grp * 8 + h) * 64;
    LAS bf16_t* KL = (LAS bf16_t*)L;
    LAS bf16_t* VT = (LAS bf16_t*)(L + 36864);
    bf16_t* PROJ = (bf16_t*)(p.ws + WS_PROJ);
    const f32x2* ROPE = (const f32x2*)(p.ws + WS_ROPE);
    const size_t rowbase = (size_t)seq * B.L;
    const u32x4 z4 = {0u, 0u, 0u, 0u};
    const int mq = mq0 + 16 * wid + fr, sq = (mq << lgd) + r;
    bf16_t* qptr = PROJ + (rowbase + sq) * NPROJ + C_QA + hcol;
    const u32x4 qa = *(const u32x4*)(qptr + 8 * g), qb = *(const u32x4*)(qptr + 32 + 8 * g);
    f32x4 qcs[4];
    { const f32x4* rp = (const f32x4*)(ROPE + (size_t)sq * 32 + 8 * g);
#pragma unroll
      for (int q = 0; q < 4; ++q) qcs[q] = rp[q]; }
    u32x4 ka[2], kb[2]; f32x4 kcs[2][4]; u32x4 va[4];
#pragma unroll
    for (int i = 0; i < 2; ++i) { const int t = tid + 512 * i, kk = t >> 2, pp = t & 3, m = mk0 + kk; ka[i] = z4; kb[i] = z4;
#pragma unroll
        for (int q = 0; q < 4; ++q) kcs[i][q] = (f32x4){0.f, 0.f, 0.f, 0.f};
        if (m >= 0 && m < Lr) { const int s = (m << lgd) + r; const bf16_t* src = PROJ + (rowbase + s) * NPROJ + C_KA + hcol + 8 * pp;
            ka[i] = *(const u32x4*)src; kb[i] = *(const u32x4*)(src + 32); const f32x4* rp = (const f32x4*)(ROPE + (size_t)s * 32 + 8 * pp);
#pragma unroll
            for (int q = 0; q < 4; ++q) kcs[i][q] = rp[q]; } }
#pragma unroll
    for (int i = 0; i < 4; ++i) { const int kk = tid & 255, p8 = (tid >> 8) + 2 * i, m = mk0 + kk; va[i] = z4;
        if (m >= 0 && m < Lr) { const int s = (m << lgd) + r; va[i] = *(const u32x4*)(PROJ + (rowbase + s) * NPROJ + C_VA + hcol + 8 * p8); } }
#pragma unroll
    for (int i = 0; i < 2; ++i) { const int t = tid + 512 * i, kk = t >> 2, pp = t & 3; u32x4 lo, hi;
#pragma unroll
        for (int q = 0; q < 4; ++q) { const f32x4 cs = kcs[i][q]; const float x1a = bflo(ka[i][q]), x1b = bfhi(ka[i][q]), x2a = bflo(kb[i][q]), x2b = bfhi(kb[i][q]);
            lo[q] = pk2(x1a * cs[0] - x2a * cs[1], x1b * cs[2] - x2b * cs[3]); hi[q] = pk2(x2a * cs[0] + x1a * cs[1], x2b * cs[2] + x1b * cs[3]); }
        *(LAS u32x4*)(KL + kk * 72 + 8 * pp) = lo; *(LAS u32x4*)(KL + kk * 72 + 32 + 8 * pp) = hi; }
#pragma unroll
    for (int i = 0; i < 4; ++i) { const int kk = tid & 255, p8 = (tid >> 8) + 2 * i;
#pragma unroll
        for (int e = 0; e < 8; ++e) { const unsigned w = va[i][e >> 1]; VT[(8 * p8 + e) * 264 + kk] = (bf16_t)((e & 1) ? (w >> 16) : (w & 0xffffu)); } }
    __syncthreads();
    {
        u32x4 lo, hi;
#pragma unroll
        for (int q = 0; q < 4; ++q) { const f32x4 cs = qcs[q] * 0.125f; const float x1a = bflo(qa[q]), x1b = bfhi(qa[q]), x2a = bflo(qb[q]), x2b = bfhi(qb[q]);
            lo[q] = pk2(x1a * cs[0] - x2a * cs[1], x1b * cs[2] - x2b * cs[3]); hi[q] = pk2(x2a * cs[0] + x1a * cs[1], x2b * cs[2] + x1b * cs[3]); }
        bf16x8 qf[2]; qf[0] = __builtin_bit_cast(bf16x8, lo); qf[1] = __builtin_bit_cast(bf16x8, hi);
        f32x4 st[9]; float mx = -3.0e38f;
#pragma unroll
        for (int t = 0; t < 9; ++t) { f32x4 acc = {0.f, 0.f, 0.f, 0.f};
#pragma unroll
            for (int ks = 0; ks < 2; ++ks) acc = MFMA16(*(const LAS bf16x8*)(KL + (16 * (wid + t) + fr) * 72 + 32 * ks + 8 * g), qf[ks], acc);
#pragma unroll
            for (int j = 0; j < 4; ++j) { const int m = mk0 + 16 * (wid + t) + 4 * g + j; const int dq = mq - m; const bool ok = (dq <= 64) && (dq >= -64) && (m >= 0) && (m < Lr);
                acc[j] = ok ? acc[j] : -1.0e30f; mx = fmaxf(mx, acc[j]); }
            st[t] = acc; }
        mx = fmaxf(mx, __shfl_xor(mx, 16)); mx = fmaxf(mx, __shfl_xor(mx, 32));
        float den = 0.f;
#pragma unroll
        for (int t = 0; t < 9; ++t)
#pragma unroll
            for (int j = 0; j < 4; ++j) { const float e = __expf(st[t][j] - mx); st[t][j] = e; den += e; }
        den += __shfl_xor(den, 16); den += __shfl_xor(den, 32);
        bf16x8 pbf[5];
#pragma unroll
        for (int ks = 0; ks < 4; ++ks) pbf[ks] = pack8(st[2 * ks], st[2 * ks + 1]);
        pbf[4] = pack8(st[8], (f32x4){0.f, 0.f, 0.f, 0.f});
        const float rden = 1.0f / den;
#pragma unroll
        for (int dt = 0; dt < 4; ++dt) { f32x4 o = {0.f, 0.f, 0.f, 0.f};
#pragma unroll
            for (int ks = 0; ks < 5; ++ks) { const LAS bf16_t* vp = VT + (16 * dt + fr) * 264 + 16 * (wid + 2 * ks) + 4 * g;
                const u32x2 vl = *(const LAS u32x2*)vp; u32x2 vh = {0u, 0u}; if (ks < 4) vh = *(const LAS u32x2*)(vp + 16);
                u32x4 w; w.x = vl.x; w.y = vl.y; w.z = vh.x; w.w = vh.y; o = MFMA16(__builtin_bit_cast(bf16x8, w), pbf[ks], o); }
            u32x2 ow; ow.x = pk2(o[0] * rden, o[1] * rden); ow.y = pk2(o[2] * rden, o[3] * rden);
            *(u32x2*)((bf16_t*)B.out + (rowbase + sq) * 1536 + hcol + 16 * dt + 4 * g) = ow; }
        if (g == 0) ((float*)(p.ws + WS_LSE))[(rowbase + sq) * 24 + grp * 8 + h] = mx + __logf(den);
    }
    __syncthreads();
}

__device__ __forceinline__ void post_mixer(const Params& p, const Batch& B) {
    const int lane = ltid() & 63, gw = blockIdx.x * 8 + (ltid() >> 6), NGW = gridDim.x * 8;
    const bf16_t* PROJ = (const bf16_t*)(p.ws + WS_PROJ); const float* LSE = (const float*)(p.ws + WS_LSE);
    const bf16_t* OD0 = (const bf16_t*)(p.ws + WS_OD); const bf16_t* OD1 = OD0 + (size_t)TB * 1024;
    bf16_t* YAD = (bf16_t*)(p.ws + WS_QKVD);
    float dg[16];
#pragma unroll
    for (int e = 0; e < 16; ++e) dg[e] = p.dn_norm_g[(16 * lane + e) & 127];
    const int hh = lane >> 3;
    for (int r0 = gw; r0 < TB; r0 += 2 * NGW) {
        float l0[2], l1[2], l2[2]; u32x4 a[2], b[2], c[2], a0[2], a1[2], b0[2], b1[2], z0[2], z1[2];
#pragma unroll
        for (int u = 0; u < 2; ++u) { const int r = r0 + u * NGW;
            l0[u] = LSE[(size_t)r * 24 + hh]; l1[u] = LSE[(size_t)r * 24 + 8 + hh]; l2[u] = LSE[(size_t)r * 24 + 16 + hh];
            const bf16_t* src = (const bf16_t*)B.out + (size_t)r * 1536 + 8 * lane;
            a[u] = *(const u32x4*)src; b[u] = *(const u32x4*)(src + 512); c[u] = *(const u32x4*)(src + 1024);
            const bf16_t* s0 = OD0 + (size_t)r * 1024 + 16 * lane; const bf16_t* s1 = OD1 + (size_t)r * 1024 + 16 * lane; const bf16_t* zp = PROJ + (size_t)r * NPROJ + C_ZD + 16 * lane;
            a0[u] = *(const u32x4*)s0; a1[u] = *(const u32x4*)(s0 + 8); b0[u] = *(const u32x4*)s1; b1[u] = *(const u32x4*)(s1 + 8); z0[u] = *(const u32x4*)zp; z1[u] = *(const u32x4*)(zp + 8); }
#pragma unroll
        for (int u = 0; u < 2; ++u) { const int r = r0 + u * NGW;
            { const float mx = fmaxf(l0[u], fmaxf(l1[u], l2[u])); float w0 = __expf(l0[u] - mx), w1 = __expf(l1[u] - mx), w2 = __expf(l2[u] - mx); const float inv = 1.0f / (w0 + w1 + w2); w0 *= inv; w1 *= inv; w2 *= inv;
              u32x4 o;
#pragma unroll
              for (int q = 0; q < 4; ++q) o[q] = pk2(w0 * bflo(a[u][q]) + w1 * bflo(b[u][q]) + w2 * bflo(c[u][q]), w0 * bfhi(a[u][q]) + w1 * bfhi(b[u][q]) + w2 * bfhi(c[u][q]));
              *(u32x4*)(YAD + (size_t)r * 1536 + 8 * lane) = o; }
            { float v[16]; float ss = 0.f;
#pragma unroll
              for (int e = 0; e < 16; ++e) { v[e] = bf_el(a0[u], a1[u], e) + bf_el(b0[u], b1[u], e); ss += v[e] * v[e]; }
              ss += __shfl_xor(ss, 1); ss += __shfl_xor(ss, 2); ss += __shfl_xor(ss, 4);
              const float rs = rsqrtf(ss * (1.0f / 128.0f) + EPSF);
#pragma unroll
              for (int e = 0; e < 16; ++e) v[e] = v[e] * rs * dg[e] * siluf_(bf_el(z0[u], z1[u], e));
              u32x4 o0, o1; o0.x = pk2(v[0], v[1]); o0.y = pk2(v[2], v[3]); o0.z = pk2(v[4], v[5]); o0.w = pk2(v[6], v[7]);
              o1.x = pk2(v[8], v[9]); o1.y = pk2(v[10], v[11]); o1.z = pk2(v[12], v[13]); o1.w = pk2(v[14], v[15]);
              *(u32x4*)(YAD + (size_t)r * 1536 + 512 + 16 * lane) = o0; *(u32x4*)(YAD + (size_t)r * 1536 + 512 + 16 * lane + 8) = o1; }
        }
    }
}

__device__ __forceinline__ void conv_act(const Params& p, const Batch& B) {
    const bf16_t* UP = (const bf16_t*)(p.ws + WS_PROJ); bf16_t* ACT = (bf16_t*)(p.ws + WS_PROJ + (size_t)TB * NUP * 2);
    const u32x4 z4 = {0u, 0u, 0u, 0u};
    constexpr int RB = 16;
    for (int t = blockIdx.x * 512 + ltid(); t < (TB / RB) * 352; t += gridDim.x * 512) {
        const int rb = t / 352, cg8 = (t - rb * 352) * 8, row0 = rb * RB; const int s0 = row0 & (B.L - 1);
        f32x4 wv[3][2], wg[3][2], bv[2], bg[2];
#pragma unroll
        for (int q = 0; q < 2; ++q) {
#pragma unroll
            for (int j = 0; j < 3; ++j) { wv[j][q] = *(const f32x4*)(p.ffn_conv_w + j * NUP + cg8 + 4 * q); wg[j][q] = *(const f32x4*)(p.ffn_conv_w + j * NUP + DFF + cg8 + 4 * q); }
            bv[q] = *(const f32x4*)(p.ffn_conv_b + cg8 + 4 * q); bg[q] = *(const f32x4*)(p.ffn_conv_b + DFF + cg8 + 4 * q); }
        const bf16_t* src = UP + (size_t)row0 * NUP + cg8;
        u32x4 vp = z4, gp = z4, vc, gc, vn, gn;
        if (s0 > 0) { vp = *(const u32x4*)(src - NUP); gp = *(const u32x4*)(src - NUP + DFF); }
        vc = *(const u32x4*)src; gc = *(const u32x4*)(src + DFF);
#pragma unroll
        for (int i = 0; i < RB; ++i) {
            vn = z4; gn = z4;
            if (i < RB - 1 || s0 + RB < B.L) { vn = *(const u32x4*)(src + (size_t)(i + 1) * NUP); gn = *(const u32x4*)(src + (size_t)(i + 1) * NUP + DFF); }
            float o[8];
#pragma unroll
            for (int e = 0; e < 8; ++e) { const int q = e >> 2, k = e & 3;
                const float val = bf_el(vp, z4, e) * wv[0][q][k] + bf_el(vc, z4, e) * wv[1][q][k] + bf_el(vn, z4, e) * wv[2][q][k] + bv[q][k];
                const float gt = bf_el(gp, z4, e) * wg[0][q][k] + bf_el(gc, z4, e) * wg[1][q][k] + bf_el(gn, z4, e) * wg[2][q][k] + bg[q][k];
                o[e] = siluf_(gt) * val; }
            u32x4 w; w.x = pk2(o[0], o[1]); w.y = pk2(o[2], o[3]); w.z = pk2(o[4], o[5]); w.w = pk2(o[6], o[7]);
            *(u32x4*)(ACT + (size_t)(row0 + i) * DFF + cg8) = w;
            vp = vc; gp = gc; vc = vn; gc = gn;
        }
    }
}

#ifndef EN_P0
#define EN_P0 1
#endif
#ifndef EN_PREP
#define EN_PREP 1
#endif
#ifndef EN_SCAN
#define EN_SCAN 1
#endif
#ifndef EN_ATT
#define EN_ATT 1
#endif
#ifndef EN_POST
#define EN_POST 1
#endif
#ifndef EN_CONV
#define EN_CONV 1
#endif
#ifndef EN_G1
#define EN_G1 1
#endif
#ifndef EN_G2
#define EN_G2 1
#endif
#ifndef EN_G3
#define EN_G3 1
#endif
#ifndef EN_G4
#define EN_G4 1
#endif
#ifndef EN_G5
#define EN_G5 1
#endif
#ifndef PROBE_POS
#define PROBE_POS -100
#endif
#ifndef REP_ATT
#define REP_ATT 1
#endif
#ifndef REP_P0
#define REP_P0 1
#endif
#ifndef REP_P3
#define REP_P3 1
#endif
#ifndef REP_SCAN
#define REP_SCAN 1
#endif
#ifndef REP_P5
#define REP_P5 1
#endif
#ifndef REP_P11
#define REP_P11 1
#endif
#ifndef REP_G1
#define REP_G1 1
#endif
#ifndef REP_G4
#define REP_G4 1
#endif
#ifndef REP_P9
#define REP_P9 1
#endif
#ifndef REP_SYNC
#define REP_SYNC 1
#endif
#define XB_TMO      128
#define XB_XCNT(j)  (256  + 64 * (j))
#define XB_XSUB(j)  (1280 + 64 * (j))
#define XB_XGEN(j)  (2304 + 64 * (j))
#define XB_TOP      3328
#define XB_TOPGEN   3392
#define XCD_BAR_WORDS 3456
#define XB_SPIN_CAP (1u << 18)

__device__ __forceinline__ unsigned xb_ld(unsigned* p)              { return __hip_atomic_load(p, __ATOMIC_RELAXED, __HIP_MEMORY_SCOPE_AGENT); }
__device__ __forceinline__ unsigned xb_add(unsigned* p, unsigned v) { return __hip_atomic_fetch_add(p, v, __ATOMIC_RELAXED, __HIP_MEMORY_SCOPE_AGENT); }
__device__ __forceinline__ unsigned xb_xcc_id() { return (unsigned)__builtin_amdgcn_s_getreg((3 << 11) | 20) & 0xFu; }
#define XB_SPIN(cond, bar) do { unsigned _sp = 0; while (cond) { __builtin_amdgcn_s_sleep(1); \
    if ((++_sp & 255u) == 0u) { if (xb_ld(&(bar)[XB_TMO])) break; if (_sp > XB_SPIN_CAP) { atomicAdd(&(bar)[XB_TMO], 1u); break; } } } } while (0)

struct XcdBarrier {
    unsigned* bar; unsigned x;
    volatile LAS unsigned* st;
};

__device__ __forceinline__ XcdBarrier xcd_barrier_post(unsigned* bar, volatile LAS unsigned* st) {
    XcdBarrier b; b.bar = bar; b.x = xb_xcc_id(); b.st = st;
    if (threadIdx.x == 0) (void)xb_add(&bar[XB_XCNT(b.x)], 1u);
    return b;
}
__device__ __forceinline__ void xcd_barrier_complete(unsigned* bar, unsigned x, unsigned& nloc, unsigned& nx) {
    const unsigned G = gridDim.x * gridDim.y * gridDim.z;
    unsigned sum, cnt, mine, sp = 0u;
    for (;;) {
        sum = 0u; cnt = 0u; mine = 0u;
#pragma unroll
        for (unsigned j = 0; j < 16; ++j) { const unsigned c = xb_ld(&bar[XB_XCNT(j)]); sum += c; cnt += (c > 0u) ? 1u : 0u; mine = (j == x) ? c : mine; }
        if (sum == G) break;
        __builtin_amdgcn_s_sleep(1);
        if ((++sp & 255u) == 0u) { if (xb_ld(&bar[XB_TMO])) break; if (sp > XB_SPIN_CAP) { atomicAdd(&bar[XB_TMO], 1u); break; } }
    }
    nloc = mine > 0u ? mine : 1u; nx = cnt > 0u ? cnt : 1u;
}

__device__ __forceinline__ void xcd_barrier(const XcdBarrier& b) {
    asm volatile("s_waitcnt vmcnt(0)" ::: "memory");
    __syncthreads();
    if (threadIdx.x == 0) {
        unsigned* bar = b.bar;
        __builtin_amdgcn_s_waitcnt(0);
        unsigned nloc = b.st[0], nx = b.st[1];
        if (nloc == 0u) { xcd_barrier_complete(bar, b.x, nloc, nx); b.st[0] = nloc; b.st[1] = nx; }
        const unsigned old = xb_add(&bar[XB_XSUB(b.x)], 1u);
        const unsigned gen = old / nloc;
        if (old + 1u == (gen + 1u) * nloc) {
            __builtin_amdgcn_fence(__ATOMIC_RELEASE, "agent");
            asm volatile("s_waitcnt vmcnt(0)" ::: "memory");
            const unsigned og = xb_add(&bar[XB_TOP], 1u);
            const unsigned tg = og / nx;
            if (og + 1u == (tg + 1u) * nx) xb_add(&bar[XB_TOPGEN], 1u);
            else XB_SPIN(xb_ld(&bar[XB_TOPGEN]) == tg, bar);
            __builtin_amdgcn_fence(__ATOMIC_ACQUIRE, "agent");
            xb_add(&bar[XB_XGEN(b.x)], 1u);
            asm volatile("s_waitcnt vmcnt(0)" ::: "memory");
        } else {
            XB_SPIN(xb_ld(&bar[XB_XGEN(b.x)]) == gen, bar);
            __builtin_amdgcn_fence(__ATOMIC_ACQUIRE, "agent");
            asm volatile("s_waitcnt vmcnt(0)" ::: "memory");
        }
    }
    __syncthreads();
}


__device__ __forceinline__ void grid_bar(unsigned* ctr, unsigned target) {
    asm volatile("s_waitcnt vmcnt(0) lgkmcnt(0)" ::: "memory");
    __syncthreads();
    if (threadIdx.x == 0) {
        __builtin_amdgcn_fence(__ATOMIC_RELEASE, "agent");
        asm volatile("s_waitcnt vmcnt(0)" ::: "memory");
        __hip_atomic_fetch_add(ctr, 1u, __ATOMIC_RELAXED, __HIP_MEMORY_SCOPE_AGENT);
        while (__hip_atomic_load(ctr, __ATOMIC_RELAXED, __HIP_MEMORY_SCOPE_AGENT) < target) __builtin_amdgcn_s_sleep(2);
        __builtin_amdgcn_fence(__ATOMIC_ACQUIRE, "agent");
        asm volatile("s_waitcnt vmcnt(0)" ::: "memory");
    }
    __syncthreads();
}
__global__ void __launch_bounds__(512) mega(Params p) {
    extern __shared__ __attribute__((aligned(16))) unsigned char lds_raw[];
    LAS unsigned char* L = (LAS unsigned char*)lds_raw;
    const int G = gridDim.x, bid = blockIdx.x, tid = ltid();
    int ph = 0;
#define PHASE_ON (ph >= p.ph_lo && ph < p.ph_hi)
#define SEAM() do { if (ph >= p.ph_lo && ph + 1 < p.ph_hi) { for (int rep_ = 0; rep_ < REP_SYNC; ++rep_) { xcd_barrier(xbar); } } PROBE_TICK(); ++ph; } while (0)
    unsigned nbar = 0;
#if PROBE_POS > -10
    unsigned long long t_prev = __builtin_amdgcn_s_memrealtime(), t_acc = 0;
#define PROBE_TICK() do { const unsigned long long t_now = __builtin_amdgcn_s_memrealtime(); const int pos_ = ph < 2 ? -1 - ph : (ph - 2) % 11; if (pos_ == PROBE_POS) t_acc += t_now - t_prev; t_prev = t_now; } while (0)
#else
#define PROBE_TICK() do {} while (0)
#endif
    unsigned* ctl = (unsigned*)(p.ws + WS_CTL);
    volatile LAS unsigned* xst = (volatile LAS unsigned*)(L + 143360 - 32);
    if (tid == 0) { xst[0] = 0u; xst[1] = 0u; }
    __syncthreads();
    XcdBarrier xbar = xcd_barrier_post(ctl + 1024, xst);
    float* MOD = (float*)(p.ws + WS_MOD);
    bf16_t* XN = (bf16_t*)(p.ws + WS_XN); bf16_t* PROJ = (bf16_t*)(p.ws + WS_PROJ);
    if (EN_P0 && PHASE_ON) for (int rep = 0; rep < REP_P0; ++rep) phase0(p, L);
    SEAM();
    if (PHASE_ON) { const Batch B0 = make_batch(p, 0); norm_mod_rows(p, B0, B0.x, p.norm1_g, 0, 1024, XN); }
    SEAM();
    for (int b = 0; b < 3; ++b) {
        const Batch B = make_batch(p, b);
        const int cbase = b == 0 ? 0 : 8 + (b - 1) * 4;
        if (EN_G1 && PHASE_ON) for (int rep = 0; rep < REP_G1; ++rep) { pg8::Gemm g{XN, (const bf16_t*)(p.ws + WS_WIN), TB, NPROJ, 1024}; pg8::StaticOrder S; S.init(TB, NPROJ, G, bid); EpiBf16S E{PROJ, NPROJ}; pg8::gemm_phase<EpiBf16S, pg8::StaticOrder>(L, g, S, E); }
        SEAM();
        if (EN_PREP && PHASE_ON) for (int rep = 0; rep < REP_P3; ++rep) { const int nit = (TB >> 6) * 4; for (int it = bid; it < nit; it += G) prep_item(p, B, it, L); }
        SEAM();
        if (PHASE_ON) {
            const int lgVS = 1; const int nscan = (B.nseq * 16) << lgVS, natt = B.nseq * 24 * (B.L >> 7);
            LAS int* slot = (LAS int*)(L + 143360 - 16);
            for (;;) {
                if (tid == 0) *slot = (int)atomicAdd(ctl + 64 * b, 1u);
                __syncthreads();
                const int idx = *slot;
                __syncthreads();
                if (idx >= nscan + natt) break;
                if (idx < nscan) { if (EN_SCAN) for (int rep = 0; rep < REP_SCAN; ++rep) scan_chain(p, B, idx >> lgVS, idx & ((1 << lgVS) - 1), lgVS, L); } else { if (EN_ATT) for (int rep = 0; rep < REP_ATT; ++rep) attn_item(p, B, idx - nscan, L); }
            }
        }
        SEAM();
        if (EN_POST && PHASE_ON) for (int rep = 0; rep < REP_P5; ++rep) post_mixer(p, B);
        SEAM();
        if (EN_G2 && PHASE_ON) {
            bf16_t* MERGED = (bf16_t*)(p.ws + WS_QKVD + (size_t)TB * 1536 * 2);
            pg8::Gemm g{(const bf16_t*)(p.ws + WS_QKVD), (const bf16_t*)(p.ws + WS_WA), TB, 1024, 1536}; pg8::StaticOrder S; S.init(TB, 1024, G, bid); EpiMerge E{PROJ + C_GA, PROJ + C_GD, NPROJ, MERGED}; pg8::gemm_phase<EpiMerge, pg8::StaticOrder>(L, g, S, E);
        }
        SEAM();
        if (EN_G3 && PHASE_ON) { const bf16_t* MERGED = (const bf16_t*)(p.ws + WS_QKVD + (size_t)TB * 1536 * 2);
            pg8::Gemm g{MERGED, (const bf16_t*)(p.ws + WS_WO), TB, 1024, 1024}; pg8::StaticOrder S; S.init(TB, 1024, G, bid); EpiResid E{B.x, B.out, MOD + 2048, B.lgL, cbase}; pg8::gemm_phase<EpiResid, pg8::StaticOrder>(L, g, S, E); }
        SEAM();
        if (PHASE_ON) for (int rep = 0; rep < REP_P9; ++rep) norm_mod_rows(p, B, B.out, p.norm2_g, 3072, 4096, XN);
        SEAM();
        if (EN_G4 && PHASE_ON) {
            pg8::StaticOrder S; S.init(65 * 256, NUP, G, bid);
            for (int i = 0; ; ++i) { pg8::Unit u; if (!S.next(i, u)) break;
                const int rowstart = 254 * u.pm - 1;
                pg8::Gemm g{XN + (ptrdiff_t)rowstart * 1024, (const bf16_t*)(p.ws + WS_WUP), 256, NUP, 1024};
                OneUnit S1{pg8::Unit{0, u.pn}};
                EpiConvFfn E{(bf16_t*)(p.ws + WS_PROJ + (size_t)TB * NUP * 2), p.ffn_conv_w, p.ffn_conv_b, rowstart, B.L};
                pg8::gemm_phase<EpiConvFfn, OneUnit>(L, g, S1, E); }
        }
        SEAM();
        if (EN_G5 && PHASE_ON) { pg8::Gemm g{(const bf16_t*)(p.ws + WS_PROJ + (size_t)TB * NUP * 2), (const bf16_t*)(p.ws + WS_WDN), TB, 1024, DFF}; pg8::StaticOrder S; S.init(TB, 1024, G, bid);
            EpiResid E{B.out, B.out, MOD + 5120, B.lgL, cbase}; pg8::gemm_phase<EpiResid, pg8::StaticOrder>(L, g, S, E); }
        SEAM();
        if (PHASE_ON) { final_norm_rows(B.out, p.norm_f_g); if (b < 2) { const Batch Bn = make_batch(p, b + 1); norm_mod_rows(p, Bn, Bn.x, p.norm1_g, 0, 1024, XN); } }
        SEAM();
    }
#if PROBE_POS > -10
    if (bid == 0 && tid == 0) { const unsigned long long t0 = __builtin_amdgcn_s_memrealtime(); while (__builtin_amdgcn_s_memrealtime() - t0 < 4ull * t_acc) __builtin_amdgcn_s_sleep(8); }
#endif
}
constexpr int N_PHASES = 2 + 3 * 10;

#ifndef MULTI_LAUNCH
#define MULTI_LAUNCH 0
#endif
extern "C" void kernel_launch(void* const* d_in, const int* in_sizes, int n_in, void* d_out, int out_size, void* d_ws, size_t ws_size, hipStream_t stream) {
    static int grid = 0;
    if (grid == 0) {
        if (n_in != 21 || ws_size < WS_END) { fprintf(stderr, "kernel_launch: need 21 inputs and %zu bytes of workspace (got %d, %zu)\n", (size_t)WS_END, n_in, ws_size); grid = -1; return; }
        int dev = 0, cus = 0, per_cu = 0;
        hipGetDevice(&dev); hipDeviceGetAttribute(&cus, hipDeviceAttributeMultiprocessorCount, dev);
        if (hipFuncSetAttribute((const void*)mega, hipFuncAttributeMaxDynamicSharedMemorySize, LDS_BYTES) != hipSuccess) { fprintf(stderr, "kernel_launch: hipFuncSetAttribute failed\n"); grid = -1; return; }
        if (hipOccupancyMaxActiveBlocksPerMultiprocessor(&per_cu, (const void*)mega, 512, LDS_BYTES) != hipSuccess || per_cu < 1) { fprintf(stderr, "kernel_launch: occupancy query says %d blocks/CU\n", per_cu); grid = -1; return; }
        grid = cus;
    }
    if (grid < 0) return;
    hipMemsetAsync((char*)d_ws + WS_CTL, 0, 20480, stream);
    Params p{};
    const float** pp = (const float**)&p;
    for (int i = 0; i < 21; ++i) pp[i] = (const float*)d_in[i];
    p.out = (float*)d_out; p.ws = (unsigned char*)d_ws;
#if MULTI_LAUNCH
    for (int ph = 0; ph < N_PHASES; ++ph) { p.ph_lo = ph; p.ph_hi = ph + 1; hipLaunchKernelGGL(mega, dim3(grid), dim3(512), LDS_BYTES, stream, p); }
#else
    p.ph_lo = 0; p.ph_hi = N_PHASES;
    void* args[] = {&p};
    hipError_t e = hipLaunchCooperativeKernel((const void*)mega, dim3(grid), dim3(512), args, LDS_BYTES, stream);
    if (e != hipSuccess) fprintf(stderr, "cooperative launch failed: %s (grid %d)\n", hipGetErrorString(e), grid);
#endif
}
```

```cpp
#include <hip/hip_runtime.h>
#include <cstdio>
namespace pg8 {
#define PG8_LAS __attribute__((address_space(3)))
typedef unsigned short bf16_t;
typedef short bf16x8 __attribute__((ext_vector_type(8)));
typedef float f32x4 __attribute__((ext_vector_type(4)));
typedef unsigned u32x4 __attribute__((ext_vector_type(4)));
constexpr int BM = 256, BK = 64, HALF = 128, HTB = HALF * BK * 2  , STAGE_BYTES = 8 * HTB, NXCD = 8, WGM = 8;

__host__ __device__ __forceinline__ int lds_byte(int r, int c) { const int st = (r >> 4) * 2 + (c >> 5), rr = r & 15, cc = c & 31, ob = rr * 64 + cc * 2; return st * 1024 + (ob ^ (((ob >> 9) & 1) << 5)); }
__host__ __device__ __forceinline__ void stage_rc(int b, int& R, int& C) { const int st = b / 1024, sb = b % 1024, swz = sb ^ (((sb >> 9) & 1) << 5); R = (st >> 1) * 16 + swz / 64; C = (st & 1) * 32 + (swz % 64) / 2; }
__host__ __device__ __forceinline__ int perm32(int rho) { const int n = rho >> 4, i = rho & 15; return 8 * (i >> 2) + 4 * n + (i & 3); }

struct Unit { int pm, pn; };
struct Gemm { const bf16_t* A; const bf16_t* Bt; int M, N, K; };

struct StaticOrder {
    int nM, nN, nwg, G, c;
    __host__ __device__ void init(int M, int N, int G_, int c_) { nM = M / BM; nN = N / BM; nwg = nM * nN; G = G_; c = c_; }
    __host__ __device__ bool next(int i, Unit& u) const {
        const long L = (long)i * G + c; if (L >= nwg) return false;
        int wgid = (int)L; { const int q = nwg / NXCD, r = nwg % NXCD, xcd = wgid % NXCD, off = wgid / NXCD; wgid = (xcd < r ? xcd * (q + 1) : r * (q + 1) + (xcd - r) * q) + off; }
        const int nig = WGM * nN, gid = wgid / nig, fm = gid * WGM, gsz = (nM - fm) < WGM ? (nM - fm) : WGM;
        u.pm = fm + ((wgid % nig) % gsz); u.pn = (wgid % nig) / gsz; return true;
    }
    __device__ __forceinline__ void a_ready(const Unit&) const {}
    __device__ __forceinline__ void done(const Unit&) const {}
};
__device__ __forceinline__ unsigned cvt_pk_bf16(float lo, float hi) { unsigned r; asm volatile("v_cvt_pk_bf16_f32 %0, %1, %2" : "=v"(r) : "v"(lo), "v"(hi)); return r; }
typedef float f32x2 __attribute__((ext_vector_type(2)));
template <class Epi, class Sched>
__device__ __forceinline__ void gemm_phase(PG8_LAS unsigned char* lds, const Gemm g, const Sched& S, const Epi& E) {
    int tid_ = threadIdx.x; asm volatile("" : "+v"(tid_)); const int tid = tid_, wid = __builtin_amdgcn_readfirstlane(tid >> 6), lane = tid & 63, wr = wid >> 2, wc = wid & 3, fr = lane & 15, fq = lane >> 4;
    const int K = g.K, nt = K / BK;
    unsigned voffA[2], voffB[2];
#pragma unroll
    for (int i = 0; i < 2; ++i) { int R, C; stage_rc(tid * 16 + i * 8192, R, C); const int Rb = Epi::PERM ? ((R & ~31) + perm32(R & 31)) : R;
        voffA[i] = (unsigned)(R * K + C) * 2u; voffB[i] = (unsigned)(Rb * K + C) * 2u; }
    const size_t kstep = (size_t)(BK * 2);
    const size_t hstep = (size_t)HALF * K * 2;
    const size_t tstep = 2 * hstep;
    const unsigned ldsw = (unsigned)wid * 1024u;
    const int aoff = lds_byte(wr * 64 + fr, fq * 8), boff = lds_byte(wc * 32 + fr, fq * 8);
#define PG8_SA(b, h) (((b) * 2 + (h)) * HTB)
#define PG8_SB(b, h) ((4 + (b) * 2 + (h)) * HTB)
#define PG8_STAGE(bufoff, gbase, voff) do { _Pragma("unroll") for (int _i = 0; _i < 2; ++_i) \
        __builtin_amdgcn_global_load_lds((const unsigned*)((const char*)(gbase) + (voff)[_i]), (PG8_LAS unsigned*)(lds + (bufoff) + ldsw + _i * 8192), 16, 0, 0); } while (0)
#define PG8_LDA(dst, b, h) do { _Pragma("unroll") for (int m = 0; m < 4; ++m) _Pragma("unroll") for (int k = 0; k < 2; ++k) dst[m][k] = *(const PG8_LAS bf16x8*)(lds + PG8_SA(b, h) + aoff + m * 2048 + k * 1024); } while (0)
#define PG8_LDB(dst, b, h) do { _Pragma("unroll") for (int n = 0; n < 2; ++n) _Pragma("unroll") for (int k = 0; k < 2; ++k) dst[n][k] = *(const PG8_LAS bf16x8*)(lds + PG8_SB(b, h) + boff + n * 2048 + k * 1024); } while (0)
#define PG8_MMA(ai, bj, At, Bt) do { __builtin_amdgcn_s_setprio(1); _Pragma("unroll") for (int m = 0; m < 4; ++m) _Pragma("unroll") for (int n = 0; n < 2; ++n) _Pragma("unroll") for (int k = 0; k < 2; ++k) \
        acc[ai][bj][m][n] = __builtin_amdgcn_mfma_f32_16x16x32_bf16(Bt[n][k], At[m][k], acc[ai][bj][m][n], 0, 0, 0); __builtin_amdgcn_s_setprio(0); } while (0)
#define PG8_WAIT_V(n) asm volatile("s_waitcnt vmcnt(" #n ")" ::: "memory")
#define PG8_WAIT_L(n) asm volatile("s_waitcnt lgkmcnt(" #n ")" ::: "memory")
#define PG8_BAR __builtin_amdgcn_s_barrier()
#define PG8_SCHED __builtin_amdgcn_sched_barrier(0)
    Unit cur, nxt; int ui = 0;
    if (!S.next(0, cur)) return;
    f32x4 acc[2][2][4][2];
#pragma unroll
    for (int a = 0; a < 2; ++a)
#pragma unroll
        for (int b = 0; b < 2; ++b)
#pragma unroll
            for (int m = 0; m < 4; ++m)
#pragma unroll
                for (int n = 0; n < 2; ++n) acc[a][b][m][n] = (f32x4){0.f, 0.f, 0.f, 0.f};
    bf16x8 At[4][2], B0[2][2], B1[2][2];
    const char* cA = (const char*)g.A + (size_t)cur.pm * tstep; const char* cB = (const char*)g.Bt + (size_t)cur.pn * tstep;
    S.a_ready(cur);
    PG8_STAGE(PG8_SB(0, 0), cB, voffB); PG8_STAGE(PG8_SA(0, 0), cA, voffA); PG8_STAGE(PG8_SB(0, 1), cB + hstep, voffB); PG8_STAGE(PG8_SA(0, 1), cA + hstep, voffA);
    if (wr == 1) PG8_BAR;
    PG8_WAIT_V(4); PG8_BAR;
    PG8_STAGE(PG8_SB(1, 0), cB + kstep, voffB); PG8_STAGE(PG8_SA(1, 0), cA + kstep, voffA); PG8_STAGE(PG8_SB(1, 1), cB + hstep + kstep, voffB);
    PG8_WAIT_V(6); PG8_BAR;
    for (;;) {
        const bool has_next = S.next(ui + 1, nxt);
        const char* nA = has_next ? (const char*)g.A + (size_t)nxt.pm * tstep : cA; const char* nB = has_next ? (const char*)g.Bt + (size_t)nxt.pn * tstep : cB;
        int t = 0;
#pragma unroll
        for (int seg = 0; seg < (Epi::KHOOK > 0 ? 2 : 1); ++seg) {
        const int tend = (Epi::KHOOK > 0 && seg == 0) ? Epi::KHOOK : nt;
        for (; t < tend; t += 2) {
            const bool last = (t == nt - 2);
            const char* a1 = cA + (size_t)(t + 1) * kstep;
            const char* a2 = last ? nA : cA + (size_t)(t + 2) * kstep; const char* b2 = last ? nB : cB + (size_t)(t + 2) * kstep;
            const char* a3 = a2 + kstep; const char* b3 = b2 + kstep;
            if (last && has_next) S.a_ready(nxt);
            PG8_LDB(B0, 0, 0); PG8_SCHED; PG8_LDA(At, 0, 0); PG8_STAGE(PG8_SA(1, 1), a1 + hstep, voffA);
            PG8_WAIT_L(8); PG8_BAR; PG8_WAIT_L(0); PG8_MMA(0, 0, At, B0); PG8_BAR; PG8_SCHED;
            PG8_LDB(B1, 0, 1); PG8_STAGE(PG8_SB(0, 0), b2, voffB);
            PG8_BAR; PG8_WAIT_L(0); PG8_MMA(0, 1, At, B1); PG8_BAR;
            PG8_LDA(At, 0, 1); PG8_STAGE(PG8_SA(0, 0), a2, voffA);
            PG8_BAR; PG8_WAIT_L(0); PG8_MMA(1, 0, At, B0); PG8_BAR; PG8_SCHED;
            PG8_STAGE(PG8_SB(0, 1), b2 + hstep, voffB);
            PG8_WAIT_V(6); PG8_BAR; PG8_MMA(1, 1, At, B1); PG8_BAR;
            PG8_LDB(B0, 1, 0); PG8_SCHED; PG8_LDA(At, 1, 0); PG8_STAGE(PG8_SA(0, 1), a2 + hstep, voffA);
            PG8_WAIT_L(8); PG8_BAR; PG8_WAIT_L(0); PG8_MMA(0, 0, At, B0); PG8_BAR; PG8_SCHED;
            PG8_LDB(B1, 1, 1); PG8_STAGE(PG8_SB(1, 0), b3, voffB);
            PG8_BAR; PG8_WAIT_L(0); PG8_MMA(0, 1, At, B1); PG8_BAR;
            PG8_LDA(At, 1, 1); PG8_STAGE(PG8_SA(1, 0), a3, voffA);
            PG8_BAR; PG8_WAIT_L(0); PG8_MMA(1, 0, At, B0); PG8_BAR; PG8_SCHED;
            PG8_STAGE(PG8_SB(1, 1), b3 + hstep, voffB);
            PG8_WAIT_V(6); PG8_BAR; PG8_MMA(1, 1, At, B1); PG8_BAR;
        }
        if constexpr (Epi::KHOOK > 0) { if (seg == 0) E.mid(acc, cur, wr, wc, fr, fq); }
        }
        if constexpr (!Epi::AFTER_DRAIN) { E(acc, cur, wr, wc, fr, fq); S.done(cur); }
        if (!has_next) break;
#pragma unroll
        for (int a = 0; a < 2; ++a)
#pragma unroll
            for (int b = 0; b < 2; ++b)
#pragma unroll
                for (int m = 0; m < 4; ++m)
#pragma unroll
                    for (int n = 0; n < 2; ++n) acc[a][b][m][n] = (f32x4){0.f, 0.f, 0.f, 0.f};
        cur = nxt; cA = nA; cB = nB; ++ui;
    }
    PG8_WAIT_V(0);
    if (wr == 0) PG8_BAR;
    PG8_BAR;
    if constexpr (Epi::AFTER_DRAIN) { E.fused(acc, cur, wr, wc, fr, fq, lds, wid, lane); S.done(cur); }
#undef PG8_SA
#undef PG8_SB
#undef PG8_STAGE
#undef PG8_LDA
#undef PG8_LDB
#undef PG8_MMA
#undef PG8_WAIT_V
#undef PG8_WAIT_L
#undef PG8_BAR
#undef PG8_SCHED
}
}

#define LAS __attribute__((address_space(3)))
using pg8::bf16_t; using pg8::bf16x8; using pg8::f32x4; using pg8::u32x4;
typedef unsigned u32x2 __attribute__((ext_vector_type(2)));
typedef float f32x2 __attribute__((ext_vector_type(2)));
typedef short bf16x4 __attribute__((ext_vector_type(4)));

constexpr int DM = 1024, TB = 16384, NPROJ = 11008, DFF = 2816, NUP = 5632;
constexpr int C_QA = 0, C_KA = 1536, C_VA = 3072, C_QD = 4608, C_KD = 5632, C_VD = 6656, C_ZD = 7680, C_GA = 8704, C_GD = 9728, C_AB = 10752;
constexpr float EPSF = 1e-6f;
constexpr int LDS_BYTES = 143360;

constexpr size_t al256(size_t x) { return (x + 255) & ~(size_t)255; }
constexpr size_t WS_CTL = 0;
constexpr size_t WS_MOD = 20480;
constexpr size_t WS_ROPE = WS_MOD + al256((size_t)16 * 6144 * 4);
constexpr size_t WS_WIN = WS_ROPE + (size_t)4096 * 32 * 8;
constexpr size_t WS_WA = WS_WIN + (size_t)NPROJ * 1024 * 2;
constexpr size_t WS_WD = WS_WA + (size_t)1024 * 512 * 2;
constexpr size_t WS_WO = WS_WD + (size_t)1024 * 1024 * 2;
constexpr size_t WS_WUP = WS_WO + (size_t)1024 * 1024 * 2;
constexpr size_t WS_WDN = WS_WUP + (size_t)NUP * 1024 * 2;
constexpr size_t WS_XN = WS_WDN + (size_t)1024 * DFF * 2;
constexpr size_t WS_PROJ = WS_XN + (size_t)TB * 1024 * 2;
constexpr size_t WS_QKVD = WS_PROJ + (size_t)TB * NPROJ * 2;
constexpr size_t WS_TP = WS_QKVD + (size_t)TB * 3072 * 2;
constexpr size_t WS_EG = WS_TP + (size_t)4096 * 16384;
constexpr size_t WS_OD = WS_EG + (size_t)4096 * 512;
constexpr size_t WS_LSE = WS_OD + (size_t)2 * TB * 1024 * 2;
constexpr size_t WS_END = WS_LSE + (size_t)TB * 24 * 4;
static_assert(WS_END <= ((size_t)700 << 20), "workspace");

struct Params {
    const float* x_prompt; const float* x_sample; const float* c_prompt; const float* c_sample;
    const float* w_ada; const float* b_ada; const float* norm1_g; const float* w_in; const float* conv_qkv_w;
    const float* a_log; const float* dt_bias; const float* dn_norm_g; const float* w_br_attn; const float* w_br_dn;
    const float* w_out; const float* norm2_g; const float* w_up; const float* ffn_conv_w; const float* ffn_conv_b;
    const float* w_down; const float* norm_f_g;
    float* out; unsigned char* ws;
    int ph_lo, ph_hi;
};

__constant__ double INVF[32] = {1.0, 0.7498942093324559, 0.5623413251903491, 0.4216965034285822, 0.31622776601683794, 0.23713737056616552, 0.1778279410038923, 0.1333521432163324, 0.1, 0.07498942093324558, 0.05623413251903491, 0.042169650342858224, 0.03162277660168379, 0.023713737056616554, 0.01778279410038923, 0.01333521432163324, 0.01, 0.007498942093324558, 0.005623413251903491, 0.004216965034285823, 0.0031622776601683794, 0.0023713737056616554, 0.0017782794100389228, 0.001333521432163324, 0.001, 0.0007498942093324559, 0.0005623413251903491, 0.00042169650342858224, 0.00031622776601683794, 0.00023713737056616554, 0.00017782794100389227, 0.0001333521432163324};

__device__ __forceinline__ float bf2f(unsigned short b) { return __uint_as_float(((unsigned)b) << 16); }
__device__ __forceinline__ float bflo(unsigned w) { return __uint_as_float(w << 16); }
__device__ __forceinline__ float bfhi(unsigned w) { return __uint_as_float(w & 0xffff0000u); }
__device__ __forceinline__ unsigned pk2(float lo, float hi) { unsigned r; asm("v_cvt_pk_bf16_f32 %0, %1, %2" : "=v"(r) : "v"(lo), "v"(hi)); return r; }
__device__ __forceinline__ unsigned short f2bf(float f) { return (unsigned short)(pk2(f, 0.f) & 0xffffu); }
__device__ __forceinline__ float sigmoidf_(float x) { return 1.0f / (1.0f + __expf(-x)); }
__device__ __forceinline__ float siluf_(float x) { return x / (1.0f + __expf(-x)); }
__device__ __forceinline__ float wave_sum(float v) {
#pragma unroll
    for (int o = 32; o >= 1; o >>= 1) v += __shfl_xor(v, o);
    return v;
}
__device__ __forceinline__ int ltid() { int t = threadIdx.x; asm volatile("" : "+v"(t)); return t; }
struct Batch { int b, L, lgL, nseq; const float* x; float* out; };
__device__ __forceinline__ Batch make_batch(const Params& p, int b) {
    Batch B; B.b = b; B.L = b == 0 ? 2048 : 4096; B.lgL = b == 0 ? 11 : 12; B.nseq = TB >> B.lgL;
    B.x = b == 0 ? p.x_prompt : p.x_sample + (size_t)(b - 1) * TB * DM; B.out = p.out + (size_t)b * TB * DM; return B;
}
__device__ __forceinline__ int cond_index(const Batch& B, int row) { const int s = row >> B.lgL; return B.b == 0 ? s : 8 + (B.b - 1) * 4 + s; }

__device__ __forceinline__ float bf_el8(const u32x4& a, int e) { const unsigned w = a[(e >> 1) & 3]; return (e & 1) ? bfhi(w) : bflo(w); }
__device__ __forceinline__ void transpose_tile(const float* __restrict__ src, int Nsrc, bf16_t* __restrict__ dst, int K, int kt, int nt, int mode, LAS float* T, int koff = 0) {
    const int tid = ltid();
    const int c4 = (tid & 15) * 4, r0 = tid >> 4;
    const int j = nt * 64 + c4; int sj = j;
    if (mode == 1) sj = (j < 8704) ? j : (j < 10752) ? j + 32 : (j < 10784) ? j - 2048 : -1;
    if (mode == 2) { const int pn = j >> 8, jj = j & 255; sj = jj < 128 ? 128 * pn + jj : DFF + 128 * pn + (jj - 128); }
#pragma unroll
    for (int i = 0; i < 2; ++i) {
        const int r = r0 + 32 * i;
        f32x4 v = {0.f, 0.f, 0.f, 0.f};
        if (sj >= 0) v = *(const f32x4*)(src + (size_t)(kt * 64 + r) * Nsrc + sj);
        T[r * 65 + c4 + 0] = v[0]; T[r * 65 + c4 + 1] = v[1]; T[r * 65 + c4 + 2] = v[2]; T[r * 65 + c4 + 3] = v[3];
    }
    __syncthreads();
    const int n = tid >> 3, kp = (tid & 7) * 8;
    u32x4 w;
    w.x = pk2(T[(kp + 0) * 65 + n], T[(kp + 1) * 65 + n]); w.y = pk2(T[(kp + 2) * 65 + n], T[(kp + 3) * 65 + n]);
    w.z = pk2(T[(kp + 4) * 65 + n], T[(kp + 5) * 65 + n]); w.w = pk2(T[(kp + 6) * 65 + n], T[(kp + 7) * 65 + n]);
    *(u32x4*)(dst + (size_t)(nt * 64 + n) * K + koff + kt * 64 + kp) = w;
    __syncthreads();
}

__device__ __forceinline__ void mod_item(const Params& p, int item, LAS unsigned char* L) {
    LAS float* sc = (LAS float*)L;
    LAS float* red = (LAS float*)(L + 65536);
    const int tid = ltid(), lane = tid & 63, wid = tid >> 6;
    for (int e = tid; e < 16384; e += 512) { const int r = e >> 10, k = e & 1023; const float c = r < 8 ? p.c_prompt[r * 1024 + k] : p.c_sample[(r - 8) * 1024 + k]; sc[k * 16 + r] = siluf_(c); }
    __syncthreads();
    const int j = item * 64 + lane;
    float acc[16];
#pragma unroll
    for (int r = 0; r < 16; ++r) acc[r] = 0.f;
    for (int k = wid * 128; k < wid * 128 + 128; ++k) {
        const float w = p.w_ada[(size_t)k * 6144 + j];
#pragma unroll
        for (int q = 0; q < 4; ++q) { const f32x4 s = *(const LAS f32x4*)(sc + k * 16 + 4 * q);
            acc[4 * q + 0] += w * s[0]; acc[4 * q + 1] += w * s[1]; acc[4 * q + 2] += w * s[2]; acc[4 * q + 3] += w * s[3]; }
    }
#pragma unroll
    for (int r = 0; r < 16; ++r) red[(wid * 16 + r) * 64 + lane] = acc[r];
    __syncthreads();
    float* MOD = (float*)(p.ws + WS_MOD);
    for (int e = tid; e < 1024; e += 512) { const int r = e >> 6, l = e & 63; float s = 0.f;
#pragma unroll
        for (int w = 0; w < 8; ++w) s += red[(w * 16 + r) * 64 + l];
        MOD[r * 6144 + item * 64 + l] = s + p.b_ada[item * 64 + l]; }
    __syncthreads();
}

__device__ __forceinline__ void phase0(const Params& p, LAS unsigned char* L) {
    const int G = gridDim.x, bid = blockIdx.x, tid = ltid();
    { f32x2* R = (f32x2*)(p.ws + WS_ROPE);
      for (int e = bid * 512 + tid; e < 4096 * 32; e += G * 512) { const int pos = e >> 5, i = e & 31;
          const double rev = (double)pos * INVF[i] * 0.15915494309189535; const double fr = rev - __builtin_rint(rev);
          f32x2 cs; cs.x = __builtin_amdgcn_cosf((float)fr); cs.y = __builtin_amdgcn_sinf((float)fr); R[e] = cs; } }
    if (bid >= G - 96) mod_item(p, bid - (G - 96), L);
    constexpr int I_IN = 16 * 172, I_A = 8 * 16, I_D = 16 * 16, I_O = 16 * 16, I_UP = 16 * 88, I_DN = 44 * 16;
    constexpr int NIT = I_IN + I_A + I_D + I_O + I_UP + I_DN;
    LAS float* T = (LAS float*)L;
    const int tid_ = ltid(), c4 = (tid_ & 15) * 4, r0 = tid_ >> 4, n_ = tid_ >> 3, kp = (tid_ & 7) * 8;
    for (int it0 = bid; it0 < NIT; it0 += 2 * G) {
        const float* src[2]; bf16_t* dst[2]; int Nsrc[2], K[2], kt[2], nt[2], mode[2], koff[2]; bool on[2];
#pragma unroll
        for (int u = 0; u < 2; ++u) { int r = it0 + u * G; on[u] = r < NIT; if (!on[u]) r = it0; koff[u] = 0; mode[u] = 0;
            if (r < I_IN) { src[u] = p.w_in; Nsrc[u] = 10784; dst[u] = (bf16_t*)(p.ws + WS_WIN); K[u] = 1024; kt[u] = r & 15; nt[u] = r >> 4; mode[u] = 1; }
            else if ((r -= I_IN) < I_A) { src[u] = p.w_br_attn; Nsrc[u] = 1024; dst[u] = (bf16_t*)(p.ws + WS_WA); K[u] = 1536; kt[u] = r & 7; nt[u] = r >> 3; }
            else if ((r -= I_A) < I_D) { src[u] = p.w_br_dn; Nsrc[u] = 1024; dst[u] = (bf16_t*)(p.ws + WS_WA); K[u] = 1536; kt[u] = r & 15; nt[u] = r >> 4; koff[u] = 512; }
            else if ((r -= I_D) < I_O) { src[u] = p.w_out; Nsrc[u] = 1024; dst[u] = (bf16_t*)(p.ws + WS_WO); K[u] = 1024; kt[u] = r & 15; nt[u] = r >> 4; }
            else if ((r -= I_O) < I_UP) { src[u] = p.w_up; Nsrc[u] = NUP; dst[u] = (bf16_t*)(p.ws + WS_WUP); K[u] = 1024; kt[u] = r & 15; nt[u] = r >> 4; mode[u] = 2; }
            else { r -= I_UP; src[u] = p.w_down; Nsrc[u] = 1024; dst[u] = (bf16_t*)(p.ws + WS_WDN); K[u] = DFF; kt[u] = r % 44; nt[u] = r / 44; } }
        f32x4 v[2][2];
#pragma unroll
        for (int u = 0; u < 2; ++u) { const int j = nt[u] * 64 + c4; int sj = j;
            if (mode[u] == 1) sj = (j < 8704) ? j : (j < 10752) ? j + 32 : (j < 10784) ? j - 2048 : -1;
            if (mode[u] == 2) { const int pn = j >> 8, jj = j & 255; sj = jj < 128 ? 128 * pn + jj : DFF + 128 * pn + (jj - 128); }
#pragma unroll
            for (int i = 0; i < 2; ++i) { v[u][i] = (f32x4){0.f, 0.f, 0.f, 0.f}; if (sj >= 0) v[u][i] = *(const f32x4*)(src[u] + (size_t)(kt[u] * 64 + r0 + 32 * i) * Nsrc[u] + sj); } }
#pragma unroll
        for (int u = 0; u < 2; ++u)
#pragma unroll
            for (int i = 0; i < 2; ++i) { LAS float* tp = T + u * 4160 + (r0 + 32 * i) * 65 + c4; tp[0] = v[u][i][0]; tp[1] = v[u][i][1]; tp[2] = v[u][i][2]; tp[3] = v[u][i][3]; }
        __syncthreads();
#pragma unroll
        for (int u = 0; u < 2; ++u) if (on[u]) { const LAS float* tq = T + u * 4160 + kp * 65 + n_; u32x4 w;
            w.x = pk2(tq[0], tq[65]); w.y = pk2(tq[130], tq[195]); w.z = pk2(tq[260], tq[325]); w.w = pk2(tq[390], tq[455]);
            *(u32x4*)(dst[u] + (size_t)(nt[u] * 64 + n_) * K[u] + koff[u] + kt[u] * 64 + kp) = w; }
        __syncthreads();
    }
}

__device__ __forceinline__ void norm_mod_rows(const Params& p, const Batch& B, const float* __restrict__ xin, const float* __restrict__ g, int sh_off, int sc_off, bf16_t* __restrict__ out) {
    const int lane = ltid() & 63, gw = blockIdx.x * 8 + (ltid() >> 6), NGW = gridDim.x * 8;
    const float* MOD = (const float*)(p.ws + WS_MOD);
    f32x4 gv[4];
#pragma unroll
    for (int i = 0; i < 4; ++i) gv[i] = *(const f32x4*)(g + 4 * lane + 256 * i);
    for (int r = gw; r < TB; r += 2 * NGW) {
        const int r1 = r + NGW; const bool has1 = r1 < TB; const int rb = has1 ? r1 : r;
        const float* xa = xin + (size_t)r * DM; const float* xb = xin + (size_t)rb * DM;
        f32x4 va[4], vb[4]; float sa = 0.f, sb = 0.f;
#pragma unroll
        for (int i = 0; i < 4; ++i) { va[i] = *(const f32x4*)(xa + 4 * lane + 256 * i); vb[i] = *(const f32x4*)(xb + 4 * lane + 256 * i); }
#pragma unroll
        for (int i = 0; i < 4; ++i) { sa += va[i][0] * va[i][0] + va[i][1] * va[i][1] + va[i][2] * va[i][2] + va[i][3] * va[i][3]; sb += vb[i][0] * vb[i][0] + vb[i][1] * vb[i][1] + vb[i][2] * vb[i][2] + vb[i][3] * vb[i][3]; }
        const float rsa = rsqrtf(wave_sum(sa) * (1.0f / DM) + EPSF), rsb = rsqrtf(wave_sum(sb) * (1.0f / DM) + EPSF);
        const float* ma = MOD + (size_t)cond_index(B, r) * 6144; const float* mb = MOD + (size_t)cond_index(B, rb) * 6144;
#pragma unroll
        for (int i = 0; i < 4; ++i) { const f32x4 sc = *(const f32x4*)(ma + sc_off + 4 * lane + 256 * i), sh = *(const f32x4*)(ma + sh_off + 4 * lane + 256 * i);
            const f32x4 y = va[i] * rsa * gv[i] * (sc + 1.0f) + sh; u32x2 w; w.x = pk2(y[0], y[1]); w.y = pk2(y[2], y[3]);
            *(u32x2*)(out + (size_t)r * DM + 4 * lane + 256 * i) = w; }
        if (has1) {
#pragma unroll
            for (int i = 0; i < 4; ++i) { const f32x4 sc = *(const f32x4*)(mb + sc_off + 4 * lane + 256 * i), sh = *(const f32x4*)(mb + sh_off + 4 * lane + 256 * i);
                const f32x4 y = vb[i] * rsb * gv[i] * (sc + 1.0f) + sh; u32x2 w; w.x = pk2(y[0], y[1]); w.y = pk2(y[2], y[3]);
                *(u32x2*)(out + (size_t)r1 * DM + 4 * lane + 256 * i) = w; } }
    }
}
__device__ __forceinline__ void final_norm_rows(float* __restrict__ io, const float* __restrict__ g) {
    const int lane = ltid() & 63, gw = blockIdx.x * 8 + (ltid() >> 6), NGW = gridDim.x * 8;
    f32x4 gv[4];
#pragma unroll
    for (int i = 0; i < 4; ++i) gv[i] = *(const f32x4*)(g + 4 * lane + 256 * i);
    for (int r = gw; r < TB; r += 2 * NGW) {
        const int r1 = r + NGW; const bool has1 = r1 < TB; const int rb = has1 ? r1 : r;
        float* xa = io + (size_t)r * DM; float* xb = io + (size_t)rb * DM; f32x4 va[4], vb[4]; float sa = 0.f, sb = 0.f;
#pragma unroll
        for (int i = 0; i < 4; ++i) { va[i] = *(const f32x4*)(xa + 4 * lane + 256 * i); vb[i] = *(const f32x4*)(xb + 4 * lane + 256 * i); }
#pragma unroll
        for (int i = 0; i < 4; ++i) { sa += va[i][0] * va[i][0] + va[i][1] * va[i][1] + va[i][2] * va[i][2] + va[i][3] * va[i][3]; sb += vb[i][0] * vb[i][0] + vb[i][1] * vb[i][1] + vb[i][2] * vb[i][2] + vb[i][3] * vb[i][3]; }
        const float rsa = rsqrtf(wave_sum(sa) * (1.0f / DM) + EPSF), rsb = rsqrtf(wave_sum(sb) * (1.0f / DM) + EPSF);
#pragma unroll
        for (int i = 0; i < 4; ++i) *(f32x4*)(xa + 4 * lane + 256 * i) = va[i] * rsa * gv[i];
        if (has1) {
#pragma unroll
            for (int i = 0; i < 4; ++i) *(f32x4*)(xb + 4 * lane + 256 * i) = vb[i] * rsb * gv[i]; }
    }
}

struct EpiBf16S {
    static constexpr bool PERM = true, AFTER_DRAIN = false; static constexpr int KHOOK = 0;
    bf16_t* O; int ldc;
    __device__ __forceinline__ void operator()(const f32x4 (&acc)[2][2][4][2], const pg8::Unit& u, int wr, int wc, int fr, int fq) const {
        const int row0 = u.pm * 256 + wr * 64 + fr, col0 = u.pn * 256 + wc * 32 + 8 * fq;
#pragma unroll
        for (int ai = 0; ai < 2; ++ai)
#pragma unroll
            for (int m = 0; m < 4; ++m) { bf16_t* rowp = O + (size_t)(row0 + ai * 128 + m * 16) * ldc + col0;
#pragma unroll
                for (int bj = 0; bj < 2; ++bj) { const f32x4 v0 = acc[ai][bj][m][0], v1 = acc[ai][bj][m][1];
                    u32x4 w; w.x = pk2(v0[0], v0[1]); w.y = pk2(v0[2], v0[3]); w.z = pk2(v1[0], v1[1]); w.w = pk2(v1[2], v1[3]);
                    *(u32x4*)(rowp + bj * 128) = w; } }
    }
};
struct EpiMerge {
    static constexpr bool PERM = true, AFTER_DRAIN = false; static constexpr int KHOOK = 8;
    const bf16_t* ga; const bf16_t* gd; int ldg; bf16_t* O;
    __device__ __forceinline__ void mid(f32x4 (&acc)[2][2][4][2], const pg8::Unit& u, int wr, int wc, int fr, int fq) const {
        const int row0 = u.pm * 256 + wr * 64 + fr, col0 = u.pn * 256 + wc * 32 + 8 * fq;
        size_t ro = (size_t)row0 * ldg + col0;
#pragma unroll
        for (int ai = 0; ai < 2; ++ai) {
#pragma unroll
            for (int m = 0; m < 4; ++m) {
#pragma unroll
                for (int bj = 0; bj < 2; ++bj) { const u32x4 a = *(const u32x4*)(ga + ro + bj * 128), d = *(const u32x4*)(gd + ro + bj * 128);
#pragma unroll
                    for (int q = 0; q < 4; ++q) { const float r0 = (1.0f + __expf(-bflo(d[q]))) * __builtin_amdgcn_rcpf(1.0f + __expf(-bflo(a[q]))), r1 = (1.0f + __expf(-bfhi(d[q]))) * __builtin_amdgcn_rcpf(1.0f + __expf(-bfhi(a[q])));
                        acc[ai][bj][m][q >> 1][2 * (q & 1)] *= r0; acc[ai][bj][m][q >> 1][2 * (q & 1) + 1] *= r1; }
                    asm volatile("" : "+v"(ro) :: "memory"); }
                ro += (size_t)16 * ldg; }
            ro += (size_t)64 * ldg; }
    }
    __device__ __forceinline__ void operator()(const f32x4 (&acc)[2][2][4][2], const pg8::Unit& u, int wr, int wc, int fr, int fq) const {
        const int row0 = u.pm * 256 + wr * 64 + fr, col0 = u.pn * 256 + wc * 32 + 8 * fq;
#pragma unroll
        for (int ai = 0; ai < 2; ++ai)
#pragma unroll
            for (int m = 0; m < 4; ++m) { const int row = row0 + ai * 128 + m * 16;
#pragma unroll
                for (int bj = 0; bj < 2; ++bj) { const u32x4 d = *(const u32x4*)(gd + (size_t)row * ldg + col0 + bj * 128); const f32x4 v0 = acc[ai][bj][m][0], v1 = acc[ai][bj][m][1];
                    u32x4 w; w.x = pk2(v0[0] * sigmoidf_(bflo(d.x)), v0[1] * sigmoidf_(bfhi(d.x))); w.y = pk2(v0[2] * sigmoidf_(bflo(d.y)), v0[3] * sigmoidf_(bfhi(d.y)));
                    w.z = pk2(v1[0] * sigmoidf_(bflo(d.z)), v1[1] * sigmoidf_(bfhi(d.z))); w.w = pk2(v1[2] * sigmoidf_(bflo(d.w)), v1[3] * sigmoidf_(bfhi(d.w)));
                    *(u32x4*)(O + (size_t)row * DM + col0 + bj * 128) = w; }
                asm volatile("" ::: "memory"); }
    }
};
struct OneUnit {
    pg8::Unit u0;
    __device__ __forceinline__ bool next(int i, pg8::Unit& u) const { if (i != 0) return false; u = u0; return true; }
    __device__ __forceinline__ void a_ready(const pg8::Unit&) const {}
    __device__ __forceinline__ void done(const pg8::Unit&) const {}
};
struct EpiConvFfn {
    static constexpr bool PERM = false, AFTER_DRAIN = true; static constexpr int KHOOK = 0;
    bf16_t* ACT; const float* cw; const float* cb; int rowstart, Lseq;
    __device__ __forceinline__ void fused(f32x4 (&acc)[2][2][4][2], const pg8::Unit& u, int wr, int wc, int fr, int fq, LAS unsigned char* lds, int wid, int lane) const {
        LAS bf16_t* T = (LAS bf16_t*)lds;
        LAS float* W = (LAS float*)(lds + 135168);
        const int tid = wid * 64 + lane;
        for (int e = tid; e < 1024; e += 512) { const int k = e >> 7, c = e & 127, cg_ = 128 * u.pn + c; float v;
            if (k < 3) v = cw[k * NUP + cg_]; else if (k < 6) v = cw[(k - 3) * NUP + DFF + cg_]; else if (k == 6) v = cb[cg_]; else v = cb[DFF + cg_];
            W[e] = v; }
#pragma unroll
        for (int ai = 0; ai < 2; ++ai)
#pragma unroll
            for (int m = 0; m < 4; ++m) { const int row = ai * 128 + wr * 64 + m * 16 + fr;
#pragma unroll
                for (int bj = 0; bj < 2; ++bj)
#pragma unroll
                    for (int n = 0; n < 2; ++n) { const int col = bj * 128 + wc * 32 + n * 16 + 4 * fq; const f32x4 v = acc[ai][bj][m][n];
                        u32x2 w; w.x = pk2(v[0], v[1]); w.y = pk2(v[2], v[3]); *(LAS u32x2*)(T + row * 264 + col) = w; } }
        __syncthreads();
        const u32x4 z4 = {0u, 0u, 0u, 0u};
#pragma unroll 1
        for (int i = 0; i < 8; ++i) { const int t = tid + 512 * i; if (t >= 4064) break;
            const int r = 1 + (t >> 4), c8 = (t & 15) * 8, grow = rowstart + r; if (grow < 0 || grow >= TB) continue;
            const int s_ = grow & (Lseq - 1);
            const LAS bf16_t* tp = T + r * 264 + c8;
            u32x4 vp = *(const LAS u32x4*)(tp - 264), vc = *(const LAS u32x4*)tp, vn = *(const LAS u32x4*)(tp + 264);
            u32x4 gp = *(const LAS u32x4*)(tp - 264 + 128), gc = *(const LAS u32x4*)(tp + 128), gn = *(const LAS u32x4*)(tp + 264 + 128);
            if (s_ == 0) { vp = z4; gp = z4; }
            if (s_ == Lseq - 1) { vn = z4; gn = z4; }
            float o[8];
#pragma unroll
            for (int q = 0; q < 2; ++q) { const f32x4 wv0 = *(const LAS f32x4*)(W + c8 + 4 * q), wv1 = *(const LAS f32x4*)(W + 128 + c8 + 4 * q), wv2 = *(const LAS f32x4*)(W + 256 + c8 + 4 * q);
                const f32x4 wg0 = *(const LAS f32x4*)(W + 384 + c8 + 4 * q), wg1 = *(const LAS f32x4*)(W + 512 + c8 + 4 * q), wg2 = *(const LAS f32x4*)(W + 640 + c8 + 4 * q);
                const f32x4 bv = *(const LAS f32x4*)(W + 768 + c8 + 4 * q), bg = *(const LAS f32x4*)(W + 896 + c8 + 4 * q);
#pragma unroll
                for (int k = 0; k < 4; ++k) { const int e = 4 * q + k;
                    const float val = bf_el8(vp, e) * wv0[k] + bf_el8(vc, e) * wv1[k] + bf_el8(vn, e) * wv2[k] + bv[k];
                    const float gt = bf_el8(gp, e) * wg0[k] + bf_el8(gc, e) * wg1[k] + bf_el8(gn, e) * wg2[k] + bg[k];
                    o[e] = siluf_(gt) * val; } }
            u32x4 w; w.x = pk2(o[0], o[1]); w.y = pk2(o[2], o[3]); w.z = pk2(o[4], o[5]); w.w = pk2(o[6], o[7]);
            *(u32x4*)(ACT + (size_t)grow * DFF + 128 * u.pn + c8) = w; }
        __syncthreads();
    }
};
struct EpiResid {
    static constexpr bool PERM = false, AFTER_DRAIN = false; static constexpr int KHOOK = 0;
    const float* xin; float* out; const float* gt; int lgL, cbase;
    __device__ __forceinline__ void operator()(const f32x4 (&acc)[2][2][4][2], const pg8::Unit& u, int wr, int wc, int fr, int fq) const {
        const int row0 = u.pm * 256 + wr * 64 + fr, col0 = u.pn * 256 + wc * 32 + 4 * fq;
#pragma unroll
        for (int ai = 0; ai < 2; ++ai)
#pragma unroll
            for (int m = 0; m < 4; ++m) { const int row = row0 + ai * 128 + m * 16; const float* gr = gt + (size_t)(cbase + (row >> lgL)) * 6144;
#pragma unroll
                for (int bj = 0; bj < 2; ++bj)
#pragma unroll
                    for (int n = 0; n < 2; ++n) { const int col = col0 + bj * 128 + n * 16;
                        const f32x4 xv = *(const f32x4*)(xin + (size_t)row * DM + col), gv = *(const f32x4*)(gr + col);
                        *(f32x4*)(out + (size_t)row * DM + col) = xv + gv * acc[ai][bj][m][n]; } }
    }
};

__device__ __forceinline__ bf16x8 permfrag_sw(const LAS bf16_t* base, int row, int stride, int kbase, int g, int sw) {
    const u32x2 lo = *(const LAS u32x2*)(base + row * stride + ((kbase + 4 * g) ^ sw)), hi = *(const LAS u32x2*)(base + row * stride + ((kbase + 16 + 4 * g) ^ sw));
    u32x4 w; w.x = lo.x; w.y = lo.y; w.z = hi.x; w.w = hi.y; return __builtin_bit_cast(bf16x8, w);
}
#define MFMA16(a, b, c) __builtin_amdgcn_mfma_f32_16x16x32_bf16((a), (b), (c), 0, 0, 0)
__device__ __forceinline__ float bf_el(const u32x4& a, const u32x4& b, int e) { const unsigned w = (e < 8) ? a[(e >> 1) & 3] : b[(e >> 1) & 3]; return (e & 1) ? bfhi(w) : bflo(w); }

__device__ __forceinline__ void prep_item(const Params& p, const Batch& B, int item, LAS unsigned char* L) {
    const int tid = ltid(), lane = tid & 63, wid = tid >> 6, g = lane >> 4, fr = lane & 15;
    const int NC = B.L >> 6;
    const int hp = item & 3, sn = item >> 2, n = sn & (NC - 1), seq = sn >> (B.lgL - 6);
    const int r0 = seq * B.L + n * 64;
    LAS bf16_t* KS = (LAS bf16_t*)L;
    LAS bf16_t* QS = (LAS bf16_t*)(L + 34816);
    LAS float* AA = (LAS float*)L;
    LAS float* KK = (LAS float*)(L + 69632);
    LAS float* QK = (LAS float*)(L + 102912);
    LAS float* GS = (LAS float*)(L + 136192);
    const bf16_t* PROJ = (const bf16_t*)(p.ws + WS_PROJ);
    bf16_t* QKVD = (bf16_t*)(p.ws + WS_QKVD);
    LAS float* CW = (LAS float*)(L + 69632);
    for (int e = tid; e < 2304; e += 512) { const int hh = e / 1152, rem = e - hh * 1152, mat = rem / 384, rem2 = rem - mat * 384, tap = rem2 >> 7, c = rem2 & 127;
        CW[e] = p.conv_qkv_w[tap * 3072 + mat * 1024 + (hp * 2 + hh) * 128 + c]; }
    float al_pre = 0.f, be_pre = 0.f;
    if (wid < 4) { const int hh = wid >> 1, dir = wid & 1, h = hp * 2 + hh; const int c = dir ? 63 - lane : lane; const int row = r0 + c;
        al_pre = bf2f(PROJ[(size_t)row * NPROJ + C_AB + dir * 8 + h]); be_pre = bf2f(PROJ[(size_t)row * NPROJ + C_AB + 16 + dir * 8 + h]); }
    __syncthreads();
    {
        const int r = tid >> 3, pc = (tid & 7) * 16; const int row = r0 + r; const int s = n * 64 + r;
        const bool hasp = s > 0, hasn = s < B.L - 1;
        const u32x4 z4 = {0u, 0u, 0u, 0u};
#pragma unroll
        for (int hh = 0; hh < 2; ++hh) {
            const int h = hp * 2 + hh;
            u32x4 xc[3][2], xp[3][2], xn[3][2];
#pragma unroll
            for (int mat = 0; mat < 3; ++mat) { const bf16_t* src = PROJ + (size_t)row * NPROJ + C_QD + mat * 1024 + h * 128 + pc;
                xc[mat][0] = *(const u32x4*)src; xc[mat][1] = *(const u32x4*)(src + 8); xp[mat][0] = z4; xp[mat][1] = z4; xn[mat][0] = z4; xn[mat][1] = z4;
                if (hasp) { xp[mat][0] = *(const u32x4*)(src - NPROJ); xp[mat][1] = *(const u32x4*)(src - NPROJ + 8); }
                if (hasn) { xn[mat][0] = *(const u32x4*)(src + NPROJ); xn[mat][1] = *(const u32x4*)(src + NPROJ + 8); } }
#pragma unroll
            for (int mat = 0; mat < 3; ++mat) {
                const int col = mat * 1024 + h * 128 + pc;
                const LAS float* cw = CW + (hh * 3 + mat) * 384 + pc;
                float y[16]; float ss = 0.f;
#pragma unroll
                for (int q = 0; q < 4; ++q) {
                    const f32x4 w0 = *(const LAS f32x4*)(cw + 4 * q), w1 = *(const LAS f32x4*)(cw + 128 + 4 * q), w2 = *(const LAS f32x4*)(cw + 256 + 4 * q);
#pragma unroll
                    for (int e = 0; e < 4; ++e) { const int ee = 4 * q + e;
                        float v = bf_el(xp[mat][0], xp[mat][1], ee) * w0[e] + bf_el(xc[mat][0], xc[mat][1], ee) * w1[e] + bf_el(xn[mat][0], xn[mat][1], ee) * w2[e];
                        v = siluf_(v); y[ee] = v; ss += v * v; }
                }
                if (mat < 2) {
                    ss += __shfl_xor(ss, 1); ss += __shfl_xor(ss, 2); ss += __shfl_xor(ss, 4);
                    float sc = rsqrtf(ss + EPSF); if (mat == 0) sc *= 0.08838834764831845f;
#pragma unroll
                    for (int e = 0; e < 16; ++e) y[e] *= sc;
                }
                u32x4 o0, o1;
                o0.x = pk2(y[0], y[1]); o0.y = pk2(y[2], y[3]); o0.z = pk2(y[4], y[5]); o0.w = pk2(y[6], y[7]);
                o1.x = pk2(y[8], y[9]); o1.y = pk2(y[10], y[11]); o1.z = pk2(y[12], y[13]); o1.w = pk2(y[14], y[15]);
                bf16_t* dst = QKVD + (size_t)row * 3072 + col;
                *(u32x4*)dst = o0; *(u32x4*)(dst + 8) = o1;
                if (mat == 0) { *(LAS u32x4*)(QS + (hh * 64 + r) * 136 + pc) = o0; *(LAS u32x4*)(QS + (hh * 64 + r) * 136 + pc + 8) = o1; }
                if (mat == 1) { *(LAS u32x4*)(KS + (hh * 64 + r) * 136 + pc) = o0; *(LAS u32x4*)(KS + (hh * 64 + r) * 136 + pc + 8) = o1; }
            }
        }
    }
    __syncthreads();
    {
        const int hh = wid >> 2, ct = wid & 3; const LAS bf16_t* Kh = KS + hh * 64 * 136; const LAS bf16_t* Qh = QS + hh * 64 * 136;
        bf16x8 ak[4], aq[4];
#pragma unroll
        for (int ks = 0; ks < 4; ++ks) { ak[ks] = *(const LAS bf16x8*)(Kh + (16 * ct + fr) * 136 + 32 * ks + 8 * g); aq[ks] = *(const LAS bf16x8*)(Qh + (16 * ct + fr) * 136 + 32 * ks + 8 * g); }
#pragma unroll
        for (int dt = 0; dt < 4; ++dt) {
            f32x4 c0 = {0.f, 0.f, 0.f, 0.f}, c1 = {0.f, 0.f, 0.f, 0.f};
#pragma unroll
            for (int ks = 0; ks < 4; ++ks) { const bf16x8 b = *(const LAS bf16x8*)(Kh + (16 * dt + fr) * 136 + 32 * ks + 8 * g); c0 = MFMA16(ak[ks], b, c0); c1 = MFMA16(aq[ks], b, c1); }
#pragma unroll
            for (int j = 0; j < 4; ++j) { KK[hh * 4160 + (16 * ct + 4 * g + j) * 65 + 16 * dt + fr] = c0[j]; QK[hh * 4160 + (16 * ct + 4 * g + j) * 65 + 16 * dt + fr] = c1[j]; }
        }
    }
    if (wid < 4) {
        const int hh = wid >> 1, dir = wid & 1, h = hp * 2 + hh; const int c = dir ? 63 - lane : lane; const int row = r0 + c;
        const float al = al_pre, be = be_pre; (void)row;
        const float xx = al + p.dt_bias[dir * 8 + h]; const float sp = fmaxf(xx, 0.f) + log1pf(__expf(-fabsf(xx)));
        float G = -__expf(p.a_log[dir * 8 + h]) * sp;
#pragma unroll
        for (int o = 1; o < 64; o <<= 1) { const float t = __shfl_up(G, o); if (lane >= o) G += t; }
        const float G63 = __shfl(G, 63);
        GS[wid * 128 + lane] = G; GS[wid * 128 + 64 + lane] = sigmoidf_(be);
        const int np = dir ? NC - 1 - n : n; const size_t cid = ((size_t)((seq * 2 + dir) * 8 + h)) * NC + np;
        float* EG = (float*)(p.ws + WS_EG) + cid * 128; EG[lane] = __expf(G); EG[64 + lane] = __expf(G63 - G);
    }
    __syncthreads();
    for (int e = tid; e < 16384; e += 512) { const int sv = e >> 12, hh = sv >> 1, dir = sv & 1, j = (e >> 6) & 63, i = e & 63; float a = 0.f;
        if (i > j) { const int ci = dir ? 63 - i : i, cj = dir ? 63 - j : j; a = GS[sv * 128 + 64 + i] * KK[hh * 4160 + ci * 65 + cj] * __expf(GS[sv * 128 + i] - GS[sv * 128 + j]); }
        AA[(sv * 64 + j) * 68 + i] = a; }
    __syncthreads();
    if (wid < 4) {
        const int sv = wid, hh = sv >> 1, dir = sv & 1, h = hp * 2 + hh; const LAS float* Ad = AA + sv * 64 * 68;
        float acc[64];
#pragma unroll
        for (int i = 0; i < 64; ++i) acc[i] = (lane == i) ? 1.f : 0.f;
#pragma unroll
        for (int j = 0; j < 63; ++j) { const float tj = acc[j];
#pragma unroll
            for (int i4 = ((j + 1) & ~3); i4 < 64; i4 += 4) { const f32x4 a = *(const LAS f32x4*)(Ad + j * 68 + i4);
#pragma unroll
                for (int e = 0; e < 4; ++e) if (i4 + e > j) acc[i4 + e] -= a[e] * tj; } }
        const int np = dir ? NC - 1 - n : n; const size_t cid = ((size_t)((seq * 2 + dir) * 8 + h)) * NC + np;
        bf16_t* Tg = (bf16_t*)(p.ws + WS_TP) + cid * 8192; const float bl = GS[sv * 128 + 64 + lane];
#pragma unroll
        for (int i = 0; i < 64; ++i) Tg[i * 64 + lane] = f2bf(acc[i] * bl);
    } else {
        bf16_t* TPg = (bf16_t*)(p.ws + WS_TP);
        for (int t = tid - 256; t < 2048; t += 256) { const int sv = t >> 9, hh = sv >> 1, dir = sv & 1, h = hp * 2 + hh, i = (t >> 3) & 63, j0 = (t & 7) * 8;
            const int np = dir ? NC - 1 - n : n; const size_t cid = ((size_t)((seq * 2 + dir) * 8 + h)) * NC + np;
            float v[8]; const int ci = dir ? 63 - i : i; const float Gi = GS[sv * 128 + i];
#pragma unroll
            for (int e = 0; e < 8; ++e) { const int j = j0 + e, cj = dir ? 63 - j : j; v[e] = (i >= j) ? QK[hh * 4160 + ci * 65 + cj] * __expf(Gi - GS[sv * 128 + j]) : 0.f; }
            u32x4 w; w.x = pk2(v[0], v[1]); w.y = pk2(v[2], v[3]); w.z = pk2(v[4], v[5]); w.w = pk2(v[6], v[7]);
            *(u32x4*)(TPg + cid * 8192 + 4096 + i * 64 + j0) = w; }
    }
    __syncthreads();
}

__device__ __forceinline__ bf16x8 pack8(const f32x4& a, const f32x4& b) { u32x4 w; w.x = pk2(a[0], a[1]); w.y = pk2(a[2], a[3]); w.z = pk2(b[0], b[1]); w.w = pk2(b[2], b[3]); return __builtin_bit_cast(bf16x8, w); }
__device__ __forceinline__ bf16x8 permfrag(const LAS bf16_t* base, int row, int stride, int kbase, int g) {
    const u32x2 lo = *(const LAS u32x2*)(base + row * stride + kbase + 4 * g), hi = *(const LAS u32x2*)(base + row * stride + kbase + 16 + 4 * g);
    u32x4 w; w.x = lo.x; w.y = lo.y; w.z = hi.x; w.w = hi.y; return __builtin_bit_cast(bf16x8, w);
}

__device__ __forceinline__ void scan_chain(const Params& p, const Batch& B, int chain, int vs, int lgVS, LAS unsigned char* L) {
    const int tid = ltid(), lane = tid & 63, wid = tid >> 6, g = lane >> 4, fr = lane & 15;
    const int NC = B.L >> 6;
    const int h = chain & 7, dir = (chain >> 3) & 1, seq = chain >> 4;
    LAS bf16_t* KS = (LAS bf16_t*)L;
    LAS bf16_t* KT = (LAS bf16_t*)(L + 17408);
    LAS bf16_t* QS = (LAS bf16_t*)(L + 35840);
    LAS bf16_t* VS = (LAS bf16_t*)(L + 53248);
    LAS bf16_t* TS = (LAS bf16_t*)(L + 70656);
    LAS bf16_t* PS = (LAS bf16_t*)(L + 79872);
    LAS float* EGS = (LAS float*)(L + 89088);
    LAS bf16_t* OS = (LAS bf16_t*)(L + 89600);
    const bf16_t* QKVD = (const bf16_t*)(p.ws + WS_QKVD);
    const bf16_t* TPg = (const bf16_t*)(p.ws + WS_TP);
    const float* EGg = (const float*)(p.ws + WS_EG);
    bf16_t* OD = (bf16_t*)(p.ws + WS_OD) + (size_t)dir * TB * 1024;
    const size_t cid0 = ((size_t)((seq * 2 + dir) * 8 + h)) * NC;
    const int cp = tid >> 3, pc = tid & 7;
    u32x4 rq0, rq1, rk0, rk1, rv0, rv1, rt, rp; float reg_eg = 0.f;
#define SC_LOAD(np_) do { const int tok_ = dir ? (B.L - 1 - ((np_) * 64 + cp)) : ((np_) * 64 + cp); const bf16_t* src_ = QKVD + (size_t)(seq * B.L + tok_) * 3072 + h * 128 + 16 * pc; \
        rq0 = *(const u32x4*)src_; rq1 = *(const u32x4*)(src_ + 8); rk0 = *(const u32x4*)(src_ + 1024); rk1 = *(const u32x4*)(src_ + 1032); rv0 = *(const u32x4*)(src_ + 2048); rv1 = *(const u32x4*)(src_ + 2056); \
        const bf16_t* tp_ = TPg + (cid0 + (np_)) * 8192 + cp * 64 + 8 * pc; rt = *(const u32x4*)tp_; rp = *(const u32x4*)(tp_ + 4096); \
        if (tid < 128) reg_eg = EGg[(cid0 + (np_)) * 128 + tid]; } while (0)
    if (__builtin_amdgcn_readfirstlane(wid) < (8 >> lgVS)) {
    f32x4 S[8];
#pragma unroll
    for (int i = 0; i < 8; ++i) S[i] = (f32x4){0.f, 0.f, 0.f, 0.f};
    SC_LOAD(0);
    for (int np = 0; np < NC; ++np) {
        *(LAS u32x4*)(QS + cp * 136 + 16 * pc) = rq0; *(LAS u32x4*)(QS + cp * 136 + 16 * pc + 8) = rq1;
        *(LAS u32x4*)(KS + cp * 136 + 16 * pc) = rk0; *(LAS u32x4*)(KS + cp * 136 + 16 * pc + 8) = rk1;
        *(LAS u32x4*)(VS + cp * 136 + 16 * pc) = rv0; *(LAS u32x4*)(VS + cp * 136 + 16 * pc + 8) = rv1;
        *(LAS u32x4*)(TS + cp * 72 + 8 * pc) = rt; *(LAS u32x4*)(PS + cp * 72 + 8 * pc) = rp;
#pragma unroll
        for (int e = 0; e < 8; ++e) { const unsigned w0 = rk0[e >> 1], w1 = rk1[e >> 1];
            KT[(16 * pc + e) * 72 + cp] = (bf16_t)((e & 1) ? (w0 >> 16) : (w0 & 0xffffu));
            KT[(16 * pc + 8 + e) * 72 + cp] = (bf16_t)((e & 1) ? (w1 >> 16) : (w1 & 0xffffu)); }
        if (tid < 128) EGS[tid] = reg_eg;
        __syncthreads();
        if (np + 1 < NC) SC_LOAD(np + 1);
        if (np > 0 && (pc >> (3 - lgVS)) == vs) { const LAS bf16_t* os = OS + ((np - 1) & 1) * 8704 + cp * 136 + 16 * pc; const u32x4 o0 = *(const LAS u32x4*)os, o1 = *(const LAS u32x4*)(os + 8);
            const int c_ = (np - 1) * 64 + cp; const int tok_ = dir ? (B.L - 1 - c_) : c_; bf16_t* dst = OD + (size_t)(seq * B.L + tok_) * 1024 + h * 128 + 16 * pc;
            *(u32x4*)dst = o0; *(u32x4*)(dst + 8) = o1; }
        const int vcol = vs * (128 >> lgVS) + 16 * wid;
#define SCHED_FENCE() __builtin_amdgcn_sched_barrier(0)
        bf16x8 Sb[4];
#pragma unroll
        for (int ks = 0; ks < 4; ++ks) Sb[ks] = pack8(S[2 * ks], S[2 * ks + 1]);
        f32x4 X[4], Q[4];
#pragma unroll
        for (int ct = 0; ct < 4; ++ct) { X[ct] = (f32x4){0.f, 0.f, 0.f, 0.f}; Q[ct] = (f32x4){0.f, 0.f, 0.f, 0.f}; }
        bf16x8 fk[2][4], fq[2][4], ft[2][4];
#pragma unroll
        for (int ct = 0; ct < 4; ++ct) { fk[0][ct] = permfrag(KS, 16 * ct + fr, 136, 0, g); fq[0][ct] = permfrag(QS, 16 * ct + fr, 136, 0, g); }
        SCHED_FENCE();
#pragma unroll
        for (int ks = 0; ks < 4; ++ks) {
            if (ks < 3) {
#pragma unroll
                for (int ct = 0; ct < 4; ++ct) { fk[(ks + 1) & 1][ct] = permfrag(KS, 16 * ct + fr, 136, 32 * (ks + 1), g); fq[(ks + 1) & 1][ct] = permfrag(QS, 16 * ct + fr, 136, 32 * (ks + 1), g); }
            } else {
#pragma unroll
                for (int ct = 0; ct < 4; ++ct) { ft[0][ct] = permfrag(TS, 16 * ct + fr, 72, 0, g); ft[1][ct] = permfrag(TS, 16 * ct + fr, 72, 32, g); }
            }
            SCHED_FENCE();
#pragma unroll
            for (int ct = 0; ct < 4; ++ct) { X[ct] = MFMA16(fk[ks & 1][ct], Sb[ks], X[ct]); Q[ct] = MFMA16(fq[ks & 1][ct], Sb[ks], Q[ct]); }
            SCHED_FENCE();
        }
        f32x4 EGv[4], R[4];
#pragma unroll
        for (int ct = 0; ct < 4; ++ct) { EGv[ct] = *(const LAS f32x4*)(EGS + 16 * ct + 4 * g);
#pragma unroll
            for (int j = 0; j < 4; ++j) { const unsigned w = *(const LAS unsigned*)(VS + (16 * ct + 4 * g + j) * 136 + vcol + (fr & ~1)); R[ct][j] = (fr & 1) ? bfhi(w) : bflo(w); } }
        bf16x8 fp[2][4];
#pragma unroll
        for (int ct = 0; ct < 4; ++ct) { fp[0][ct] = permfrag(PS, 16 * ct + fr, 72, 0, g); fp[1][ct] = permfrag(PS, 16 * ct + fr, 72, 32, g); }
        SCHED_FENCE();
#pragma unroll
        for (int ct = 0; ct < 4; ++ct) R[ct] = R[ct] - EGv[ct] * X[ct];
        bf16x8 Rb[2]; Rb[0] = pack8(R[0], R[1]); Rb[1] = pack8(R[2], R[3]);
        f32x4 Vn[4];
#pragma unroll
        for (int ct = 0; ct < 4; ++ct) Vn[ct] = (f32x4){0.f, 0.f, 0.f, 0.f};
#pragma unroll
        for (int k2 = 0; k2 < 2; ++k2)
#pragma unroll
            for (int ct = 0; ct < 4; ++ct) Vn[ct] = MFMA16(ft[k2][ct], Rb[k2], Vn[ct]);
        bf16x8 fkt[2][8];
#pragma unroll
        for (int i = 0; i < 8; ++i) fkt[0][i] = permfrag(KT, 16 * i + fr, 72, 0, g);
        SCHED_FENCE();
        bf16x8 Vb[2]; Vb[0] = pack8(Vn[0], Vn[1]); Vb[1] = pack8(Vn[2], Vn[3]);
        f32x4 O[4];
#pragma unroll
        for (int ct = 0; ct < 4; ++ct) O[ct] = EGv[ct] * Q[ct];
#pragma unroll
        for (int k2 = 0; k2 < 2; ++k2)
#pragma unroll
            for (int ct = 0; ct < 4; ++ct) O[ct] = MFMA16(fp[k2][ct], Vb[k2], O[ct]);
#pragma unroll
        for (int i = 0; i < 8; ++i) fkt[1][i] = permfrag(KT, 16 * i + fr, 72, 32, g);
        SCHED_FENCE();
#pragma unroll
        for (int ct = 0; ct < 4; ++ct) { const f32x4 egd = *(const LAS f32x4*)(EGS + 64 + 16 * ct + 4 * g); Vn[ct] = Vn[ct] * egd; }
        Vb[0] = pack8(Vn[0], Vn[1]); Vb[1] = pack8(Vn[2], Vn[3]);
        const float egl = EGS[63];
#pragma unroll
        for (int i = 0; i < 8; ++i) S[i] = S[i] * egl;
#pragma unroll
        for (int k2 = 0; k2 < 2; ++k2)
#pragma unroll
            for (int i = 0; i < 8; ++i) S[i] = MFMA16(fkt[k2][i], Vb[k2], S[i]);
#pragma unroll
        for (int ct = 0; ct < 4; ++ct)
#pragma unroll
            for (int j = 0; j < 4; ++j) OS[(np & 1) * 8704 + (16 * ct + 4 * g + j) * 136 + vcol + fr] = f2bf(O[ct][j]);
#undef SCHED_FENCE
        __syncthreads();
    }
    } else {
    SC_LOAD(0);
    for (int np = 0; np < NC; ++np) {
        *(LAS u32x4*)(QS + cp * 136 + 16 * pc) = rq0; *(LAS u32x4*)(QS + cp * 136 + 16 * pc + 8) = rq1;
        *(LAS u32x4*)(KS + cp * 136 + 16 * pc) = rk0; *(LAS u32x4*)(KS + cp * 136 + 16 * pc + 8) = rk1;
        *(LAS u32x4*)(VS + cp * 136 + 16 * pc) = rv0; *(LAS u32x4*)(VS + cp * 136 + 16 * pc + 8) = rv1;
        *(LAS u32x4*)(TS + cp * 72 + 8 * pc) = rt; *(LAS u32x4*)(PS + cp * 72 + 8 * pc) = rp;
#pragma unroll
        for (int e = 0; e < 8; ++e) { const unsigned w0 = rk0[e >> 1], w1 = rk1[e >> 1];
            KT[(16 * pc + e) * 72 + cp] = (bf16_t)((e & 1) ? (w0 >> 16) : (w0 & 0xffffu));
            KT[(16 * pc + 8 + e) * 72 + cp] = (bf16_t)((e & 1) ? (w1 >> 16) : (w1 & 0xffffu)); }
        if (tid < 128) EGS[tid] = reg_eg;
        __syncthreads();
        if (np + 1 < NC) SC_LOAD(np + 1);
        if (np > 0 && (pc >> (3 - lgVS)) == vs) { const LAS bf16_t* os = OS + ((np - 1) & 1) * 8704 + cp * 136 + 16 * pc; const u32x4 o0 = *(const LAS u32x4*)os, o1 = *(const LAS u32x4*)(os + 8);
            const int c_ = (np - 1) * 64 + cp; const int tok_ = dir ? (B.L - 1 - c_) : c_; bf16_t* dst = OD + (size_t)(seq * B.L + tok_) * 1024 + h * 128 + 16 * pc;
            *(u32x4*)dst = o0; *(u32x4*)(dst + 8) = o1; }
        __syncthreads();
    }
    }
    if ((pc >> (3 - lgVS)) == vs) { const LAS bf16_t* os = OS + ((NC - 1) & 1) * 8704 + cp * 136 + 16 * pc; const u32x4 o0 = *(const LAS u32x4*)os, o1 = *(const LAS u32x4*)(os + 8);
      const int c_ = (NC - 1) * 64 + cp; const int tok_ = dir ? (B.L - 1 - c_) : c_; bf16_t* dst = OD + (size_t)(seq * B.L + tok_) * 1024 + h * 128 + 16 * pc;
      *(u32x4*)dst = o0; *(u32x4*)(dst + 8) = o1; }
    __syncthreads();
#undef SC_LOAD
}

__device__ __forceinline__ void attn_item(const Params& p, const Batch& B, int item, LAS unsigned char* L) {
    const int tid = ltid(), lane = tid & 63, wid = tid >> 6, g = lane >> 4, fr = lane & 15;
    const int lgper = B.lgL - 7;
    const int x = item & ((1 << lgper) - 1), sgh = item >> lgper, h = sgh & 7, sg = sgh >> 3, grp = sg % 3, seq = sg / 3;
    const int lgd = 2 * grp, r = x & ((1 << lgd) - 1), pb = x >> lgd, Lr = B.L >> lgd;
    const int mq0 = pb * 128, mk0 = mq0 - 64, hcol = (grp * 8 + h) * 64;
    LAS bf16_t* KL = (LAS bf16_t*)L;
    LAS bf16_t* VT = (LAS bf16_t*)(L + 36864);
    bf16_t* PROJ = (bf16_t*)(p.ws + WS_PROJ);
    const f32x2* ROPE = (const f32x2*)(p.ws + WS_ROPE);
    const size_t rowbase = (size_t)seq * B.L;
    const u32x4 z4 = {0u, 0u, 0u, 0u};
    const int mq = mq0 + 16 * wid + fr, sq = (mq << lgd) + r;
    bf16_t* qptr = PROJ + (rowbase + sq) * NPROJ + C_QA + hcol;
    const u32x4 qa = *(const u32x4*)(qptr + 8 * g), qb = *(const u32x4*)(qptr + 32 + 8 * g);
    f32x4 qcs[4];
    { const f32x4* rp = (const f32x4*)(ROPE + (size_t)sq * 32 + 8 * g);
#pragma unroll
      for (int q = 0; q < 4; ++q) qcs[q] = rp[q]; }
    u32x4 ka[2], kb[2]; f32x4 kcs[2][4]; u32x4 va[4];
#pragma unroll
    for (int i = 0; i < 2; ++i) { const int t = tid + 512 * i, kk = t >> 2, pp = t & 3, m = mk0 + kk; ka[i] = z4; kb[i] = z4;
#pragma unroll
        for (int q = 0; q < 4; ++q) kcs[i][q] = (f32x4){0.f, 0.f, 0.f, 0.f};
        if (m >= 0 && m < Lr) { const int s = (m << lgd) + r; const bf16_t* src = PROJ + (rowbase + s) * NPROJ + C_KA + hcol + 8 * pp;
            ka[i] = *(const u32x4*)src; kb[i] = *(const u32x4*)(src + 32); const f32x4* rp = (const f32x4*)(ROPE + (size_t)s * 32 + 8 * pp);
#pragma unroll
            for (int q = 0; q < 4; ++q) kcs[i][q] = rp[q]; } }
#pragma unroll
    for (int i = 0; i < 4; ++i) { const int kk = tid & 255, p8 = (tid >> 8) + 2 * i, m = mk0 + kk; va[i] = z4;
        if (m >= 0 && m < Lr) { const int s = (m << lgd) + r; va[i] = *(const u32x4*)(PROJ + (rowbase + s) * NPROJ + C_VA + hcol + 8 * p8); } }
#pragma unroll
    for (int i = 0; i < 2; ++i) { const int t = tid + 512 * i, kk = t >> 2, pp = t & 3; u32x4 lo, hi;
#pragma unroll
        for (int q = 0; q < 4; ++q) { const f32x4 cs = kcs[i][q]; const float x1a = bflo(ka[i][q]), x1b = bfhi(ka[i][q]), x2a = bflo(kb[i][q]), x2b = bfhi(kb[i][q]);
            lo[q] = pk2(x1a * cs[0] - x2a * cs[1], x1b * cs[2] - x2b * cs[3]); hi[q] = pk2(x2a * cs[0] + x1a * cs[1], x2b * cs[2] + x1b * cs[3]); }
        *(LAS u32x4*)(KL + kk * 72 + 8 * pp) = lo; *(LAS u32x4*)(KL + kk * 72 + 32 + 8 * pp) = hi; }
#pragma unroll
    for (int i = 0; i < 4; ++i) { const int kk = tid & 255, p8 = (tid >> 8) + 2 * i;
#pragma unroll
        for (int e = 0; e < 8; ++e) { const unsigned w = va[i][e >> 1]; VT[(8 * p8 + e) * 264 + kk] = (bf16_t)((e & 1) ? (w >> 16) : (w & 0xffffu)); } }
    __syncthreads();
    {
        u32x4 lo, hi;
#pragma unroll
        for (int q = 0; q < 4; ++q) { const f32x4 cs = qcs[q] * 0.125f; const float x1a = bflo(qa[q]), x1b = bfhi(qa[q]), x2a = bflo(qb[q]), x2b = bfhi(qb[q]);
            lo[q] = pk2(x1a * cs[0] - x2a * cs[1], x1b * cs[2] - x2b * cs[3]); hi[q] = pk2(x2a * cs[0] + x1a * cs[1], x2b * cs[2] + x1b * cs[3]); }
        bf16x8 qf[2]; qf[0] = __builtin_bit_cast(bf16x8, lo); qf[1] = __builtin_bit_cast(bf16x8, hi);
        f32x4 st[9]; float mx = -3.0e38f;
#pragma unroll
        for (int t = 0; t < 9; ++t) { f32x4 acc = {0.f, 0.f, 0.f, 0.f};
#pragma unroll
            for (int ks = 0; ks < 2; ++ks) acc = MFMA16(*(const LAS bf16x8*)(KL + (16 * (wid + t) + fr) * 72 + 32 * ks + 8 * g), qf[ks], acc);
#pragma unroll
            for (int j = 0; j < 4; ++j) { const int m = mk0 + 16 * (wid + t) + 4 * g + j; const int dq = mq - m; const bool ok = (dq <= 64) && (dq >= -64) && (m >= 0) && (m < Lr);
                acc[j] = ok ? acc[j] : -1.0e30f; mx = fmaxf(mx, acc[j]); }
            st[t] = acc; }
        mx = fmaxf(mx, __shfl_xor(mx, 16)); mx = fmaxf(mx, __shfl_xor(mx, 32));
        float den = 0.f;
#pragma unroll
        for (int t = 0; t < 9; ++t)
#pragma unroll
            for (int j = 0; j < 4; ++j) { const float e = __expf(st[t][j] - mx); st[t][j] = e; den += e; }
        den += __shfl_xor(den, 16); den += __shfl_xor(den, 32);
        bf16x8 pbf[5];
#pragma unroll
        for (int ks = 0; ks < 4; ++ks) pbf[ks] = pack8(st[2 * ks], st[2 * ks + 1]);
        pbf[4] = pack8(st[8], (f32x4){0.f, 0.f, 0.f, 0.f});
        const float rden = 1.0f / den;
#pragma unroll
        for (int dt = 0; dt < 4; ++dt) { f32x4 o = {0.f, 0.f, 0.f, 0.f};
#pragma unroll
            for (int ks = 0; ks < 5; ++ks) { const LAS bf16_t* vp = VT + (16 * dt + fr) * 264 + 16 * (wid + 2 * ks) + 4 * g;
                const u32x2 vl = *(const LAS u32x2*)vp; u32x2 vh = {0u, 0u}; if (ks < 4) vh = *(const LAS u32x2*)(vp + 16);
                u32x4 w; w.x = vl.x; w.y = vl.y; w.z = vh.x; w.w = vh.y; o = MFMA16(__builtin_bit_cast(bf16x8, w), pbf[ks], o); }
            u32x2 ow; ow.x = pk2(o[0] * rden, o[1] * rden); ow.y = pk2(o[2] * rden, o[3] * rden);
            *(u32x2*)((bf16_t*)B.out + (rowbase + sq) * 1536 + hcol + 16 * dt + 4 * g) = ow; }
        if (g == 0) ((float*)(p.ws + WS_LSE))[(rowbase + sq) * 24 + grp * 8 + h] = mx + __logf(den);
    }
    __syncthreads();
}

__device__ __forceinline__ void post_mixer(const Params& p, const Batch& B) {
    const int lane = ltid() & 63, gw = blockIdx.x * 8 + (ltid() >> 6), NGW = gridDim.x * 8;
    const bf16_t* PROJ = (const bf16_t*)(p.ws + WS_PROJ); const float* LSE = (const float*)(p.ws + WS_LSE);
    const bf16_t* OD0 = (const bf16_t*)(p.ws + WS_OD); const bf16_t* OD1 = OD0 + (size_t)TB * 1024;
    bf16_t* YAD = (bf16_t*)(p.ws + WS_QKVD);
    float dg[16];
#pragma unroll
    for (int e = 0; e < 16; ++e) dg[e] = p.dn_norm_g[(16 * lane + e) & 127];
    const int hh = lane >> 3;
    for (int r0 = gw; r0 < TB; r0 += 2 * NGW) {
        float l0[2], l1[2], l2[2]; u32x4 a[2], b[2], c[2], a0[2], a1[2], b0[2], b1[2], z0[2], z1[2];
#pragma unroll
        for (int u = 0; u < 2; ++u) { const int r = r0 + u * NGW;
            l0[u] = LSE[(size_t)r * 24 + hh]; l1[u] = LSE[(size_t)r * 24 + 8 + hh]; l2[u] = LSE[(size_t)r * 24 + 16 + hh];
            const bf16_t* src = (const bf16_t*)B.out + (size_t)r * 1536 + 8 * lane;
            a[u] = *(const u32x4*)src; b[u] = *(const u32x4*)(src + 512); c[u] = *(const u32x4*)(src + 1024);
            const bf16_t* s0 = OD0 + (size_t)r * 1024 + 16 * lane; const bf16_t* s1 = OD1 + (size_t)r * 1024 + 16 * lane; const bf16_t* zp = PROJ + (size_t)r * NPROJ + C_ZD + 16 * lane;
            a0[u] = *(const u32x4*)s0; a1[u] = *(const u32x4*)(s0 + 8); b0[u] = *(const u32x4*)s1; b1[u] = *(const u32x4*)(s1 + 8); z0[u] = *(const u32x4*)zp; z1[u] = *(const u32x4*)(zp + 8); }
#pragma unroll
        for (int u = 0; u < 2; ++u) { const int r = r0 + u * NGW;
            { const float mx = fmaxf(l0[u], fmaxf(l1[u], l2[u])); float w0 = __expf(l0[u] - mx), w1 = __expf(l1[u] - mx), w2 = __expf(l2[u] - mx); const float inv = 1.0f / (w0 + w1 + w2); w0 *= inv; w1 *= inv; w2 *= inv;
              u32x4 o;
#pragma unroll
              for (int q = 0; q < 4; ++q) o[q] = pk2(w0 * bflo(a[u][q]) + w1 * bflo(b[u][q]) + w2 * bflo(c[u][q]), w0 * bfhi(a[u][q]) + w1 * bfhi(b[u][q]) + w2 * bfhi(c[u][q]));
              *(u32x4*)(YAD + (size_t)r * 1536 + 8 * lane) = o; }
            { float v[16]; float ss = 0.f;
#pragma unroll
              for (int e = 0; e < 16; ++e) { v[e] = bf_el(a0[u], a1[u], e) + bf_el(b0[u], b1[u], e); ss += v[e] * v[e]; }
              ss += __shfl_xor(ss, 1); ss += __shfl_xor(ss, 2); ss += __shfl_xor(ss, 4);
              const float rs = rsqrtf(ss * (1.0f / 128.0f) + EPSF);
#pragma unroll
              for (int e = 0; e < 16; ++e) v[e] = v[e] * rs * dg[e] * siluf_(bf_el(z0[u], z1[u], e));
              u32x4 o0, o1; o0.x = pk2(v[0], v[1]); o0.y = pk2(v[2], v[3]); o0.z = pk2(v[4], v[5]); o0.w = pk2(v[6], v[7]);
              o1.x = pk2(v[8], v[9]); o1.y = pk2(v[10], v[11]); o1.z = pk2(v[12], v[13]); o1.w = pk2(v[14], v[15]);
              *(u32x4*)(YAD + (size_t)r * 1536 + 512 + 16 * lane) = o0; *(u32x4*)(YAD + (size_t)r * 1536 + 512 + 16 * lane + 8) = o1; }
        }
    }
}

__device__ __forceinline__ void conv_act(const Params& p, const Batch& B) {
    const bf16_t* UP = (const bf16_t*)(p.ws + WS_PROJ); bf16_t* ACT = (bf16_t*)(p.ws + WS_PROJ + (size_t)TB * NUP * 2);
    const u32x4 z4 = {0u, 0u, 0u, 0u};
    constexpr int RB = 16;
    for (int t = blockIdx.x * 512 + ltid(); t < (TB / RB) * 352; t += gridDim.x * 512) {
        const int rb = t / 352, cg8 = (t - rb * 352) * 8, row0 = rb * RB; const int s0 = row0 & (B.L - 1);
        f32x4 wv[3][2], wg[3][2], bv[2], bg[2];
#pragma unroll
        for (int q = 0; q < 2; ++q) {
#pragma unroll
            for (int j = 0; j < 3; ++j) { wv[j][q] = *(const f32x4*)(p.ffn_conv_w + j * NUP + cg8 + 4 * q); wg[j][q] = *(const f32x4*)(p.ffn_conv_w + j * NUP + DFF + cg8 + 4 * q); }
            bv[q] = *(const f32x4*)(p.ffn_conv_b + cg8 + 4 * q); bg[q] = *(const f32x4*)(p.ffn_conv_b + DFF + cg8 + 4 * q); }
        const bf16_t* src = UP + (size_t)row0 * NUP + cg8;
        u32x4 vp = z4, gp = z4, vc, gc, vn, gn;
        if (s0 > 0) { vp = *(const u32x4*)(src - NUP); gp = *(const u32x4*)(src - NUP + DFF); }
        vc = *(const u32x4*)src; gc = *(const u32x4*)(src + DFF);
#pragma unroll
        for (int i = 0; i < RB; ++i) {
            vn = z4; gn = z4;
            if (i < RB - 1 || s0 + RB < B.L) { vn = *(const u32x4*)(src + (size_t)(i + 1) * NUP); gn = *(const u32x4*)(src + (size_t)(i + 1) * NUP + DFF); }
            float o[8];
#pragma unroll
            for (int e = 0; e < 8; ++e) { const int q = e >> 2, k = e & 3;
                const float val = bf_el(vp, z4, e) * wv[0][q][k] + bf_el(vc, z4, e) * wv[1][q][k] + bf_el(vn, z4, e) * wv[2][q][k] + bv[q][k];
                const float gt = bf_el(gp, z4, e) * wg[0][q][k] + bf_el(gc, z4, e) * wg[1][q][k] + bf_el(gn, z4, e) * wg[2][q][k] + bg[q][k];
                o[e] = siluf_(gt) * val; }
            u32x4 w; w.x = pk2(o[0], o[1]); w.y = pk2(o[2], o[3]); w.z = pk2(o[4], o[5]); w.w = pk2(o[6], o[7]);
            *(u32x4*)(ACT + (size_t)(row0 + i) * DFF + cg8) = w;
            vp = vc; gp = gc; vc = vn; gc = gn;
        }
    }
}

#ifndef EN_P0
#define EN_P0 1
#endif
#ifndef EN_PREP
#define EN_PREP 1
#endif
#ifndef EN_SCAN
#define EN_SCAN 1
#endif
#ifndef EN_ATT
#define EN_ATT 1
#endif
#ifndef EN_POST
#define EN_POST 1
#endif
#ifndef EN_CONV
#define EN_CONV 1
#endif
#ifndef EN_G1
#define EN_G1 1
#endif
#ifndef EN_G2
#define EN_G2 1
#endif
#ifndef EN_G3
#define EN_G3 1
#endif
#ifndef EN_G4
#define EN_G4 1
#endif
#ifndef EN_G5
#define EN_G5 1
#endif
#ifndef PROBE_POS
#define PROBE_POS -100
#endif
#ifndef REP_ATT
#define REP_ATT 1
#endif
#ifndef REP_P0
#define REP_P0 1
#endif
#ifndef REP_P3
#define REP_P3 1
#endif
#ifndef REP_SCAN
#define REP_SCAN 1
#endif
#ifndef REP_P5
#define REP_P5 1
#endif
#ifndef REP_P11
#define REP_P11 1
#endif
#ifndef REP_G1
#define REP_G1 1
#endif
#ifndef REP_G4
#define REP_G4 1
#endif
#ifndef REP_P9
#define REP_P9 1
#endif
#ifndef REP_SYNC
#define REP_SYNC 1
#endif
#define XB_TMO      128
#define XB_XCNT(j)  (256  + 64 * (j))
#define XB_XSUB(j)  (1280 + 64 * (j))
#define XB_XGEN(j)  (2304 + 64 * (j))
#define XB_TOP      3328
#define XB_TOPGEN   3392
#define XCD_BAR_WORDS 3456
#define XB_SPIN_CAP (1u << 18)

__device__ __forceinline__ unsigned xb_ld(unsigned* p)              { return __hip_atomic_load(p, __ATOMIC_RELAXED, __HIP_MEMORY_SCOPE_AGENT); }
__device__ __forceinline__ unsigned xb_add(unsigned* p, unsigned v) { return __hip_atomic_fetch_add(p, v, __ATOMIC_RELAXED, __HIP_MEMORY_SCOPE_AGENT); }
__device__ __forceinline__ unsigned xb_xcc_id() { return (unsigned)__builtin_amdgcn_s_getreg((3 << 11) | 20) & 0xFu; }
#define XB_SPIN(cond, bar) do { unsigned _sp = 0; while (cond) { __builtin_amdgcn_s_sleep(1); \
    if ((++_sp & 255u) == 0u) { if (xb_ld(&(bar)[XB_TMO])) break; if (_sp > XB_SPIN_CAP) { atomicAdd(&(bar)[XB_TMO], 1u); break; } } } } while (0)

struct XcdBarrier {
    unsigned* bar; unsigned x;
    volatile LAS unsigned* st;
};

__device__ __forceinline__ XcdBarrier xcd_barrier_post(unsigned* bar, volatile LAS unsigned* st) {
    XcdBarrier b; b.bar = bar; b.x = xb_xcc_id(); b.st = st;
    if (threadIdx.x == 0) (void)xb_add(&bar[XB_XCNT(b.x)], 1u);
    return b;
}
__device__ __forceinline__ void xcd_barrier_complete(unsigned* bar, unsigned x, unsigned& nloc, unsigned& nx) {
    const unsigned G = gridDim.x * gridDim.y * gridDim.z;
    unsigned sum, cnt, mine, sp = 0u;
    for (;;) {
        sum = 0u; cnt = 0u; mine = 0u;
#pragma unroll
        for (unsigned j = 0; j < 16; ++j) { const unsigned c = xb_ld(&bar[XB_XCNT(j)]); sum += c; cnt += (c > 0u) ? 1u : 0u; mine = (j == x) ? c : mine; }
        if (sum == G) break;
        __builtin_amdgcn_s_sleep(1);
        if ((++sp & 255u) == 0u) { if (xb_ld(&bar[XB_TMO])) break; if (sp > XB_SPIN_CAP) { atomicAdd(&bar[XB_TMO], 1u); break; } }
    }
    nloc = mine > 0u ? mine : 1u; nx = cnt > 0u ? cnt : 1u;
}

__device__ __forceinline__ void xcd_barrier(const XcdBarrier& b) {
    asm volatile("s_waitcnt vmcnt(0)" ::: "memory");
    __syncthreads();
    if (threadIdx.x == 0) {
        unsigned* bar = b.bar;
        __builtin_amdgcn_s_waitcnt(0);
        unsigned nloc = b.st[0], nx = b.st[1];
        if (nloc == 0u) { xcd_barrier_complete(bar, b.x, nloc, nx); b.st[0] = nloc; b.st[1] = nx; }
        const unsigned old = xb_add(&bar[XB_XSUB(b.x)], 1u);
        const unsigned gen = old / nloc;
        if (old + 1u == (gen + 1u) * nloc) {
            __builtin_amdgcn_fence(__ATOMIC_RELEASE, "agent");
            asm volatile("s_waitcnt vmcnt(0)" ::: "memory");
            const unsigned og = xb_add(&bar[XB_TOP], 1u);
            const unsigned tg = og / nx;
            if (og + 1u == (tg + 1u) * nx) xb_add(&bar[XB_TOPGEN], 1u);
            else XB_SPIN(xb_ld(&bar[XB_TOPGEN]) == tg, bar);
            __builtin_amdgcn_fence(__ATOMIC_ACQUIRE, "agent");
            xb_add(&bar[XB_XGEN(b.x)], 1u);
            asm volatile("s_waitcnt vmcnt(0)" ::: "memory");
        } else {
            XB_SPIN(xb_ld(&bar[XB_XGEN(b.x)]) == gen, bar);
            __builtin_amdgcn_fence(__ATOMIC_ACQUIRE, "agent");
            asm volatile("s_waitcnt vmcnt(0)" ::: "memory");
        }
    }
    __syncthreads();
}


__device__ __forceinline__ void grid_bar(unsigned* ctr, unsigned target) {
    asm volatile("s_waitcnt vmcnt(0) lgkmcnt(0)" ::: "memory");
    __syncthreads();
    if (threadIdx.x == 0) {
        __builtin_amdgcn_fence(__ATOMIC_RELEASE, "agent");
        asm volatile("s_waitcnt vmcnt(0)" ::: "memory");
        __hip_atomic_fetch_add(ctr, 1u, __ATOMIC_RELAXED, __HIP_MEMORY_SCOPE_AGENT);
        while (__hip_atomic_load(ctr, __ATOMIC_RELAXED, __HIP_MEMORY_SCOPE_AGENT) < target) __builtin_amdgcn_s_sleep(2);
        __builtin_amdgcn_fence(__ATOMIC_ACQUIRE, "agent");
        asm volatile("s_waitcnt vmcnt(0)" ::: "memory");
    }
    __syncthreads();
}
__global__ void __launch_bounds__(512) mega(Params p) {
    extern __shared__ __attribute__((aligned(16))) unsigned char lds_raw[];
    LAS unsigned char* L = (LAS unsigned char*)lds_raw;
    const int G = gridDim.x, bid = blockIdx.x, tid = ltid();
    int ph = 0;
#define PHASE_ON (ph >= p.ph_lo && ph < p.ph_hi)
#define SEAM() do { if (ph >= p.ph_lo && ph + 1 < p.ph_hi) { for (int rep_ = 0; rep_ < REP_SYNC; ++rep_) { xcd_barrier(xbar); } } PROBE_TICK(); ++ph; } while (0)
    unsigned nbar = 0;
#if PROBE_POS > -10
    unsigned long long t_prev = __builtin_amdgcn_s_memrealtime(), t_acc = 0;
#define PROBE_TICK() do { const unsigned long long t_now = __builtin_amdgcn_s_memrealtime(); const int pos_ = ph < 2 ? -1 - ph : (ph - 2) % 11; if (pos_ == PROBE_POS) t_acc += t_now - t_prev; t_prev = t_now; } while (0)
#else
#define PROBE_TICK() do {} while (0)
#endif
    unsigned* ctl = (unsigned*)(p.ws + WS_CTL);
    volatile LAS unsigned* xst = (volatile LAS unsigned*)(L + 143360 - 32);
    if (tid == 0) { xst[0] = 0u; xst[1] = 0u; }
    __syncthreads();
    XcdBarrier xbar = xcd_barrier_post(ctl + 1024, xst);
    float* MOD = (float*)(p.ws + WS_MOD);
    bf16_t* XN = (bf16_t*)(p.ws + WS_XN); bf16_t* PROJ = (bf16_t*)(p.ws + WS_PROJ);
    if (EN_P0 && PHASE_ON) for (int rep = 0; rep < REP_P0; ++rep) phase0(p, L);
    SEAM();
    if (PHASE_ON) { const Batch B0 = make_batch(p, 0); norm_mod_rows(p, B0, B0.x, p.norm1_g, 0, 1024, XN); }
    SEAM();
    for (int b = 0; b < 3; ++b) {
        const Batch B = make_batch(p, b);
        const int cbase = b == 0 ? 0 : 8 + (b - 1) * 4;
        if (EN_G1 && PHASE_ON) for (int rep = 0; rep < REP_G1; ++rep) { pg8::Gemm g{XN, (const bf16_t*)(p.ws + WS_WIN), TB, NPROJ, 1024}; pg8::StaticOrder S; S.init(TB, NPROJ, G, bid); EpiBf16S E{PROJ, NPROJ}; pg8::gemm_phase<EpiBf16S, pg8::StaticOrder>(L, g, S, E); }
        SEAM();
        if (EN_PREP && PHASE_ON) for (int rep = 0; rep < REP_P3; ++rep) { const int nit = (TB >> 6) * 4; for (int it = bid; it < nit; it += G) prep_item(p, B, it, L); }
        SEAM();
        if (PHASE_ON) {
            const int lgVS = 1; const int nscan = (B.nseq * 16) << lgVS, natt = B.nseq * 24 * (B.L >> 7);
            LAS int* slot = (LAS int*)(L + 143360 - 16);
            for (;;) {
                if (tid == 0) *slot = (int)atomicAdd(ctl + 64 * b, 1u);
                __syncthreads();
                const int idx = *slot;
                __syncthreads();
                if (idx >= nscan + natt) break;
                if (idx < nscan) { if (EN_SCAN) for (int rep = 0; rep < REP_SCAN; ++rep) scan_chain(p, B, idx >> lgVS, idx & ((1 << lgVS) - 1), lgVS, L); } else { if (EN_ATT) for (int rep = 0; rep < REP_ATT; ++rep) attn_item(p, B, idx - nscan, L); }
            }
        }
        SEAM();
        if (EN_POST && PHASE_ON) for (int rep = 0; rep < REP_P5; ++rep) post_mixer(p, B);
        SEAM();
        if (EN_G2 && PHASE_ON) {
            bf16_t* MERGED = (bf16_t*)(p.ws + WS_QKVD + (size_t)TB * 1536 * 2);
            pg8::Gemm g{(const bf16_t*)(p.ws + WS_QKVD), (const bf16_t*)(p.ws + WS_WA), TB, 1024, 1536}; pg8::StaticOrder S; S.init(TB, 1024, G, bid); EpiMerge E{PROJ + C_GA, PROJ + C_GD, NPROJ, MERGED}; pg8::gemm_phase<EpiMerge, pg8::StaticOrder>(L, g, S, E);
        }
        SEAM();
        if (EN_G3 && PHASE_ON) { const bf16_t* MERGED = (const bf16_t*)(p.ws + WS_QKVD + (size_t)TB * 1536 * 2);
            pg8::Gemm g{MERGED, (const bf16_t*)(p.ws + WS_WO), TB, 1024, 1024}; pg8::StaticOrder S; S.init(TB, 1024, G, bid); EpiResid E{B.x, B.out, MOD + 2048, B.lgL, cbase}; pg8::gemm_phase<EpiResid, pg8::StaticOrder>(L, g, S, E); }
        SEAM();
        if (PHASE_ON) for (int rep = 0; rep < REP_P9; ++rep) norm_mod_rows(p, B, B.out, p.norm2_g, 3072, 4096, XN);
        SEAM();
        if (EN_G4 && PHASE_ON) {
            pg8::StaticOrder S; S.init(65 * 256, NUP, G, bid);
            for (int i = 0; ; ++i) { pg8::Unit u; if (!S.next(i, u)) break;
                const int rowstart = 254 * u.pm - 1;
                pg8::Gemm g{XN + (ptrdiff_t)rowstart * 1024, (const bf16_t*)(p.ws + WS_WUP), 256, NUP, 1024};
                OneUnit S1{pg8::Unit{0, u.pn}};
                EpiConvFfn E{(bf16_t*)(p.ws + WS_PROJ + (size_t)TB * NUP * 2), p.ffn_conv_w, p.ffn_conv_b, rowstart, B.L};
                pg8::gemm_phase<EpiConvFfn, OneUnit>(L, g, S1, E); }
        }
        SEAM();
        if (EN_G5 && PHASE_ON) { pg8::Gemm g{(const bf16_t*)(p.ws + WS_PROJ + (size_t)TB * NUP * 2), (const bf16_t*)(p.ws + WS_WDN), TB, 1024, DFF}; pg8::StaticOrder S; S.init(TB, 1024, G, bid);
            EpiResid E{B.out, B.out, MOD + 5120, B.lgL, cbase}; pg8::gemm_phase<EpiResid, pg8::StaticOrder>(L, g, S, E); }
        SEAM();
        if (PHASE_ON) { final_norm_rows(B.out, p.norm_f_g); if (b < 2) { const Batch Bn = make_batch(p, b + 1); norm_mod_rows(p, Bn, Bn.x, p.norm1_g, 0, 1024, XN); } }
        SEAM();
    }
#if PROBE_POS > -10
    if (bid == 0 && tid == 0) { const unsigned long long t0 = __builtin_amdgcn_s_memrealtime(); while (__builtin_amdgcn_s_memrealtime() - t0 < 4ull * t_acc) __builtin_amdgcn_s_sleep(8); }
#endif
}
constexpr int N_PHASES = 2 + 3 * 10;

#ifndef MULTI_LAUNCH
#define MULTI_LAUNCH 0
#endif
extern "C" void kernel_launch(void* const* d_in, const int* in_sizes, int n_in, void* d_out, int out_size, void* d_ws, size_t ws_size, hipStream_t stream) {
    static int grid = 0;
    if (grid == 0) {
        if (n_in != 21 || ws_size < WS_END) { fprintf(stderr, "kernel_launch: need 21 inputs and %zu bytes of workspace (got %d, %zu)\n", (size_t)WS_END, n_in, ws_size); grid = -1; return; }
        int dev = 0, cus = 0, per_cu = 0;
        hipGetDevice(&dev); hipDeviceGetAttribute(&cus, hipDeviceAttributeMultiprocessorCount, dev);
        if (hipFuncSetAttribute((const void*)mega, hipFuncAttributeMaxDynamicSharedMemorySize, LDS_BYTES) != hipSuccess) { fprintf(stderr, "kernel_launch: hipFuncSetAttribute failed\n"); grid = -1; return; }
        if (hipOccupancyMaxActiveBlocksPerMultiprocessor(&per_cu, (const void*)mega, 512, LDS_BYTES) != hipSuccess || per_cu < 1) { fprintf(stderr, "kernel_launch: occupancy query says %d blocks/CU\n", per_cu); grid = -1; return; }
        grid = cus;
    }
    if (grid < 0) return;
    hipMemsetAsync((char*)d_ws + WS_CTL, 0, 20480, stream);
    Params p{};
    const float** pp = (const float**)&p;
    for (int i = 0; i < 21; ++i) pp[i] = (const float*)d_in[i];
    p.out = (float*)d_out; p.ws = (unsigned char*)d_ws;
#if MULTI_LAUNCH
    for (int ph = 0; ph < N_PHASES; ++ph) { p.ph_lo = ph; p.ph_hi = ph + 1; hipLaunchKernelGGL(mega, dim3(grid), dim3(512), LDS_BYTES, stream, p); }
#else
    p.ph_lo = 0; p.ph_hi = N_PHASES;
    void* args[] = {&p};
    hipError_t e = hipLaunchCooperativeKernel((const void*)mega, dim3(grid), dim3(512), args, LDS_BYTES, stream);
    if (e != hipSuccess) fprintf(stderr, "cooperative launch failed: %s (grid %d)\n", hipGetErrorString(e), grid);
#endif
}
```

```cpp
#include <hip/hip_runtime.h>
#include <cstdio>
namespace pg8 {
#define PG8_LAS __attribute__((address_space(3)))
typedef unsigned short bf16_t;
typedef short bf16x8 __attribute__((ext_vector_type(8)));
typedef float f32x4 __attribute__((ext_vector_type(4)));
typedef unsigned u32x4 __attribute__((ext_vector_type(4)));
constexpr int BM = 256, BK = 64, HALF = 128, HTB = HALF * BK * 2  , STAGE_BYTES = 8 * HTB, NXCD = 8, WGM = 8;

__host__ __device__ __forceinline__ int lds_byte(int r, int c) { const int st = (r >> 4) * 2 + (c >> 5), rr = r & 15, cc = c & 31, ob = rr * 64 + cc * 2; return st * 1024 + (ob ^ (((ob >> 9) & 1) << 5)); }
__host__ __device__ __forceinline__ void stage_rc(int b, int& R, int& C) { const int st = b / 1024, sb = b % 1024, swz = sb ^ (((sb >> 9) & 1) << 5); R = (st >> 1) * 16 + swz / 64; C = (st & 1) * 32 + (swz % 64) / 2; }
__host__ __device__ __forceinline__ int perm32(int rho) { const int n = rho >> 4, i = rho & 15; return 8 * (i >> 2) + 4 * n + (i & 3); }

struct Unit { int pm, pn; };
struct Gemm { const bf16_t* A; const bf16_t* Bt; int M, N, K; };

struct StaticOrder {
    int nM, nN, nwg, G, c;
    __host__ __device__ void init(int M, int N, int G_, int c_) { nM = M / BM; nN = N / BM; nwg = nM * nN; G = G_; c = c_; }
    __host__ __device__ bool next(int i, Unit& u) const {
        const long L = (long)i * G + c; if (L >= nwg) return false;
        int wgid = (int)L; { const int q = nwg / NXCD, r = nwg % NXCD, xcd = wgid % NXCD, off = wgid / NXCD; wgid = (xcd < r ? xcd * (q + 1) : r * (q + 1) + (xcd - r) * q) + off; }
        const int nig = WGM * nN, gid = wgid / nig, fm = gid * WGM, gsz = (nM - fm) < WGM ? (nM - fm) : WGM;
        u.pm = fm + ((wgid % nig) % gsz); u.pn = (wgid % nig) / gsz; return true;
    }
    __device__ __forceinline__ void a_ready(const Unit&) const {}
    __device__ __forceinline__ void done(const Unit&) const {}
};
__device__ __forceinline__ unsigned cvt_pk_bf16(float lo, float hi) { unsigned r; asm volatile("v_cvt_pk_bf16_f32 %0, %1, %2" : "=v"(r) : "v"(lo), "v"(hi)); return r; }
typedef float f32x2 __attribute__((ext_vector_type(2)));
template <class Epi, class Sched>
__device__ __forceinline__ void gemm_phase(PG8_LAS unsigned char* lds, const Gemm g, const Sched& S, const Epi& E) {
    int tid_ = threadIdx.x; asm volatile("" : "+v"(tid_)); const int tid = tid_, wid = __builtin_amdgcn_readfirstlane(tid >> 6), lane = tid & 63, wr = wid >> 2, wc = wid & 3, fr = lane & 15, fq = lane >> 4;
    const int K = g.K, nt = K / BK;
    unsigned voffA[2], voffB[2];
#pragma unroll
    for (int i = 0; i < 2; ++i) { int R, C; stage_rc(tid * 16 + i * 8192, R, C); const int Rb = Epi::PERM ? ((R & ~31) + perm32(R & 31)) : R;
        voffA[i] = (unsigned)(R * K + C) * 2u; voffB[i] = (unsigned)(Rb * K + C) * 2u; }
    const size_t kstep = (size_t)(BK * 2);
    const size_t hstep = (size_t)HALF * K * 2;
    const size_t tstep = 2 * hstep;
    const unsigned ldsw = (unsigned)wid * 1024u;
    const int aoff = lds_byte(wr * 64 + fr, fq * 8), boff = lds_byte(wc * 32 + fr, fq * 8);
#define PG8_SA(b, h) (((b) * 2 + (h)) * HTB)
#define PG8_SB(b, h) ((4 + (b) * 2 + (h)) * HTB)
#define PG8_STAGE(bufoff, gbase, voff) do { _Pragma("unroll") for (int _i = 0; _i < 2; ++_i) \
        __builtin_amdgcn_global_load_lds((const unsigned*)((const char*)(gbase) + (voff)[_i]), (PG8_LAS unsigned*)(lds + (bufoff) + ldsw + _i * 8192), 16, 0, 0); } while (0)
#define PG8_LDA(dst, b, h) do { _Pragma("unroll") for (int m = 0; m < 4; ++m) _Pragma("unroll") for (int k = 0; k < 2; ++k) dst[m][k] = *(const PG8_LAS bf16x8*)(lds + PG8_SA(b, h) + aoff + m * 2048 + k * 1024); } while (0)
#define PG8_LDB(dst, b, h) do { _Pragma("unroll") for (int n = 0; n < 2; ++n) _Pragma("unroll") for (int k = 0; k < 2; ++k) dst[n][k] = *(const PG8_LAS bf16x8*)(lds + PG8_SB(b, h) + boff + n * 2048 + k * 1024); } while (0)
#define PG8_MMA(ai, bj, At, Bt) do { __builtin_amdgcn_s_setprio(1); _Pragma("unroll") for (int m = 0; m < 4; ++m) _Pragma("unroll") for (int n = 0; n < 2; ++n) _Pragma("unroll") for (int k = 0; k < 2; ++k) \
        acc[ai][bj][m][n] = __builtin_amdgcn_mfma_f32_16x16x32_bf16(Bt[n][k], At[m][k], acc[ai][bj][m][n], 0, 0, 0); __builtin_amdgcn_s_setprio(0); } while (0)
#define PG8_WAIT_V(n) asm volatile("s_waitcnt vmcnt(" #n ")" ::: "memory")
#define PG8_WAIT_L(n) asm volatile("s_waitcnt lgkmcnt(" #n ")" ::: "memory")
#define PG8_BAR __builtin_amdgcn_s_barrier()
#define PG8_SCHED __builtin_amdgcn_sched_barrier(0)
    Unit cur, nxt; int ui = 0;
    if (!S.next(0, cur)) return;
    f32x4 acc[2][2][4][2];
#pragma unroll
    for (int a = 0; a < 2; ++a)
#pragma unroll
        for (int b = 0; b < 2; ++b)
#pragma unroll
            for (int m = 0; m < 4; ++m)
#pragma unroll
                for (int n = 0; n < 2; ++n) acc[a][b][m][n] = (f32x4){0.f, 0.f, 0.f, 0.f};
    bf16x8 At[4][2], B0[2][2], B1[2][2];
    const char* cA = (const char*)g.A + (size_t)cur.pm * tstep; const char* cB = (const char*)g.Bt + (size_t)cur.pn * tstep;
    S.a_ready(cur);
    PG8_STAGE(PG8_SB(0, 0), cB, voffB); PG8_STAGE(PG8_SA(0, 0), cA, voffA); PG8_STAGE(PG8_SB(0, 1), cB + hstep, voffB); PG8_STAGE(PG8_SA(0, 1), cA + hstep, voffA);
    if (wr == 1) PG8_BAR;
    PG8_WAIT_V(4); PG8_BAR;
    PG8_STAGE(PG8_SB(1, 0), cB + kstep, voffB); PG8_STAGE(PG8_SA(1, 0), cA + kstep, voffA); PG8_STAGE(PG8_SB(1, 1), cB + hstep + kstep, voffB);
    PG8_WAIT_V(6); PG8_BAR;
    for (;;) {
        const bool has_next = S.next(ui + 1, nxt);
        const char* nA = has_next ? (const char*)g.A + (size_t)nxt.pm * tstep : cA; const char* nB = has_next ? (const char*)g.Bt + (size_t)nxt.pn * tstep : cB;
        int t = 0;
#pragma unroll
        for (int seg = 0; seg < (Epi::KHOOK > 0 ? 2 : 1); ++seg) {
        const int tend = (Epi::KHOOK > 0 && seg == 0) ? Epi::KHOOK : nt;
        for (; t < tend; t += 2) {
            const bool last = (t == nt - 2);
            const char* a1 = cA + (size_t)(t + 1) * kstep;
            const char* a2 = last ? nA : cA + (size_t)(t + 2) * kstep; const char* b2 = last ? nB : cB + (size_t)(t + 2) * kstep;
            const char* a3 = a2 + kstep; const char* b3 = b2 + kstep;
            if (last && has_next) S.a_ready(nxt);
            PG8_LDB(B0, 0, 0); PG8_SCHED; PG8_LDA(At, 0, 0); PG8_STAGE(PG8_SA(1, 1), a1 + hstep, voffA);
            PG8_WAIT_L(8); PG8_BAR; PG8_WAIT_L(0); PG8_MMA(0, 0, At, B0); PG8_BAR; PG8_SCHED;
            PG8_LDB(B1, 0, 1); PG8_STAGE(PG8_SB(0, 0), b2, voffB);
            PG8_BAR; PG8_WAIT_L(0); PG8_MMA(0, 1, At, B1); PG8_BAR;
            PG8_LDA(At, 0, 1); PG8_STAGE(PG8_SA(0, 0), a2, voffA);
            PG8_BAR; PG8_WAIT_L(0); PG8_MMA(1, 0, At, B0); PG8_BAR; PG8_SCHED;
            PG8_STAGE(PG8_SB(0, 1), b2 + hstep, voffB);
            PG8_WAIT_V(6); PG8_BAR; PG8_MMA(1, 1, At, B1); PG8_BAR;
            PG8_LDB(B0, 1, 0); PG8_SCHED; PG8_LDA(At, 1, 0); PG8_STAGE(PG8_SA(0, 1), a2 + hstep, voffA);
            PG8_WAIT_L(8); PG8_BAR; PG8_WAIT_L(0); PG8_MMA(0, 0, At, B0); PG8_BAR; PG8_SCHED;
            PG8_LDB(B1, 1, 1); PG8_STAGE(PG8_SB(1, 0), b3, voffB);
            PG8_BAR; PG8_WAIT_L(0); PG8_MMA(0, 1, At, B1); PG8_BAR;
            PG8_LDA(At, 1, 1); PG8_STAGE(PG8_SA(1, 0), a3, voffA);
            PG8_BAR; PG8_WAIT_L(0); PG8_MMA(1, 0, At, B0); PG8_BAR; PG8_SCHED;
            PG8_STAGE(PG8_SB(1, 1), b3 + hstep, voffB);
            PG8_WAIT_V(6); PG8_BAR; PG8_MMA(1, 1, At, B1); PG8_BAR;
        }
        if constexpr (Epi::KHOOK > 0) { if (seg == 0) E.mid(acc, cur, wr, wc, fr, fq); }
        }
        if constexpr (!Epi::AFTER_DRAIN) { E(acc, cur, wr, wc, fr, fq); S.done(cur); }
        if (!has_next) break;
#pragma unroll
        for (int a = 0; a < 2; ++a)
#pragma unroll
            for (int b = 0; b < 2; ++b)
#pragma unroll
                for (int m = 0; m < 4; ++m)
#pragma unroll
                    for (int n = 0; n < 2; ++n) acc[a][b][m][n] = (f32x4){0.f, 0.f, 0.f, 0.f};
        cur = nxt; cA = nA; cB = nB; ++ui;
    }
    PG8_WAIT_V(0);
    if (wr == 0) PG8_BAR;
    PG8_BAR;
    if constexpr (Epi::AFTER_DRAIN) { E.fused(acc, cur, wr, wc, fr, fq, lds, wid, lane); S.done(cur); }
#undef PG8_SA
#undef PG8_SB
#undef PG8_STAGE
#undef PG8_LDA
#undef PG8_LDB
#undef PG8_MMA
#undef PG8_WAIT_V
#undef PG8_WAIT_L
#undef PG8_BAR
#undef PG8_SCHED
}
}

#define LAS __attribute__((address_space(3)))
using pg8::bf16_t; using pg8::bf16x8; using pg8::f32x4; using pg8::u32x4;
typedef unsigned u32x2 __attribute__((ext_vector_type(2)));
typedef float f32x2 __attribute__((ext_vector_type(2)));
typedef short bf16x4 __attribute__((ext_vector_type(4)));

constexpr int DM = 1024, TB = 16384, NPROJ = 11008, DFF = 2816, NUP = 5632;
constexpr int C_QA = 0, C_KA = 1536, C_VA = 3072, C_QD = 4608, C_KD = 5632, C_VD = 6656, C_ZD = 7680, C_GA = 8704, C_GD = 9728, C_AB = 10752;
constexpr float EPSF = 1e-6f;
constexpr int LDS_BYTES = 147456;

constexpr size_t al256(size_t x) { return (x + 255) & ~(size_t)255; }
constexpr size_t WS_CTL = 0;
constexpr size_t WS_MOD = 20480;
constexpr size_t WS_ROPE = WS_MOD + al256((size_t)16 * 6144 * 4);
constexpr size_t WS_WIN = WS_ROPE + (size_t)4096 * 32 * 8;
constexpr size_t WS_WA = WS_WIN + (size_t)NPROJ * 1024 * 2;
constexpr size_t WS_WD = WS_WA + (size_t)1024 * 512 * 2;
constexpr size_t WS_WO = WS_WD + (size_t)1024 * 1024 * 2;
constexpr size_t WS_WUP = WS_WO + (size_t)1024 * 1024 * 2;
constexpr size_t WS_WDN = WS_WUP + (size_t)NUP * 1024 * 2;
constexpr size_t WS_XN = WS_WDN + (size_t)1024 * DFF * 2;
constexpr size_t WS_PROJ = WS_XN + (size_t)TB * 1024 * 2;
constexpr size_t WS_QKVD = WS_PROJ + (size_t)TB * NPROJ * 2;
constexpr size_t WS_TP = WS_QKVD + (size_t)TB * 3072 * 2;
constexpr size_t WS_EG = WS_TP + (size_t)4096 * 16384;
constexpr size_t WS_OD = WS_EG + (size_t)4096 * 512;
constexpr size_t WS_LSE = WS_OD + (size_t)2 * TB * 1024 * 2;
constexpr size_t WS_END = WS_LSE + (size_t)TB * 24 * 4;
static_assert(WS_END <= ((size_t)700 << 20), "workspace");

struct Params {
    const float* x_prompt; const float* x_sample; const float* c_prompt; const float* c_sample;
    const float* w_ada; const float* b_ada; const float* norm1_g; const float* w_in; const float* conv_qkv_w;
    const float* a_log; const float* dt_bias; const float* dn_norm_g; const float* w_br_attn; const float* w_br_dn;
    const float* w_out; const float* norm2_g; const float* w_up; const float* ffn_conv_w; const float* ffn_conv_b;
    const float* w_down; const float* norm_f_g;
    float* out; unsigned char* ws;
    int ph_lo, ph_hi;
};

__constant__ double INVF[32] = {1.0, 0.7498942093324559, 0.5623413251903491, 0.4216965034285822, 0.31622776601683794, 0.23713737056616552, 0.1778279410038923, 0.1333521432163324, 0.1, 0.07498942093324558, 0.05623413251903491, 0.042169650342858224, 0.03162277660168379, 0.023713737056616554, 0.01778279410038923, 0.01333521432163324, 0.01, 0.007498942093324558, 0.005623413251903491, 0.004216965034285823, 0.0031622776601683794, 0.0023713737056616554, 0.0017782794100389228, 0.001333521432163324, 0.001, 0.0007498942093324559, 0.0005623413251903491, 0.00042169650342858224, 0.00031622776601683794, 0.00023713737056616554, 0.00017782794100389227, 0.0001333521432163324};

__device__ __forceinline__ float bf2f(unsigned short b) { return __uint_as_float(((unsigned)b) << 16); }
__device__ __forceinline__ float bflo(unsigned w) { return __uint_as_float(w << 16); }
__device__ __forceinline__ float bfhi(unsigned w) { return __uint_as_float(w & 0xffff0000u); }
typedef __bf16 bf16x2n_t __attribute__((ext_vector_type(2)));
__device__ __forceinline__ unsigned pk2(float lo, float hi) { const f32x2 v = {lo, hi}; const bf16x2n_t r = __builtin_convertvector(v, bf16x2n_t); return __builtin_bit_cast(unsigned, r); }
__device__ __forceinline__ unsigned short f2bf(float f) { return (unsigned short)(pk2(f, 0.f) & 0xffffu); }
__device__ __forceinline__ float sigmoidf_(float x) { return 1.0f / (1.0f + __expf(-x)); }
__device__ __forceinline__ float siluf_(float x) { return x / (1.0f + __expf(-x)); }
__device__ __forceinline__ float wave_sum(float v) {
#pragma unroll
    for (int o = 32; o >= 1; o >>= 1) v += __shfl_xor(v, o);
    return v;
}
__device__ __forceinline__ int ltid() { int t = threadIdx.x; asm volatile("" : "+v"(t)); return t; }
struct Batch { int b, L, lgL, nseq; const float* x; float* out; };
__device__ __forceinline__ Batch make_batch(const Params& p, int b) {
    Batch B; B.b = b; B.L = b == 0 ? 2048 : 4096; B.lgL = b == 0 ? 11 : 12; B.nseq = TB >> B.lgL;
    B.x = b == 0 ? p.x_prompt : p.x_sample + (size_t)(b - 1) * TB * DM; B.out = p.out + (size_t)b * TB * DM; return B;
}
__device__ __forceinline__ int cond_index(const Batch& B, int row) { const int s = row >> B.lgL; return B.b == 0 ? s : 8 + (B.b - 1) * 4 + s; }

__device__ __forceinline__ float bf_el8(const u32x4& a, int e) { const unsigned w = a[(e >> 1) & 3]; return (e & 1) ? bfhi(w) : bflo(w); }
__device__ __forceinline__ void transpose_tile(const float* __restrict__ src, int Nsrc, bf16_t* __restrict__ dst, int K, int kt, int nt, int mode, LAS float* T, int koff = 0) {
    const int tid = ltid();
    const int c4 = (tid & 15) * 4, r0 = tid >> 4;
    const int j = nt * 64 + c4; int sj = j;
    if (mode == 1) sj = (j < 8704) ? j : (j < 10752) ? j + 32 : (j < 10784) ? j - 2048 : -1;
    if (mode == 2) { const int pn = j >> 8, jj = j & 255; sj = jj < 128 ? 128 * pn + jj : DFF + 128 * pn + (jj - 128); }
#pragma unroll
    for (int i = 0; i < 2; ++i) {
        const int r = r0 + 32 * i;
        f32x4 v = {0.f, 0.f, 0.f, 0.f};
        if (sj >= 0) v = *(const f32x4*)(src + (size_t)(kt * 64 + r) * Nsrc + sj);
        T[r * 65 + c4 + 0] = v[0]; T[r * 65 + c4 + 1] = v[1]; T[r * 65 + c4 + 2] = v[2]; T[r * 65 + c4 + 3] = v[3];
    }
    __syncthreads();
    const int n = tid >> 3, kp = (tid & 7) * 8;
    u32x4 w;
    w.x = pk2(T[(kp + 0) * 65 + n], T[(kp + 1) * 65 + n]); w.y = pk2(T[(kp + 2) * 65 + n], T[(kp + 3) * 65 + n]);
    w.z = pk2(T[(kp + 4) * 65 + n], T[(kp + 5) * 65 + n]); w.w = pk2(T[(kp + 6) * 65 + n], T[(kp + 7) * 65 + n]);
    *(u32x4*)(dst + (size_t)(nt * 64 + n) * K + koff + kt * 64 + kp) = w;
    __syncthreads();
}

__device__ __forceinline__ void mod_item(const Params& p, int item, LAS unsigned char* L) {
    LAS float* sc = (LAS float*)L;
    LAS float* red = (LAS float*)(L + 65536);
    const int tid = ltid(), lane = tid & 63, wid = tid >> 6;
    for (int e = tid; e < 16384; e += 512) { const int r = e >> 10, k = e & 1023; const float c = r < 8 ? p.c_prompt[r * 1024 + k] : p.c_sample[(r - 8) * 1024 + k]; sc[k * 16 + r] = siluf_(c); }
    __syncthreads();
    const int j = item * 64 + lane;
    float acc[16];
#pragma unroll
    for (int r = 0; r < 16; ++r) acc[r] = 0.f;
    for (int k = wid * 128; k < wid * 128 + 128; ++k) {
        const float w = p.w_ada[(size_t)k * 6144 + j];
#pragma unroll
        for (int q = 0; q < 4; ++q) { const f32x4 s = *(const LAS f32x4*)(sc + k * 16 + 4 * q);
            acc[4 * q + 0] += w * s[0]; acc[4 * q + 1] += w * s[1]; acc[4 * q + 2] += w * s[2]; acc[4 * q + 3] += w * s[3]; }
    }
#pragma unroll
    for (int r = 0; r < 16; ++r) red[(wid * 16 + r) * 64 + lane] = acc[r];
    __syncthreads();
    float* MOD = (float*)(p.ws + WS_MOD);
    for (int e = tid; e < 1024; e += 512) { const int r = e >> 6, l = e & 63; float s = 0.f;
#pragma unroll
        for (int w = 0; w < 8; ++w) s += red[(w * 16 + r) * 64 + l];
        MOD[r * 6144 + item * 64 + l] = s + p.b_ada[item * 64 + l]; }
    __syncthreads();
}

__device__ __forceinline__ void phase0(const Params& p, LAS unsigned char* L) {
    const int G = gridDim.x, bid = blockIdx.x, tid = ltid();
    { f32x2* R = (f32x2*)(p.ws + WS_ROPE);
      for (int e = bid * 512 + tid; e < 4096 * 32; e += G * 512) { const int pos = e >> 5, i = e & 31;
          const double rev = (double)pos * INVF[i] * 0.15915494309189535; const double fr = rev - __builtin_rint(rev);
          f32x2 cs; cs.x = __builtin_amdgcn_cosf((float)fr); cs.y = __builtin_amdgcn_sinf((float)fr); R[e] = cs; } }
    if (bid >= G - 96) mod_item(p, bid - (G - 96), L);
    constexpr int I_IN = 16 * 172, I_A = 8 * 16, I_D = 16 * 16, I_O = 16 * 16, I_UP = 16 * 88, I_DN = 44 * 16;
    constexpr int NIT = I_IN + I_A + I_D + I_O + I_UP + I_DN;
    LAS float* T = (LAS float*)L;
    const int tid_ = ltid(), c4 = (tid_ & 15) * 4, r0 = tid_ >> 4, n_ = tid_ >> 3, kp = (tid_ & 7) * 8;
    for (int it0 = bid; it0 < NIT; it0 += 2 * G) {
        const float* src[2]; bf16_t* dst[2]; int Nsrc[2], K[2], kt[2], nt[2], mode[2], koff[2]; bool on[2];
#pragma unroll
        for (int u = 0; u < 2; ++u) { int r = it0 + u * G; on[u] = r < NIT; if (!on[u]) r = it0; koff[u] = 0; mode[u] = 0;
            if (r < I_IN) { src[u] = p.w_in; Nsrc[u] = 10784; dst[u] = (bf16_t*)(p.ws + WS_WIN); K[u] = 1024; kt[u] = r & 15; nt[u] = r >> 4; mode[u] = 1; }
            else if ((r -= I_IN) < I_A) { src[u] = p.w_br_attn; Nsrc[u] = 1024; dst[u] = (bf16_t*)(p.ws + WS_WA); K[u] = 1536; kt[u] = r & 7; nt[u] = r >> 3; }
            else if ((r -= I_A) < I_D) { src[u] = p.w_br_dn; Nsrc[u] = 1024; dst[u] = (bf16_t*)(p.ws + WS_WA); K[u] = 1536; kt[u] = r & 15; nt[u] = r >> 4; koff[u] = 512; }
            else if ((r -= I_D) < I_O) { src[u] = p.w_out; Nsrc[u] = 1024; dst[u] = (bf16_t*)(p.ws + WS_WO); K[u] = 1024; kt[u] = r & 15; nt[u] = r >> 4; }
            else if ((r -= I_O) < I_UP) { src[u] = p.w_up; Nsrc[u] = NUP; dst[u] = (bf16_t*)(p.ws + WS_WUP); K[u] = 1024; kt[u] = r & 15; nt[u] = r >> 4; mode[u] = 2; }
            else { r -= I_UP; src[u] = p.w_down; Nsrc[u] = 1024; dst[u] = (bf16_t*)(p.ws + WS_WDN); K[u] = DFF; kt[u] = r % 44; nt[u] = r / 44; } }
        f32x4 v[2][2];
#pragma unroll
        for (int u = 0; u < 2; ++u) { const int j = nt[u] * 64 + c4; int sj = j;
            if (mode[u] == 1) sj = (j < 8704) ? j : (j < 10752) ? j + 32 : (j < 10784) ? j - 2048 : -1;
            if (mode[u] == 2) { const int pn = j >> 8, jj = j & 255; sj = jj < 128 ? 128 * pn + jj : DFF + 128 * pn + (jj - 128); }
#pragma unroll
            for (int i = 0; i < 2; ++i) { v[u][i] = (f32x4){0.f, 0.f, 0.f, 0.f}; if (sj >= 0) v[u][i] = *(const f32x4*)(src[u] + (size_t)(kt[u] * 64 + r0 + 32 * i) * Nsrc[u] + sj); } }
#pragma unroll
        for (int u = 0; u < 2; ++u)
#pragma unroll
            for (int i = 0; i < 2; ++i) { LAS float* tp = T + u * 4160 + (r0 + 32 * i) * 65 + c4; tp[0] = v[u][i][0]; tp[1] = v[u][i][1]; tp[2] = v[u][i][2]; tp[3] = v[u][i][3]; }
        __syncthreads();
#pragma unroll
        for (int u = 0; u < 2; ++u) if (on[u]) { const LAS float* tq = T + u * 4160 + kp * 65 + n_; u32x4 w;
            w.x = pk2(tq[0], tq[65]); w.y = pk2(tq[130], tq[195]); w.z = pk2(tq[260], tq[325]); w.w = pk2(tq[390], tq[455]);
            *(u32x4*)(dst[u] + (size_t)(nt[u] * 64 + n_) * K[u] + koff[u] + kt[u] * 64 + kp) = w; }
        __syncthreads();
    }
}

__device__ __forceinline__ void norm_mod_rows(const Params& p, const Batch& B, const float* __restrict__ xin, const float* __restrict__ g, int sh_off, int sc_off, bf16_t* __restrict__ out) {
    const int lane = ltid() & 63, gw = blockIdx.x * 8 + (ltid() >> 6), NGW = gridDim.x * 8;
    const float* MOD = (const float*)(p.ws + WS_MOD);
    f32x4 gv[4];
#pragma unroll
    for (int i = 0; i < 4; ++i) gv[i] = *(const f32x4*)(g + 4 * lane + 256 * i);
    for (int r = gw; r < TB; r += 2 * NGW) {
        const int r1 = r + NGW; const bool has1 = r1 < TB; const int rb = has1 ? r1 : r;
        const float* xa = xin + (size_t)r * DM; const float* xb = xin + (size_t)rb * DM;
        f32x4 va[4], vb[4]; float sa = 0.f, sb = 0.f;
#pragma unroll
        for (int i = 0; i < 4; ++i) { va[i] = *(const f32x4*)(xa + 4 * lane + 256 * i); vb[i] = *(const f32x4*)(xb + 4 * lane + 256 * i); }
#pragma unroll
        for (int i = 0; i < 4; ++i) { sa += va[i][0] * va[i][0] + va[i][1] * va[i][1] + va[i][2] * va[i][2] + va[i][3] * va[i][3]; sb += vb[i][0] * vb[i][0] + vb[i][1] * vb[i][1] + vb[i][2] * vb[i][2] + vb[i][3] * vb[i][3]; }
        const float rsa = rsqrtf(wave_sum(sa) * (1.0f / DM) + EPSF), rsb = rsqrtf(wave_sum(sb) * (1.0f / DM) + EPSF);
        const float* ma = MOD + (size_t)cond_index(B, r) * 6144; const float* mb = MOD + (size_t)cond_index(B, rb) * 6144;
#pragma unroll
        for (int i = 0; i < 4; ++i) { const f32x4 sc = *(const f32x4*)(ma + sc_off + 4 * lane + 256 * i), sh = *(const f32x4*)(ma + sh_off + 4 * lane + 256 * i);
            const f32x4 y = va[i] * rsa * gv[i] * (sc + 1.0f) + sh; u32x2 w; w.x = pk2(y[0], y[1]); w.y = pk2(y[2], y[3]);
            *(u32x2*)(out + (size_t)r * DM + 4 * lane + 256 * i) = w; }
        if (has1) {
#pragma unroll
            for (int i = 0; i < 4; ++i) { const f32x4 sc = *(const f32x4*)(mb + sc_off + 4 * lane + 256 * i), sh = *(const f32x4*)(mb + sh_off + 4 * lane + 256 * i);
                const f32x4 y = vb[i] * rsb * gv[i] * (sc + 1.0f) + sh; u32x2 w; w.x = pk2(y[0], y[1]); w.y = pk2(y[2], y[3]);
                *(u32x2*)(out + (size_t)r1 * DM + 4 * lane + 256 * i) = w; } }
    }
}
__device__ __forceinline__ void final_norm_rows(float* __restrict__ io, const float* __restrict__ g) {
    const int lane = ltid() & 63, gw = blockIdx.x * 8 + (ltid() >> 6), NGW = gridDim.x * 8;
    f32x4 gv[4];
#pragma unroll
    for (int i = 0; i < 4; ++i) gv[i] = *(const f32x4*)(g + 4 * lane + 256 * i);
    for (int r = gw; r < TB; r += 2 * NGW) {
        const int r1 = r + NGW; const bool has1 = r1 < TB; const int rb = has1 ? r1 : r;
        float* xa = io + (size_t)r * DM; float* xb = io + (size_t)rb * DM; f32x4 va[4], vb[4]; float sa = 0.f, sb = 0.f;
#pragma unroll
        for (int i = 0; i < 4; ++i) { va[i] = *(const f32x4*)(xa + 4 * lane + 256 * i); vb[i] = *(const f32x4*)(xb + 4 * lane + 256 * i); }
#pragma unroll
        for (int i = 0; i < 4; ++i) { sa += va[i][0] * va[i][0] + va[i][1] * va[i][1] + va[i][2] * va[i][2] + va[i][3] * va[i][3]; sb += vb[i][0] * vb[i][0] + vb[i][1] * vb[i][1] + vb[i][2] * vb[i][2] + vb[i][3] * vb[i][3]; }
        const float rsa = rsqrtf(wave_sum(sa) * (1.0f / DM) + EPSF), rsb = rsqrtf(wave_sum(sb) * (1.0f / DM) + EPSF);
#pragma unroll
        for (int i = 0; i < 4; ++i) *(f32x4*)(xa + 4 * lane + 256 * i) = va[i] * rsa * gv[i];
        if (has1) {
#pragma unroll
            for (int i = 0; i < 4; ++i) *(f32x4*)(xb + 4 * lane + 256 * i) = vb[i] * rsb * gv[i]; }
    }
}

struct EpiBf16S {
    static constexpr bool PERM = true, AFTER_DRAIN = false; static constexpr int KHOOK = 0;
    bf16_t* O; int ldc;
    __device__ __forceinline__ void operator()(const f32x4 (&acc)[2][2][4][2], const pg8::Unit& u, int wr, int wc, int fr, int fq) const {
        const int row0 = u.pm * 256 + wr * 64 + fr, col0 = u.pn * 256 + wc * 32 + 8 * fq;
#pragma unroll
        for (int ai = 0; ai < 2; ++ai)
#pragma unroll
            for (int m = 0; m < 4; ++m) { bf16_t* rowp = O + (size_t)(row0 + ai * 128 + m * 16) * ldc + col0;
#pragma unroll
                for (int bj = 0; bj < 2; ++bj) { const f32x4 v0 = acc[ai][bj][m][0], v1 = acc[ai][bj][m][1];
                    u32x4 w; w.x = pk2(v0[0], v0[1]); w.y = pk2(v0[2], v0[3]); w.z = pk2(v1[0], v1[1]); w.w = pk2(v1[2], v1[3]);
                    *(u32x4*)(rowp + bj * 128) = w; } }
    }
};
struct EpiMerge {
    static constexpr bool PERM = true, AFTER_DRAIN = false; static constexpr int KHOOK = 8;
    const bf16_t* ga; const bf16_t* gd; int ldg; bf16_t* O;
    __device__ __forceinline__ void mid(f32x4 (&acc)[2][2][4][2], const pg8::Unit& u, int wr, int wc, int fr, int fq) const {
        const int row0 = u.pm * 256 + wr * 64 + fr, col0 = u.pn * 256 + wc * 32 + 8 * fq;
        size_t ro = (size_t)row0 * ldg + col0;
#pragma unroll
        for (int ai = 0; ai < 2; ++ai) {
#pragma unroll
            for (int m = 0; m < 4; ++m) {
#pragma unroll
                for (int bj = 0; bj < 2; ++bj) { const u32x4 a = *(const u32x4*)(ga + ro + bj * 128), d = *(const u32x4*)(gd + ro + bj * 128);
#pragma unroll
                    for (int q = 0; q < 4; ++q) { const float r0 = (1.0f + __expf(-bflo(d[q]))) * __builtin_amdgcn_rcpf(1.0f + __expf(-bflo(a[q]))), r1 = (1.0f + __expf(-bfhi(d[q]))) * __builtin_amdgcn_rcpf(1.0f + __expf(-bfhi(a[q])));
                        acc[ai][bj][m][q >> 1][2 * (q & 1)] *= r0; acc[ai][bj][m][q >> 1][2 * (q & 1) + 1] *= r1; }
                    asm volatile("" : "+v"(ro) :: "memory"); }
                ro += (size_t)16 * ldg; }
            ro += (size_t)64 * ldg; }
    }
    __device__ __forceinline__ void operator()(const f32x4 (&acc)[2][2][4][2], const pg8::Unit& u, int wr, int wc, int fr, int fq) const {
        const int row0 = u.pm * 256 + wr * 64 + fr, col0 = u.pn * 256 + wc * 32 + 8 * fq;
#pragma unroll
        for (int ai = 0; ai < 2; ++ai)
#pragma unroll
            for (int m = 0; m < 4; ++m) { const int row = row0 + ai * 128 + m * 16;
#pragma unroll
                for (int bj = 0; bj < 2; ++bj) { const u32x4 d = *(const u32x4*)(gd + (size_t)row * ldg + col0 + bj * 128); const f32x4 v0 = acc[ai][bj][m][0], v1 = acc[ai][bj][m][1];
                    u32x4 w; w.x = pk2(v0[0] * sigmoidf_(bflo(d.x)), v0[1] * sigmoidf_(bfhi(d.x))); w.y = pk2(v0[2] * sigmoidf_(bflo(d.y)), v0[3] * sigmoidf_(bfhi(d.y)));
                    w.z = pk2(v1[0] * sigmoidf_(bflo(d.z)), v1[1] * sigmoidf_(bfhi(d.z))); w.w = pk2(v1[2] * sigmoidf_(bflo(d.w)), v1[3] * sigmoidf_(bfhi(d.w)));
                    *(u32x4*)(O + (size_t)row * DM + col0 + bj * 128) = w; }
                asm volatile("" ::: "memory"); }
    }
};
struct OneUnit {
    pg8::Unit u0;
    __device__ __forceinline__ bool next(int i, pg8::Unit& u) const { if (i != 0) return false; u = u0; return true; }
    __device__ __forceinline__ void a_ready(const pg8::Unit&) const {}
    __device__ __forceinline__ void done(const pg8::Unit&) const {}
};
struct EpiConvFfn {
    static constexpr bool PERM = false, AFTER_DRAIN = true; static constexpr int KHOOK = 0;
    bf16_t* ACT; const float* cw; const float* cb; int rowstart, Lseq;
    __device__ __forceinline__ void fused(f32x4 (&acc)[2][2][4][2], const pg8::Unit& u, int wr, int wc, int fr, int fq, LAS unsigned char* lds, int wid, int lane) const {
        LAS bf16_t* T = (LAS bf16_t*)lds;
        LAS float* W = (LAS float*)(lds + 135168);
        const int tid = wid * 64 + lane;
        for (int e = tid; e < 1024; e += 512) { const int k = e >> 7, c = e & 127, cg_ = 128 * u.pn + c; float v;
            if (k < 3) v = cw[k * NUP + cg_]; else if (k < 6) v = cw[(k - 3) * NUP + DFF + cg_]; else if (k == 6) v = cb[cg_]; else v = cb[DFF + cg_];
            W[e] = v; }
#pragma unroll
        for (int ai = 0; ai < 2; ++ai)
#pragma unroll
            for (int m = 0; m < 4; ++m) { const int row = ai * 128 + wr * 64 + m * 16 + fr;
#pragma unroll
                for (int bj = 0; bj < 2; ++bj)
#pragma unroll
                    for (int n = 0; n < 2; ++n) { const int col = bj * 128 + wc * 32 + n * 16 + 4 * fq; const f32x4 v = acc[ai][bj][m][n];
                        u32x2 w; w.x = pk2(v[0], v[1]); w.y = pk2(v[2], v[3]); *(LAS u32x2*)(T + row * 264 + col) = w; } }
        __syncthreads();
        const u32x4 z4 = {0u, 0u, 0u, 0u};
#pragma unroll 1
        for (int i = 0; i < 8; ++i) { const int t = tid + 512 * i; if (t >= 4064) break;
            const int r = 1 + (t >> 4), c8 = (t & 15) * 8, grow = rowstart + r; if (grow < 0 || grow >= TB) continue;
            const int s_ = grow & (Lseq - 1);
            const LAS bf16_t* tp = T + r * 264 + c8;
            u32x4 vp = *(const LAS u32x4*)(tp - 264), vc = *(const LAS u32x4*)tp, vn = *(const LAS u32x4*)(tp + 264);
            u32x4 gp = *(const LAS u32x4*)(tp - 264 + 128), gc = *(const LAS u32x4*)(tp + 128), gn = *(const LAS u32x4*)(tp + 264 + 128);
            if (s_ == 0) { vp = z4; gp = z4; }
            if (s_ == Lseq - 1) { vn = z4; gn = z4; }
            float o[8];
#pragma unroll
            for (int q = 0; q < 2; ++q) { const f32x4 wv0 = *(const LAS f32x4*)(W + c8 + 4 * q), wv1 = *(const LAS f32x4*)(W + 128 + c8 + 4 * q), wv2 = *(const LAS f32x4*)(W + 256 + c8 + 4 * q);
                const f32x4 wg0 = *(const LAS f32x4*)(W + 384 + c8 + 4 * q), wg1 = *(const LAS f32x4*)(W + 512 + c8 + 4 * q), wg2 = *(const LAS f32x4*)(W + 640 + c8 + 4 * q);
                const f32x4 bv = *(const LAS f32x4*)(W + 768 + c8 + 4 * q), bg = *(const LAS f32x4*)(W + 896 + c8 + 4 * q);
#pragma unroll
                for (int k = 0; k < 4; ++k) { const int e = 4 * q + k;
                    const float val = bf_el8(vp, e) * wv0[k] + bf_el8(vc, e) * wv1[k] + bf_el8(vn, e) * wv2[k] + bv[k];
                    const float gt = bf_el8(gp, e) * wg0[k] + bf_el8(gc, e) * wg1[k] + bf_el8(gn, e) * wg2[k] + bg[k];
                    o[e] = siluf_(gt) * val; } }
            u32x4 w; w.x = pk2(o[0], o[1]); w.y = pk2(o[2], o[3]); w.z = pk2(o[4], o[5]); w.w = pk2(o[6], o[7]);
            *(u32x4*)(ACT + (size_t)grow * DFF + 128 * u.pn + c8) = w; }
        __syncthreads();
    }
};
struct EpiResid {
    static constexpr bool PERM = false, AFTER_DRAIN = false; static constexpr int KHOOK = 0;
    const float* xin; float* out; const float* gt; int lgL, cbase;
    __device__ __forceinline__ void operator()(const f32x4 (&acc)[2][2][4][2], const pg8::Unit& u, int wr, int wc, int fr, int fq) const {
        const int row0 = u.pm * 256 + wr * 64 + fr, col0 = u.pn * 256 + wc * 32 + 4 * fq;
#pragma unroll
        for (int ai = 0; ai < 2; ++ai)
#pragma unroll
            for (int m = 0; m < 4; ++m) { const int row = row0 + ai * 128 + m * 16; const float* gr = gt + (size_t)(cbase + (row >> lgL)) * 6144;
#pragma unroll
                for (int bj = 0; bj < 2; ++bj)
#pragma unroll
                    for (int n = 0; n < 2; ++n) { const int col = col0 + bj * 128 + n * 16;
                        const f32x4 xv = *(const f32x4*)(xin + (size_t)row * DM + col), gv = *(const f32x4*)(gr + col);
                        *(f32x4*)(out + (size_t)row * DM + col) = xv + gv * acc[ai][bj][m][n]; } }
    }
};

__device__ __forceinline__ bf16x8 permfrag_sw(const LAS bf16_t* base, int row, int stride, int kbase, int g, int sw) {
    const u32x2 lo = *(const LAS u32x2*)(base + row * stride + ((kbase + 4 * g) ^ sw)), hi = *(const LAS u32x2*)(base + row * stride + ((kbase + 16 + 4 * g) ^ sw));
    u32x4 w; w.x = lo.x; w.y = lo.y; w.z = hi.x; w.w = hi.y; return __builtin_bit_cast(bf16x8, w);
}
#define MFMA16(a, b, c) __builtin_amdgcn_mfma_f32_16x16x32_bf16((a), (b), (c), 0, 0, 0)
__device__ __forceinline__ float bf_el(const u32x4& a, const u32x4& b, int e) { const unsigned w = (e < 8) ? a[(e >> 1) & 3] : b[(e >> 1) & 3]; return (e & 1) ? bfhi(w) : bflo(w); }

__device__ __forceinline__ void prep_item(const Params& p, const Batch& B, int item, LAS unsigned char* L) {
    const int tid = ltid(), lane = tid & 63, wid = tid >> 6, g = lane >> 4, fr = lane & 15;
    const int NC = B.L >> 6;
    const int hp = item & 3, sn = item >> 2, n = sn & (NC - 1), seq = sn >> (B.lgL - 6);
    const int r0 = seq * B.L + n * 64;
    LAS bf16_t* KS = (LAS bf16_t*)L;
    LAS bf16_t* QS = (LAS bf16_t*)(L + 34816);
    LAS float* AA = (LAS float*)L;
    LAS float* KK = (LAS float*)(L + 69632);
    LAS float* QK = (LAS float*)(L + 102912);
    LAS float* GS = (LAS float*)(L + 136192);
    const bf16_t* PROJ = (const bf16_t*)(p.ws + WS_PROJ);
    bf16_t* QKVD = (bf16_t*)(p.ws + WS_QKVD);
    LAS float* CW = (LAS float*)(L + 69632);
    for (int e = tid; e < 2304; e += 512) { const int hh = e / 1152, rem = e - hh * 1152, mat = rem / 384, rem2 = rem - mat * 384, tap = rem2 >> 7, c = rem2 & 127;
        CW[e] = p.conv_qkv_w[tap * 3072 + mat * 1024 + (hp * 2 + hh) * 128 + c]; }
    float al_pre = 0.f, be_pre = 0.f;
    if (wid < 4) { const int hh = wid >> 1, dir = wid & 1, h = hp * 2 + hh; const int c = dir ? 63 - lane : lane; const int row = r0 + c;
        al_pre = bf2f(PROJ[(size_t)row * NPROJ + C_AB + dir * 8 + h]); be_pre = bf2f(PROJ[(size_t)row * NPROJ + C_AB + 16 + dir * 8 + h]); }
    __syncthreads();
    {
        const int r = tid >> 3, pc = (tid & 7) * 16; const int row = r0 + r; const int s = n * 64 + r;
        const bool hasp = s > 0, hasn = s < B.L - 1;
        const u32x4 z4 = {0u, 0u, 0u, 0u};
#pragma unroll
        for (int hh = 0; hh < 2; ++hh) {
            const int h = hp * 2 + hh;
            u32x4 xc[3][2], xp[3][2], xn[3][2];
#pragma unroll
            for (int mat = 0; mat < 3; ++mat) { const bf16_t* src = PROJ + (size_t)row * NPROJ + C_QD + mat * 1024 + h * 128 + pc;
                xc[mat][0] = *(const u32x4*)src; xc[mat][1] = *(const u32x4*)(src + 8); xp[mat][0] = z4; xp[mat][1] = z4; xn[mat][0] = z4; xn[mat][1] = z4;
                if (hasp) { xp[mat][0] = *(const u32x4*)(src - NPROJ); xp[mat][1] = *(const u32x4*)(src - NPROJ + 8); }
                if (hasn) { xn[mat][0] = *(const u32x4*)(src + NPROJ); xn[mat][1] = *(const u32x4*)(src + NPROJ + 8); } }
#pragma unroll
            for (int mat = 0; mat < 3; ++mat) {
                const int col = mat * 1024 + h * 128 + pc;
                const LAS float* cw = CW + (hh * 3 + mat) * 384 + pc;
                float y[16]; float ss = 0.f;
#pragma unroll
                for (int q = 0; q < 4; ++q) {
                    const f32x4 w0 = *(const LAS f32x4*)(cw + 4 * q), w1 = *(const LAS f32x4*)(cw + 128 + 4 * q), w2 = *(const LAS f32x4*)(cw + 256 + 4 * q);
#pragma unroll
                    for (int e = 0; e < 4; ++e) { const int ee = 4 * q + e;
                        float v = bf_el(xp[mat][0], xp[mat][1], ee) * w0[e] + bf_el(xc[mat][0], xc[mat][1], ee) * w1[e] + bf_el(xn[mat][0], xn[mat][1], ee) * w2[e];
                        v = siluf_(v); y[ee] = v; ss += v * v; }
                }
                if (mat < 2) {
                    ss += __shfl_xor(ss, 1); ss += __shfl_xor(ss, 2); ss += __shfl_xor(ss, 4);
                    float sc = rsqrtf(ss + EPSF); if (mat == 0) sc *= 0.08838834764831845f;
#pragma unroll
                    for (int e = 0; e < 16; ++e) y[e] *= sc;
                }
                u32x4 o0, o1;
                o0.x = pk2(y[0], y[1]); o0.y = pk2(y[2], y[3]); o0.z = pk2(y[4], y[5]); o0.w = pk2(y[6], y[7]);
                o1.x = pk2(y[8], y[9]); o1.y = pk2(y[10], y[11]); o1.z = pk2(y[12], y[13]); o1.w = pk2(y[14], y[15]);
                bf16_t* dst = QKVD + (size_t)row * 3072 + col;
                *(u32x4*)dst = o0; *(u32x4*)(dst + 8) = o1;
                if (mat == 0) { *(LAS u32x4*)(QS + (hh * 64 + r) * 136 + pc) = o0; *(LAS u32x4*)(QS + (hh * 64 + r) * 136 + pc + 8) = o1; }
                if (mat == 1) { *(LAS u32x4*)(KS + (hh * 64 + r) * 136 + pc) = o0; *(LAS u32x4*)(KS + (hh * 64 + r) * 136 + pc + 8) = o1; }
            }
        }
    }
    __syncthreads();
    {
        const int hh = wid >> 2, ct = wid & 3; const LAS bf16_t* Kh = KS + hh * 64 * 136; const LAS bf16_t* Qh = QS + hh * 64 * 136;
        bf16x8 ak[4], aq[4];
#pragma unroll
        for (int ks = 0; ks < 4; ++ks) { ak[ks] = *(const LAS bf16x8*)(Kh + (16 * ct + fr) * 136 + 32 * ks + 8 * g); aq[ks] = *(const LAS bf16x8*)(Qh + (16 * ct + fr) * 136 + 32 * ks + 8 * g); }
#pragma unroll
        for (int dt = 0; dt < 4; ++dt) {
            f32x4 c0 = {0.f, 0.f, 0.f, 0.f}, c1 = {0.f, 0.f, 0.f, 0.f};
#pragma unroll
            for (int ks = 0; ks < 4; ++ks) { const bf16x8 b = *(const LAS bf16x8*)(Kh + (16 * dt + fr) * 136 + 32 * ks + 8 * g); c0 = MFMA16(ak[ks], b, c0); c1 = MFMA16(aq[ks], b, c1); }
#pragma unroll
            for (int j = 0; j < 4; ++j) { KK[hh * 4160 + (16 * ct + 4 * g + j) * 65 + 16 * dt + fr] = c0[j]; QK[hh * 4160 + (16 * ct + 4 * g + j) * 65 + 16 * dt + fr] = c1[j]; }
        }
    }
    if (wid < 4) {
        const int hh = wid >> 1, dir = wid & 1, h = hp * 2 + hh; const int c = dir ? 63 - lane : lane; const int row = r0 + c;
        const float al = al_pre, be = be_pre; (void)row;
        const float xx = al + p.dt_bias[dir * 8 + h]; const float sp = fmaxf(xx, 0.f) + log1pf(__expf(-fabsf(xx)));
        float G = -__expf(p.a_log[dir * 8 + h]) * sp;
#pragma unroll
        for (int o = 1; o < 64; o <<= 1) { const float t = __shfl_up(G, o); if (lane >= o) G += t; }
        const float G63 = __shfl(G, 63);
        GS[wid * 128 + lane] = G; GS[wid * 128 + 64 + lane] = sigmoidf_(be);
        const int np = dir ? NC - 1 - n : n; const size_t cid = ((size_t)((seq * 2 + dir) * 8 + h)) * NC + np;
        float* EG = (float*)(p.ws + WS_EG) + cid * 128; EG[lane] = __expf(G); EG[64 + lane] = __expf(G63 - G);
    }
    __syncthreads();
    for (int e = tid; e < 16384; e += 512) { const int sv = e >> 12, hh = sv >> 1, dir = sv & 1, j = (e >> 6) & 63, i = e & 63; float a = 0.f;
        if (i > j) { const int ci = dir ? 63 - i : i, cj = dir ? 63 - j : j; a = GS[sv * 128 + 64 + i] * KK[hh * 4160 + ci * 65 + cj] * __expf(GS[sv * 128 + i] - GS[sv * 128 + j]); }
        AA[(sv * 64 + j) * 68 + i] = a; }
    __syncthreads();
    if (wid < 4) {
        const int sv = wid, hh = sv >> 1, dir = sv & 1, h = hp * 2 + hh; const LAS float* Ad = AA + sv * 64 * 68;
        float acc[64];
#pragma unroll
        for (int i = 0; i < 64; ++i) acc[i] = (lane == i) ? 1.f : 0.f;
#pragma unroll
        for (int j = 0; j < 63; ++j) { const float tj = acc[j];
#pragma unroll
            for (int i4 = ((j + 1) & ~3); i4 < 64; i4 += 4) { const f32x4 a = *(const LAS f32x4*)(Ad + j * 68 + i4);
#pragma unroll
                for (int e = 0; e < 4; ++e) if (i4 + e > j) acc[i4 + e] -= a[e] * tj; } }
        const int np = dir ? NC - 1 - n : n; const size_t cid = ((size_t)((seq * 2 + dir) * 8 + h)) * NC + np;
        bf16_t* Tg = (bf16_t*)(p.ws + WS_TP) + cid * 8192; const float bl = GS[sv * 128 + 64 + lane];
#pragma unroll
        for (int i = 0; i < 64; ++i) Tg[i * 64 + lane] = f2bf(acc[i] * bl);
    } else {
        bf16_t* TPg = (bf16_t*)(p.ws + WS_TP);
        for (int t = tid - 256; t < 2048; t += 256) { const int sv = t >> 9, hh = sv >> 1, dir = sv & 1, h = hp * 2 + hh, i = (t >> 3) & 63, j0 = (t & 7) * 8;
            const int np = dir ? NC - 1 - n : n; const size_t cid = ((size_t)((seq * 2 + dir) * 8 + h)) * NC + np;
            float v[8]; const int ci = dir ? 63 - i : i; const float Gi = GS[sv * 128 + i];
#pragma unroll
            for (int e = 0; e < 8; ++e) { const int j = j0 + e, cj = dir ? 63 - j : j; v[e] = (i >= j) ? QK[hh * 4160 + ci * 65 + cj] * __expf(Gi - GS[sv * 128 + j]) : 0.f; }
            u32x4 w; w.x = pk2(v[0], v[1]); w.y = pk2(v[2], v[3]); w.z = pk2(v[4], v[5]); w.w = pk2(v[6], v[7]);
            *(u32x4*)(TPg + cid * 8192 + 4096 + i * 64 + j0) = w; }
    }
    __syncthreads();
}

__device__ __forceinline__ bf16x8 pack8(const f32x4& a, const f32x4& b) { u32x4 w; w.x = pk2(a[0], a[1]); w.y = pk2(a[2], a[3]); w.z = pk2(b[0], b[1]); w.w = pk2(b[2], b[3]); return __builtin_bit_cast(bf16x8, w); }
__device__ __forceinline__ bf16x8 permfrag(const LAS bf16_t* base, int row, int stride, int kbase, int g) {
    const u32x2 lo = *(const LAS u32x2*)(base + row * stride + kbase + 4 * g), hi = *(const LAS u32x2*)(base + row * stride + kbase + 16 + 4 * g);
    u32x4 w; w.x = lo.x; w.y = lo.y; w.z = hi.x; w.w = hi.y; return __builtin_bit_cast(bf16x8, w);
}

__device__ __forceinline__ void scan_chain(const Params& p, const Batch& B, int chain, int vs, int lgVS, LAS unsigned char* L) {
    const int tid = ltid(), lane = tid & 63, wid = tid >> 6, g = lane >> 4, fr = lane & 15;
    const int NC = B.L >> 6;
    const int h = chain & 7, dir = (chain >> 3) & 1, seq = chain >> 4;
    LAS bf16_t* KS = (LAS bf16_t*)L;
    LAS bf16_t* KT = (LAS bf16_t*)(L + 124416);
    LAS bf16_t* QS = (LAS bf16_t*)(L + 35840);
    LAS bf16_t* VS = (LAS bf16_t*)(L + 53248);
    LAS bf16_t* TS = (LAS bf16_t*)(L + 70656);
    LAS bf16_t* PS = (LAS bf16_t*)(L + 79872);
    LAS float* EGS = (LAS float*)(L + 89088);
    LAS bf16_t* OS = (LAS bf16_t*)(L + 89600);
    const bf16_t* QKVD = (const bf16_t*)(p.ws + WS_QKVD);
    const bf16_t* TPg = (const bf16_t*)(p.ws + WS_TP);
    const float* EGg = (const float*)(p.ws + WS_EG);
    bf16_t* OD = (bf16_t*)(p.ws + WS_OD) + (size_t)dir * TB * 1024;
    const size_t cid0 = ((size_t)((seq * 2 + dir) * 8 + h)) * NC;
    const int cp = tid >> 3, pc = tid & 7;
    u32x4 rq0, rq1, rk0, rk1, rv0, rv1, rt, rp; float reg_eg = 0.f;
#define SC_LOAD(np_) do { const int tok_ = dir ? (B.L - 1 - ((np_) * 64 + cp)) : ((np_) * 64 + cp); const bf16_t* src_ = QKVD + (size_t)(seq * B.L + tok_) * 3072 + h * 128 + 16 * pc; \
        rq0 = *(const u32x4*)src_; rq1 = *(const u32x4*)(src_ + 8); rk0 = *(const u32x4*)(src_ + 1024); rk1 = *(const u32x4*)(src_ + 1032); rv0 = *(const u32x4*)(src_ + 2048); rv1 = *(const u32x4*)(src_ + 2056); \
        const bf16_t* tp_ = TPg + (cid0 + (np_)) * 8192 + cp * 64 + 8 * pc; rt = *(const u32x4*)tp_; rp = *(const u32x4*)(tp_ + 4096); \
        if (tid < 128) reg_eg = EGg[(cid0 + (np_)) * 128 + tid]; } while (0)
    if (__builtin_amdgcn_readfirstlane(wid) < (8 >> lgVS)) {
    f32x4 S[8];
#pragma unroll
    for (int i = 0; i < 8; ++i) S[i] = (f32x4){0.f, 0.f, 0.f, 0.f};
    SC_LOAD(0);
    for (int np = 0; np < NC; ++np) {
        *(LAS u32x4*)(QS + cp * 136 + 16 * pc) = rq0; *(LAS u32x4*)(QS + cp * 136 + 16 * pc + 8) = rq1;
        *(LAS u32x4*)(KS + cp * 136 + 16 * pc) = rk0; *(LAS u32x4*)(KS + cp * 136 + 16 * pc + 8) = rk1;
        *(LAS u32x4*)(VS + cp * 136 + 16 * pc) = rv0; *(LAS u32x4*)(VS + cp * 136 + 16 * pc + 8) = rv1;
        *(LAS u32x4*)(TS + cp * 72 + 8 * pc) = rt; *(LAS u32x4*)(PS + cp * 72 + 8 * pc) = rp;
#pragma unroll
        for (int e = 0; e < 8; ++e) { const unsigned w0 = rk0[e >> 1], w1 = rk1[e >> 1];
            KT[(17 * pc + e) * 72 + cp] = (bf16_t)((e & 1) ? (w0 >> 16) : (w0 & 0xffffu));
            KT[(17 * pc + 8 + e) * 72 + cp] = (bf16_t)((e & 1) ? (w1 >> 16) : (w1 & 0xffffu)); }
        if (tid < 128) EGS[tid] = reg_eg;
        __syncthreads();
        if (np + 1 < NC) SC_LOAD(np + 1);
        if (np > 0 && (pc >> (3 - lgVS)) == vs) { const LAS bf16_t* os = OS + ((np - 1) & 1) * 8704 + cp * 136 + 16 * pc; const u32x4 o0 = *(const LAS u32x4*)os, o1 = *(const LAS u32x4*)(os + 8);
            const int c_ = (np - 1) * 64 + cp; const int tok_ = dir ? (B.L - 1 - c_) : c_; bf16_t* dst = OD + (size_t)(seq * B.L + tok_) * 1024 + h * 128 + 16 * pc;
            *(u32x4*)dst = o0; *(u32x4*)(dst + 8) = o1; }
        const int vcol = vs * (128 >> lgVS) + 16 * wid;
#define SCHED_FENCE() __builtin_amdgcn_sched_barrier(0)
        bf16x8 Sb[4];
#pragma unroll
        for (int ks = 0; ks < 4; ++ks) Sb[ks] = pack8(S[2 * ks], S[2 * ks + 1]);
        f32x4 X[4], Q[4];
#pragma unroll
        for (int ct = 0; ct < 4; ++ct) { X[ct] = (f32x4){0.f, 0.f, 0.f, 0.f}; Q[ct] = (f32x4){0.f, 0.f, 0.f, 0.f}; }
        bf16x8 fk[2][4], fq[2][4], ft[2][4];
#pragma unroll
        for (int ct = 0; ct < 4; ++ct) { fk[0][ct] = permfrag(KS, 16 * ct + fr, 136, 0, g); fq[0][ct] = permfrag(QS, 16 * ct + fr, 136, 0, g); }
        SCHED_FENCE();
#pragma unroll
        for (int ks = 0; ks < 4; ++ks) {
            if (ks < 3) {
#pragma unroll
                for (int ct = 0; ct < 4; ++ct) { fk[(ks + 1) & 1][ct] = permfrag(KS, 16 * ct + fr, 136, 32 * (ks + 1), g); fq[(ks + 1) & 1][ct] = permfrag(QS, 16 * ct + fr, 136, 32 * (ks + 1), g); }
            } else {
#pragma unroll
                for (int ct = 0; ct < 4; ++ct) { ft[0][ct] = permfrag(TS, 16 * ct + fr, 72, 0, g); ft[1][ct] = permfrag(TS, 16 * ct + fr, 72, 32, g); }
            }
            SCHED_FENCE();
#pragma unroll
            for (int ct = 0; ct < 4; ++ct) { X[ct] = MFMA16(fk[ks & 1][ct], Sb[ks], X[ct]); Q[ct] = MFMA16(fq[ks & 1][ct], Sb[ks], Q[ct]); }
            SCHED_FENCE();
        }
        f32x4 EGv[4], R[4];
#pragma unroll
        for (int ct = 0; ct < 4; ++ct) { EGv[ct] = *(const LAS f32x4*)(EGS + 16 * ct + 4 * g);
#pragma unroll
            for (int j = 0; j < 4; ++j) { const unsigned w = *(const LAS unsigned*)(VS + (16 * ct + 4 * g + j) * 136 + vcol + (fr & ~1)); R[ct][j] = (fr & 1) ? bfhi(w) : bflo(w); } }
        bf16x8 fp[2][4];
#pragma unroll
        for (int ct = 0; ct < 4; ++ct) { fp[0][ct] = permfrag(PS, 16 * ct + fr, 72, 0, g); fp[1][ct] = permfrag(PS, 16 * ct + fr, 72, 32, g); }
        SCHED_FENCE();
#pragma unroll
        for (int ct = 0; ct < 4; ++ct) R[ct] = R[ct] - EGv[ct] * X[ct];
        bf16x8 Rb[2]; Rb[0] = pack8(R[0], R[1]); Rb[1] = pack8(R[2], R[3]);
        f32x4 Vn[4];
#pragma unroll
        for (int ct = 0; ct < 4; ++ct) Vn[ct] = (f32x4){0.f, 0.f, 0.f, 0.f};
#pragma unroll
        for (int k2 = 0; k2 < 2; ++k2)
#pragma unroll
            for (int ct = 0; ct < 4; ++ct) Vn[ct] = MFMA16(ft[k2][ct], Rb[k2], Vn[ct]);
        bf16x8 fkt[2][8];
#pragma unroll
        for (int i = 0; i < 8; ++i) fkt[0][i] = permfrag(KT, 17 * i + fr, 72, 0, g);
        SCHED_FENCE();
        bf16x8 Vb[2]; Vb[0] = pack8(Vn[0], Vn[1]); Vb[1] = pack8(Vn[2], Vn[3]);
        f32x4 O[4];
#pragma unroll
        for (int ct = 0; ct < 4; ++ct) O[ct] = EGv[ct] * Q[ct];
#pragma unroll
        for (int k2 = 0; k2 < 2; ++k2)
#pragma unroll
            for (int ct = 0; ct < 4; ++ct) O[ct] = MFMA16(fp[k2][ct], Vb[k2], O[ct]);
#pragma unroll
        for (int i = 0; i < 8; ++i) fkt[1][i] = permfrag(KT, 17 * i + fr, 72, 32, g);
        SCHED_FENCE();
#pragma unroll
        for (int ct = 0; ct < 4; ++ct) { const f32x4 egd = *(const LAS f32x4*)(EGS + 64 + 16 * ct + 4 * g); Vn[ct] = Vn[ct] * egd; }
        Vb[0] = pack8(Vn[0], Vn[1]); Vb[1] = pack8(Vn[2], Vn[3]);
        const float egl = EGS[63];
#pragma unroll
        for (int i = 0; i < 8; ++i) S[i] = S[i] * egl;
#pragma unroll
        for (int k2 = 0; k2 < 2; ++k2)
#pragma unroll
            for (int i = 0; i < 8; ++i) S[i] = MFMA16(fkt[k2][i], Vb[k2], S[i]);
#pragma unroll
        for (int ct = 0; ct < 4; ++ct)
#pragma unroll
            for (int j = 0; j < 4; ++j) OS[(np & 1) * 8704 + (16 * ct + 4 * g + j) * 136 + vcol + fr] = f2bf(O[ct][j]);
#undef SCHED_FENCE
        __syncthreads();
    }
    } else {
    SC_LOAD(0);
    for (int np = 0; np < NC; ++np) {
        *(LAS u32x4*)(QS + cp * 136 + 16 * pc) = rq0; *(LAS u32x4*)(QS + cp * 136 + 16 * pc + 8) = rq1;
        *(LAS u32x4*)(KS + cp * 136 + 16 * pc) = rk0; *(LAS u32x4*)(KS + cp * 136 + 16 * pc + 8) = rk1;
        *(LAS u32x4*)(VS + cp * 136 + 16 * pc) = rv0; *(LAS u32x4*)(VS + cp * 136 + 16 * pc + 8) = rv1;
        *(LAS u32x4*)(TS + cp * 72 + 8 * pc) = rt; *(LAS u32x4*)(PS + cp * 72 + 8 * pc) = rp;
#pragma unroll
        for (int e = 0; e < 8; ++e) { const unsigned w0 = rk0[e >> 1], w1 = rk1[e >> 1];
            KT[(17 * pc + e) * 72 + cp] = (bf16_t)((e & 1) ? (w0 >> 16) : (w0 & 0xffffu));
            KT[(17 * pc + 8 + e) * 72 + cp] = (bf16_t)((e & 1) ? (w1 >> 16) : (w1 & 0xffffu)); }
        if (tid < 128) EGS[tid] = reg_eg;
        __syncthreads();
        if (np + 1 < NC) SC_LOAD(np + 1);
        if (np > 0 && (pc >> (3 - lgVS)) == vs) { const LAS bf16_t* os = OS + ((np - 1) & 1) * 8704 + cp * 136 + 16 * pc; const u32x4 o0 = *(const LAS u32x4*)os, o1 = *(const LAS u32x4*)(os + 8);
            const int c_ = (np - 1) * 64 + cp; const int tok_ = dir ? (B.L - 1 - c_) : c_; bf16_t* dst = OD + (size_t)(seq * B.L + tok_) * 1024 + h * 128 + 16 * pc;
            *(u32x4*)dst = o0; *(u32x4*)(dst + 8) = o1; }
        __syncthreads();
    }
    }
    if ((pc >> (3 - lgVS)) == vs) { const LAS bf16_t* os = OS + ((NC - 1) & 1) * 8704 + cp * 136 + 16 * pc; const u32x4 o0 = *(const LAS u32x4*)os, o1 = *(const LAS u32x4*)(os + 8);
      const int c_ = (NC - 1) * 64 + cp; const int tok_ = dir ? (B.L - 1 - c_) : c_; bf16_t* dst = OD + (size_t)(seq * B.L + tok_) * 1024 + h * 128 + 16 * pc;
      *(u32x4*)dst = o0; *(u32x4*)(dst + 8) = o1; }
    __syncthreads();
#undef SC_LOAD
}

__device__ __forceinline__ void attn_item(const Params& p, const Batch& B, int item, LAS unsigned char* L) {
    const int tid = ltid(), lane = tid & 63, wid = tid >> 6, g = lane >> 4, fr = lane & 15;
    const int lgper = B.lgL - 7;
    const int x = item & ((1 << lgper) - 1), sgh = item >> lgper, h = sgh & 7, sg = sgh >> 3, grp = sg % 3, seq = sg / 3;
    const int lgd = 2 * grp, r = x & ((1 << lgd) - 1), pb = x >> lgd, Lr = B.L >> lgd;
    const int mq0 = pb * 128, mk0 = mq0 - 64, hcol = (grp * 8 + h) * 64;
    LAS bf16_t* KL = (LAS bf16_t*)L;
    LAS bf16_t* VT = (LAS bf16_t*)(L + 36864);
    bf16_t* PROJ = (bf16_t*)(p.ws + WS_PROJ);
    const f32x2* ROPE = (const f32x2*)(p.ws + WS_ROPE);
    const size_t rowbase = (size_t)seq * B.L;
    const u32x4 z4 = {0u, 0u, 0u, 0u};
    const int mq = mq0 + 16 * wid + fr, sq = (mq << lgd) + r;
    bf16_t* qptr = PROJ + (rowbase + sq) * NPROJ + C_QA + hcol;
    const u32x4 qa = *(const u32x4*)(qptr + 8 * g), qb = *(const u32x4*)(qptr + 32 + 8 * g);
    f32x4 qcs[4];
    { const f32x4* rp = (const f32x4*)(ROPE + (size_t)sq * 32 + 8 * g);
#pragma unroll
      for (int q = 0; q < 4; ++q) qcs[q] = rp[q]; }
    u32x4 ka[2], kb[2]; f32x4 kcs[2][4]; u32x4 va[4];
#pragma unroll
    for (int i = 0; i < 2; ++i) { const int t = tid + 512 * i, kk = t >> 2, pp = t & 3, m = mk0 + kk; ka[i] = z4; kb[i] = z4;
#pragma unroll
        for (int q = 0; q < 4; ++q) kcs[i][q] = (f32x4){0.f, 0.f, 0.f, 0.f};
        if (m >= 0 && m < Lr) { const int s = (m << lgd) + r; const bf16_t* src = PROJ + (rowbase + s) * NPROJ + C_KA + hcol + 8 * pp;
            ka[i] = *(const u32x4*)src; kb[i] = *(const u32x4*)(src + 32); const f32x4* rp = (const f32x4*)(ROPE + (size_t)s * 32 + 8 * pp);
#pragma unroll
            for (int q = 0; q < 4; ++q) kcs[i][q] = rp[q]; } }
#pragma unroll
    for (int i = 0; i < 4; ++i) { const int kk = tid & 255, p8 = (tid >> 8) + 2 * i, m = mk0 + kk; va[i] = z4;
        if (m >= 0 && m < Lr) { const int s = (m << lgd) + r; va[i] = *(const u32x4*)(PROJ + (rowbase + s) * NPROJ + C_VA + hcol + 8 * p8); } }
#pragma unroll
    for (int i = 0; i < 2; ++i) { const int t = tid + 512 * i, kk = t >> 2, pp = t & 3; u32x4 lo, hi;
#pragma unroll
        for (int q = 0; q < 4; ++q) { const f32x4 cs = kcs[i][q]; const float x1a = bflo(ka[i][q]), x1b = bfhi(ka[i][q]), x2a = bflo(kb[i][q]), x2b = bfhi(kb[i][q]);
            lo[q] = pk2(x1a * cs[0] - x2a * cs[1], x1b * cs[2] - x2b * cs[3]); hi[q] = pk2(x2a * cs[0] + x1a * cs[1], x2b * cs[2] + x1b * cs[3]); }
        *(LAS u32x4*)(KL + kk * 72 + 8 * pp) = lo; *(LAS u32x4*)(KL + kk * 72 + 32 + 8 * pp) = hi; }
#pragma unroll
    for (int i = 0; i < 4; ++i) { const int kk = tid & 255, p8 = (tid >> 8) + 2 * i;
#pragma unroll
        for (int e = 0; e < 8; ++e) { const unsigned w = va[i][e >> 1]; VT[(8 * p8 + e) * 264 + kk] = (bf16_t)((e & 1) ? (w >> 16) : (w & 0xffffu)); } }
    __syncthreads();
    {
        u32x4 lo, hi;
#pragma unroll
        for (int q = 0; q < 4; ++q) { const f32x4 cs = qcs[q] * 0.125f; const float x1a = bflo(qa[q]), x1b = bfhi(qa[q]), x2a = bflo(qb[q]), x2b = bfhi(qb[q]);
            lo[q] = pk2(x1a * cs[0] - x2a * cs[1], x1b * cs[2] - x2b * cs[3]); hi[q] = pk2(x2a * cs[0] + x1a * cs[1], x2b * cs[2] + x1b * cs[3]); }
        bf16x8 qf[2]; qf[0] = __builtin_bit_cast(bf16x8, lo); qf[1] = __builtin_bit_cast(bf16x8, hi);
        f32x4 st[9]; float mx = -3.0e38f;
#pragma unroll
        for (int t = 0; t < 9; ++t) { f32x4 acc = {0.f, 0.f, 0.f, 0.f};
#pragma unroll
            for (int ks = 0; ks < 2; ++ks) acc = MFMA16(*(const LAS bf16x8*)(KL + (16 * (wid + t) + fr) * 72 + 32 * ks + 8 * g), qf[ks], acc);
#pragma unroll
            for (int j = 0; j < 4; ++j) { const int m = mk0 + 16 * (wid + t) + 4 * g + j; const int dq = mq - m; const bool ok = (dq <= 64) && (dq >= -64) && (m >= 0) && (m < Lr);
                acc[j] = ok ? acc[j] : -1.0e30f; mx = fmaxf(mx, acc[j]); }
            st[t] = acc; }
        mx = fmaxf(mx, __shfl_xor(mx, 16)); mx = fmaxf(mx, __shfl_xor(mx, 32));
        float den = 0.f;
#pragma unroll
        for (int t = 0; t < 9; ++t)
#pragma unroll
            for (int j = 0; j < 4; ++j) { const float e = __expf(st[t][j] - mx); st[t][j] = e; den += e; }
        den += __shfl_xor(den, 16); den += __shfl_xor(den, 32);
        bf16x8 pbf[5];
#pragma unroll
        for (int ks = 0; ks < 4; ++ks) pbf[ks] = pack8(st[2 * ks], st[2 * ks + 1]);
        pbf[4] = pack8(st[8], (f32x4){0.f, 0.f, 0.f, 0.f});
        const float rden = 1.0f / den;
#pragma unroll
        for (int dt = 0; dt < 4; ++dt) { f32x4 o = {0.f, 0.f, 0.f, 0.f};
#pragma unroll
            for (int ks = 0; ks < 5; ++ks) { const LAS bf16_t* vp = VT + (16 * dt + fr) * 264 + 16 * (wid + 2 * ks) + 4 * g;
                const u32x2 vl = *(const LAS u32x2*)vp; u32x2 vh = {0u, 0u}; if (ks < 4) vh = *(const LAS u32x2*)(vp + 16);
                u32x4 w; w.x = vl.x; w.y = vl.y; w.z = vh.x; w.w = vh.y; o = MFMA16(__builtin_bit_cast(bf16x8, w), pbf[ks], o); }
            u32x2 ow; ow.x = pk2(o[0] * rden, o[1] * rden); ow.y = pk2(o[2] * rden, o[3] * rden);
            *(u32x2*)((bf16_t*)B.out + (rowbase + sq) * 1536 + hcol + 16 * dt + 4 * g) = ow; }
        if (g == 0) ((float*)(p.ws + WS_LSE))[(rowbase + sq) * 24 + grp * 8 + h] = mx + __logf(den);
    }
    __syncthreads();
}

__device__ __forceinline__ void post_mixer(const Params& p, const Batch& B) {
    const int lane = ltid() & 63, gw = blockIdx.x * 8 + (ltid() >> 6), NGW = gridDim.x * 8;
    const bf16_t* PROJ = (const bf16_t*)(p.ws + WS_PROJ); const float* LSE = (const float*)(p.ws + WS_LSE);
    const bf16_t* OD0 = (const bf16_t*)(p.ws + WS_OD); const bf16_t* OD1 = OD0 + (size_t)TB * 1024;
    bf16_t* YAD = (bf16_t*)(p.ws + WS_QKVD);
    float dg[16];
#pragma unroll
    for (int e = 0; e < 16; ++e) dg[e] = p.dn_norm_g[(16 * lane + e) & 127];
    const int hh = lane >> 3;
    for (int r0 = gw; r0 < TB; r0 += 2 * NGW) {
        float l0[2], l1[2], l2[2]; u32x4 a[2], b[2], c[2], a0[2], a1[2], b0[2], b1[2], z0[2], z1[2];
#pragma unroll
        for (int u = 0; u < 2; ++u) { const int r = r0 + u * NGW;
            l0[u] = LSE[(size_t)r * 24 + hh]; l1[u] = LSE[(size_t)r * 24 + 8 + hh]; l2[u] = LSE[(size_t)r * 24 + 16 + hh];
            const bf16_t* src = (const bf16_t*)B.out + (size_t)r * 1536 + 8 * lane;
            a[u] = *(const u32x4*)src; b[u] = *(const u32x4*)(src + 512); c[u] = *(const u32x4*)(src + 1024);
            const bf16_t* s0 = OD0 + (size_t)r * 1024 + 16 * lane; const bf16_t* s1 = OD1 + (size_t)r * 1024 + 16 * lane; const bf16_t* zp = PROJ + (size_t)r * NPROJ + C_ZD + 16 * lane;
            a0[u] = *(const u32x4*)s0; a1[u] = *(const u32x4*)(s0 + 8); b0[u] = *(const u32x4*)s1; b1[u] = *(const u32x4*)(s1 + 8); z0[u] = *(const u32x4*)zp; z1[u] = *(const u32x4*)(zp + 8); }
#pragma unroll
        for (int u = 0; u < 2; ++u) { const int r = r0 + u * NGW;
            { const float mx = fmaxf(l0[u], fmaxf(l1[u], l2[u])); float w0 = __expf(l0[u] - mx), w1 = __expf(l1[u] - mx), w2 = __expf(l2[u] - mx); const float inv = 1.0f / (w0 + w1 + w2); w0 *= inv; w1 *= inv; w2 *= inv;
              u32x4 o;
#pragma unroll
              for (int q = 0; q < 4; ++q) o[q] = pk2(w0 * bflo(a[u][q]) + w1 * bflo(b[u][q]) + w2 * bflo(c[u][q]), w0 * bfhi(a[u][q]) + w1 * bfhi(b[u][q]) + w2 * bfhi(c[u][q]));
              *(u32x4*)(YAD + (size_t)r * 1536 + 8 * lane) = o; }
            { float v[16]; float ss = 0.f;
#pragma unroll
              for (int e = 0; e < 16; ++e) { v[e] = bf_el(a0[u], a1[u], e) + bf_el(b0[u], b1[u], e); ss += v[e] * v[e]; }
              ss += __shfl_xor(ss, 1); ss += __shfl_xor(ss, 2); ss += __shfl_xor(ss, 4);
              const float rs = rsqrtf(ss * (1.0f / 128.0f) + EPSF);
#pragma unroll
              for (int e = 0; e < 16; ++e) v[e] = v[e] * rs * dg[e] * siluf_(bf_el(z0[u], z1[u], e));
              u32x4 o0, o1; o0.x = pk2(v[0], v[1]); o0.y = pk2(v[2], v[3]); o0.z = pk2(v[4], v[5]); o0.w = pk2(v[6], v[7]);
              o1.x = pk2(v[8], v[9]); o1.y = pk2(v[10], v[11]); o1.z = pk2(v[12], v[13]); o1.w = pk2(v[14], v[15]);
              *(u32x4*)(YAD + (size_t)r * 1536 + 512 + 16 * lane) = o0; *(u32x4*)(YAD + (size_t)r * 1536 + 512 + 16 * lane + 8) = o1; }
        }
    }
}

__device__ __forceinline__ void conv_act(const Params& p, const Batch& B) {
    const bf16_t* UP = (const bf16_t*)(p.ws + WS_PROJ); bf16_t* ACT = (bf16_t*)(p.ws + WS_PROJ + (size_t)TB * NUP * 2);
    const u32x4 z4 = {0u, 0u, 0u, 0u};
    constexpr int RB = 16;
    for (int t = blockIdx.x * 512 + ltid(); t < (TB / RB) * 352; t += gridDim.x * 512) {
        const int rb = t / 352, cg8 = (t - rb * 352) * 8, row0 = rb * RB; const int s0 = row0 & (B.L - 1);
        f32x4 wv[3][2], wg[3][2], bv[2], bg[2];
#pragma unroll
        for (int q = 0; q < 2; ++q) {
#pragma unroll
            for (int j = 0; j < 3; ++j) { wv[j][q] = *(const f32x4*)(p.ffn_conv_w + j * NUP + cg8 + 4 * q); wg[j][q] = *(const f32x4*)(p.ffn_conv_w + j * NUP + DFF + cg8 + 4 * q); }
            bv[q] = *(const f32x4*)(p.ffn_conv_b + cg8 + 4 * q); bg[q] = *(const f32x4*)(p.ffn_conv_b + DFF + cg8 + 4 * q); }
        const bf16_t* src = UP + (size_t)row0 * NUP + cg8;
        u32x4 vp = z4, gp = z4, vc, gc, vn, gn;
        if (s0 > 0) { vp = *(const u32x4*)(src - NUP); gp = *(const u32x4*)(src - NUP + DFF); }
        vc = *(const u32x4*)src; gc = *(const u32x4*)(src + DFF);
#pragma unroll
        for (int i = 0; i < RB; ++i) {
            vn = z4; gn = z4;
            if (i < RB - 1 || s0 + RB < B.L) { vn = *(const u32x4*)(src + (size_t)(i + 1) * NUP); gn = *(const u32x4*)(src + (size_t)(i + 1) * NUP + DFF); }
            float o[8];
#pragma unroll
            for (int e = 0; e < 8; ++e) { const int q = e >> 2, k = e & 3;
                const float val = bf_el(vp, z4, e) * wv[0][q][k] + bf_el(vc, z4, e) * wv[1][q][k] + bf_el(vn, z4, e) * wv[2][q][k] + bv[q][k];
                const float gt = bf_el(gp, z4, e) * wg[0][q][k] + bf_el(gc, z4, e) * wg[1][q][k] + bf_el(gn, z4, e) * wg[2][q][k] + bg[q][k];
                o[e] = siluf_(gt) * val; }
            u32x4 w; w.x = pk2(o[0], o[1]); w.y = pk2(o[2], o[3]); w.z = pk2(o[4], o[5]); w.w = pk2(o[6], o[7]);
            *(u32x4*)(ACT + (size_t)(row0 + i) * DFF + cg8) = w;
            vp = vc; gp = gc; vc = vn; gc = gn;
        }
    }
}

#ifndef EN_P0
#define EN_P0 1
#endif
#ifndef EN_PREP
#define EN_PREP 1
#endif
#ifndef EN_SCAN
#define EN_SCAN 1
#endif
#ifndef EN_ATT
#define EN_ATT 1
#endif
#ifndef EN_POST
#define EN_POST 1
#endif
#ifndef EN_CONV
#define EN_CONV 1
#endif
#ifndef EN_G1
#define EN_G1 1
#endif
#ifndef EN_G2
#define EN_G2 1
#endif
#ifndef EN_G3
#define EN_G3 1
#endif
#ifndef EN_G4
#define EN_G4 1
#endif
#ifndef EN_G5
#define EN_G5 1
#endif
#ifndef PROBE_POS
#define PROBE_POS -100
#endif
#ifndef REP_ATT
#define REP_ATT 1
#endif
#ifndef REP_P0
#define REP_P0 1
#endif
#ifndef REP_P3
#define REP_P3 1
#endif
#ifndef REP_SCAN
#define REP_SCAN 1
#endif
#ifndef REP_P5
#define REP_P5 1
#endif
#ifndef REP_P11
#define REP_P11 1
#endif
#ifndef REP_G1
#define REP_G1 1
#endif
#ifndef REP_G4
#define REP_G4 1
#endif
#ifndef REP_P9
#define REP_P9 1
#endif
#ifndef REP_SYNC
#define REP_SYNC 1
#endif
#define XB_TMO      128
#define XB_XCNT(j)  (256  + 64 * (j))
#define XB_XSUB(j)  (1280 + 64 * (j))
#define XB_XGEN(j)  (2304 + 64 * (j))
#define XB_TOP      3328
#define XB_TOPGEN   3392
#define XCD_BAR_WORDS 3456
#define XB_SPIN_CAP (1u << 18)

__device__ __forceinline__ unsigned xb_ld(unsigned* p)              { return __hip_atomic_load(p, __ATOMIC_RELAXED, __HIP_MEMORY_SCOPE_AGENT); }
__device__ __forceinline__ unsigned xb_add(unsigned* p, unsigned v) { return __hip_atomic_fetch_add(p, v, __ATOMIC_RELAXED, __HIP_MEMORY_SCOPE_AGENT); }
__device__ __forceinline__ unsigned xb_xcc_id() { return (unsigned)__builtin_amdgcn_s_getreg((3 << 11) | 20) & 0xFu; }
#define XB_SPIN(cond, bar) do { unsigned _sp = 0; while (cond) { __builtin_amdgcn_s_sleep(1); \
    if ((++_sp & 255u) == 0u) { if (xb_ld(&(bar)[XB_TMO])) break; if (_sp > XB_SPIN_CAP) { atomicAdd(&(bar)[XB_TMO], 1u); break; } } } } while (0)

struct XcdBarrier {
    unsigned* bar; unsigned x;
    volatile LAS unsigned* st;
};

__device__ __forceinline__ XcdBarrier xcd_barrier_post(unsigned* bar, volatile LAS unsigned* st) {
    XcdBarrier b; b.bar = bar; b.x = xb_xcc_id(); b.st = st;
    if (threadIdx.x == 0) (void)xb_add(&bar[XB_XCNT(b.x)], 1u);
    return b;
}
__device__ __forceinline__ void xcd_barrier_complete(unsigned* bar, unsigned x, unsigned& nloc, unsigned& nx) {
    const unsigned G = gridDim.x * gridDim.y * gridDim.z;
    unsigned sum, cnt, mine, sp = 0u;
    for (;;) {
        sum = 0u; cnt = 0u; mine = 0u;
#pragma unroll
        for (unsigned j = 0; j < 16; ++j) { const unsigned c = xb_ld(&bar[XB_XCNT(j)]); sum += c; cnt += (c > 0u) ? 1u : 0u; mine = (j == x) ? c : mine; }
        if (sum == G) break;
        __builtin_amdgcn_s_sleep(1);
        if ((++sp & 255u) == 0u) { if (xb_ld(&bar[XB_TMO])) break; if (sp > XB_SPIN_CAP) { atomicAdd(&bar[XB_TMO], 1u); break; } }
    }
    nloc = mine > 0u ? mine : 1u; nx = cnt > 0u ? cnt : 1u;
}

__device__ __forceinline__ void xcd_barrier(const XcdBarrier& b) {
    asm volatile("s_waitcnt vmcnt(0)" ::: "memory");
    __syncthreads();
    if (threadIdx.x == 0) {
        unsigned* bar = b.bar;
        __builtin_amdgcn_s_waitcnt(0);
        unsigned nloc = b.st[0], nx = b.st[1];
        if (nloc == 0u) { xcd_barrier_complete(bar, b.x, nloc, nx); b.st[0] = nloc; b.st[1] = nx; }
        const unsigned old = xb_add(&bar[XB_XSUB(b.x)], 1u);
        const unsigned gen = old / nloc;
        if (old + 1u == (gen + 1u) * nloc) {
            __builtin_amdgcn_fence(__ATOMIC_RELEASE, "agent");
            asm volatile("s_waitcnt vmcnt(0)" ::: "memory");
            const unsigned og = xb_add(&bar[XB_TOP], 1u);
            const unsigned tg = og / nx;
            if (og + 1u == (tg + 1u) * nx) xb_add(&bar[XB_TOPGEN], 1u);
            else XB_SPIN(xb_ld(&bar[XB_TOPGEN]) == tg, bar);
            __builtin_amdgcn_fence(__ATOMIC_ACQUIRE, "agent");
            xb_add(&bar[XB_XGEN(b.x)], 1u);
            asm volatile("s_waitcnt vmcnt(0)" ::: "memory");
        } else {
            XB_SPIN(xb_ld(&bar[XB_XGEN(b.x)]) == gen, bar);
            __builtin_amdgcn_fence(__ATOMIC_ACQUIRE, "agent");
            asm volatile("s_waitcnt vmcnt(0)" ::: "memory");
        }
    }
    __syncthreads();
}


__device__ __forceinline__ void grid_bar(unsigned* ctr, unsigned target) {
    asm volatile("s_waitcnt vmcnt(0) lgkmcnt(0)" ::: "memory");
    __syncthreads();
    if (threadIdx.x == 0) {
        __builtin_amdgcn_fence(__ATOMIC_RELEASE, "agent");
        asm volatile("s_waitcnt vmcnt(0)" ::: "memory");
        __hip_atomic_fetch_add(ctr, 1u, __ATOMIC_RELAXED, __HIP_MEMORY_SCOPE_AGENT);
        while (__hip_atomic_load(ctr, __ATOMIC_RELAXED, __HIP_MEMORY_SCOPE_AGENT) < target) __builtin_amdgcn_s_sleep(2);
        __builtin_amdgcn_fence(__ATOMIC_ACQUIRE, "agent");
        asm volatile("s_waitcnt vmcnt(0)" ::: "memory");
    }
    __syncthreads();
}
__global__ void __launch_bounds__(512) mega(Params p) {
    extern __shared__ __attribute__((aligned(16))) unsigned char lds_raw[];
    LAS unsigned char* L = (LAS unsigned char*)lds_raw;
    const int G = gridDim.x, bid = blockIdx.x, tid = ltid();
    int ph = 0;
#define PHASE_ON (ph >= p.ph_lo && ph < p.ph_hi)
#define SEAM() do { if (ph >= p.ph_lo && ph + 1 < p.ph_hi) { for (int rep_ = 0; rep_ < REP_SYNC; ++rep_) { xcd_barrier(xbar); } } PROBE_TICK(); ++ph; } while (0)
    unsigned nbar = 0;
#if PROBE_POS > -10
    unsigned long long t_prev = __builtin_amdgcn_s_memrealtime(), t_acc = 0;
#define PROBE_TICK() do { const unsigned long long t_now = __builtin_amdgcn_s_memrealtime(); const int pos_ = ph < 2 ? -1 - ph : (ph - 2) % 11; if (pos_ == PROBE_POS) t_acc += t_now - t_prev; t_prev = t_now; } while (0)
#else
#define PROBE_TICK() do {} while (0)
#endif
    unsigned* ctl = (unsigned*)(p.ws + WS_CTL);
    volatile LAS unsigned* xst = (volatile LAS unsigned*)(L + LDS_BYTES - 32);
    if (tid == 0) { xst[0] = 0u; xst[1] = 0u; }
    __syncthreads();
    XcdBarrier xbar = xcd_barrier_post(ctl + 1024, xst);
    float* MOD = (float*)(p.ws + WS_MOD);
    bf16_t* XN = (bf16_t*)(p.ws + WS_XN); bf16_t* PROJ = (bf16_t*)(p.ws + WS_PROJ);
    if (EN_P0 && PHASE_ON) for (int rep = 0; rep < REP_P0; ++rep) phase0(p, L);
    SEAM();
    if (PHASE_ON) { const Batch B0 = make_batch(p, 0); norm_mod_rows(p, B0, B0.x, p.norm1_g, 0, 1024, XN); }
    SEAM();
    for (int b = 0; b < 3; ++b) {
        const Batch B = make_batch(p, b);
        const int cbase = b == 0 ? 0 : 8 + (b - 1) * 4;
        if (EN_G1 && PHASE_ON) for (int rep = 0; rep < REP_G1; ++rep) { pg8::Gemm g{XN, (const bf16_t*)(p.ws + WS_WIN), TB, NPROJ, 1024}; pg8::StaticOrder S; S.init(TB, NPROJ, G, bid); EpiBf16S E{PROJ, NPROJ}; pg8::gemm_phase<EpiBf16S, pg8::StaticOrder>(L, g, S, E); }
        SEAM();
        if (EN_PREP && PHASE_ON) for (int rep = 0; rep < REP_P3; ++rep) { const int nit = (TB >> 6) * 4; for (int it = bid; it < nit; it += G) prep_item(p, B, it, L); }
        SEAM();
        if (PHASE_ON) {
            const int lgVS = 1; const int nscan = (B.nseq * 16) << lgVS, natt = B.nseq * 24 * (B.L >> 7);
            LAS int* slot = (LAS int*)(L + LDS_BYTES - 16);
            for (;;) {
                if (tid == 0) *slot = (int)atomicAdd(ctl + 64 * b, 1u);
                __syncthreads();
                const int idx = *slot;
                __syncthreads();
                if (idx >= nscan + natt) break;
                if (idx < nscan) { if (EN_SCAN) for (int rep = 0; rep < REP_SCAN; ++rep) scan_chain(p, B, idx >> lgVS, idx & ((1 << lgVS) - 1), lgVS, L); } else { if (EN_ATT) for (int rep = 0; rep < REP_ATT; ++rep) attn_item(p, B, idx - nscan, L); }
            }
        }
        SEAM();
        if (EN_POST && PHASE_ON) for (int rep = 0; rep < REP_P5; ++rep) post_mixer(p, B);
        SEAM();
        if (EN_G2 && PHASE_ON) {
            bf16_t* MERGED = (bf16_t*)(p.ws + WS_QKVD + (size_t)TB * 1536 * 2);
            pg8::Gemm g{(const bf16_t*)(p.ws + WS_QKVD), (const bf16_t*)(p.ws + WS_WA), TB, 1024, 1536}; pg8::StaticOrder S; S.init(TB, 1024, G, bid); EpiMerge E{PROJ + C_GA, PROJ + C_GD, NPROJ, MERGED}; pg8::gemm_phase<EpiMerge, pg8::StaticOrder>(L, g, S, E);
        }
        SEAM();
        if (EN_G3 && PHASE_ON) { const bf16_t* MERGED = (const bf16_t*)(p.ws + WS_QKVD + (size_t)TB * 1536 * 2);
            pg8::Gemm g{MERGED, (const bf16_t*)(p.ws + WS_WO), TB, 1024, 1024}; pg8::StaticOrder S; S.init(TB, 1024, G, bid); EpiResid E{B.x, B.out, MOD + 2048, B.lgL, cbase}; pg8::gemm_phase<EpiResid, pg8::StaticOrder>(L, g, S, E); }
        SEAM();
        if (PHASE_ON) for (int rep = 0; rep < REP_P9; ++rep) norm_mod_rows(p, B, B.out, p.norm2_g, 3072, 4096, XN);
        SEAM();
        if (EN_G4 && PHASE_ON) {
            pg8::StaticOrder S; S.init(65 * 256, NUP, G, bid);
            for (int i = 0; ; ++i) { pg8::Unit u; if (!S.next(i, u)) break;
                const int rowstart = 254 * u.pm - 1;
                pg8::Gemm g{XN + (ptrdiff_t)rowstart * 1024, (const bf16_t*)(p.ws + WS_WUP), 256, NUP, 1024};
                OneUnit S1{pg8::Unit{0, u.pn}};
                EpiConvFfn E{(bf16_t*)(p.ws + WS_PROJ + (size_t)TB * NUP * 2), p.ffn_conv_w, p.ffn_conv_b, rowstart, B.L};
                pg8::gemm_phase<EpiConvFfn, OneUnit>(L, g, S1, E); }
        }
        SEAM();
        if (EN_G5 && PHASE_ON) { pg8::Gemm g{(const bf16_t*)(p.ws + WS_PROJ + (size_t)TB * NUP * 2), (const bf16_t*)(p.ws + WS_WDN), TB, 1024, DFF}; pg8::StaticOrder S; S.init(TB, 1024, G, bid);
            EpiResid E{B.out, B.out, MOD + 5120, B.lgL, cbase}; pg8::gemm_phase<EpiResid, pg8::StaticOrder>(L, g, S, E); }
        SEAM();
        if (PHASE_ON) { final_norm_rows(B.out, p.norm_f_g); if (b < 2) { const Batch Bn = make_batch(p, b + 1); norm_mod_rows(p, Bn, Bn.x, p.norm1_g, 0, 1024, XN); } }
        SEAM();
    }
#if PROBE_POS > -10
    if (bid == 0 && tid == 0) { const unsigned long long t0 = __builtin_amdgcn_s_memrealtime(); while (__builtin_amdgcn_s_memrealtime() - t0 < 4ull * t_acc) __builtin_amdgcn_s_sleep(8); }
#endif
}
constexpr int N_PHASES = 2 + 3 * 10;

#ifndef MULTI_LAUNCH
#define MULTI_LAUNCH 0
#endif
extern "C" void kernel_launch(void* const* d_in, const int* in_sizes, int n_in, void* d_out, int out_size, void* d_ws, size_t ws_size, hipStream_t stream) {
    static int grid = 0;
    if (grid == 0) {
        if (n_in != 21 || ws_size < WS_END) { fprintf(stderr, "kernel_launch: need 21 inputs and %zu bytes of workspace (got %d, %zu)\n", (size_t)WS_END, n_in, ws_size); grid = -1; return; }
        int dev = 0, cus = 0, per_cu = 0;
        hipGetDevice(&dev); hipDeviceGetAttribute(&cus, hipDeviceAttributeMultiprocessorCount, dev);
        if (hipFuncSetAttribute((const void*)mega, hipFuncAttributeMaxDynamicSharedMemorySize, LDS_BYTES) != hipSuccess) { fprintf(stderr, "kernel_launch: hipFuncSetAttribute failed\n"); grid = -1; return; }
        if (hipOccupancyMaxActiveBlocksPerMultiprocessor(&per_cu, (const void*)mega, 512, LDS_BYTES) != hipSuccess || per_cu < 1) { fprintf(stderr, "kernel_launch: occupancy query says %d blocks/CU\n", per_cu); grid = -1; return; }
        grid = cus;
    }
    if (grid < 0) return;
    hipMemsetAsync((char*)d_ws + WS_CTL, 0, 20480, stream);
    Params p{};
    const float** pp = (const float**)&p;
    for (int i = 0; i < 21; ++i) pp[i] = (const float*)d_in[i];
    p.out = (float*)d_out; p.ws = (unsigned char*)d_ws;
#if MULTI_LAUNCH
    for (int ph = 0; ph < N_PHASES; ++ph) { p.ph_lo = ph; p.ph_hi = ph + 1; hipLaunchKernelGGL(mega, dim3(grid), dim3(512), LDS_BYTES, stream, p); }
#else
    p.ph_lo = 0; p.ph_hi = N_PHASES;
    void* args[] = {&p};
    hipError_t e = hipLaunchCooperativeKernel((const void*)mega, dim3(grid), dim3(512), args, LDS_BYTES, stream);
    if (e != hipSuccess) fprintf(stderr, "cooperative launch failed: %s (grid %d)\n", hipGetErrorString(e), grid);
#endif
}
```

```cpp
#include <hip/hip_runtime.h>
#include <cstdio>
namespace pg8 {
#define PG8_LAS __attribute__((address_space(3)))
typedef unsigned short bf16_t;
typedef short bf16x8 __attribute__((ext_vector_type(8)));
typedef float f32x4 __attribute__((ext_vector_type(4)));
typedef unsigned u32x4 __attribute__((ext_vector_type(4)));
constexpr int BM = 256, BK = 64, HALF = 128, HTB = HALF * BK * 2  , STAGE_BYTES = 8 * HTB, NXCD = 8, WGM = 8;

__host__ __device__ __forceinline__ int lds_byte(int r, int c) { const int st = (r >> 4) * 2 + (c >> 5), rr = r & 15, cc = c & 31, ob = rr * 64 + cc * 2; return st * 1024 + (ob ^ (((ob >> 9) & 1) << 5)); }
__host__ __device__ __forceinline__ void stage_rc(int b, int& R, int& C) { const int st = b / 1024, sb = b % 1024, swz = sb ^ (((sb >> 9) & 1) << 5); R = (st >> 1) * 16 + swz / 64; C = (st & 1) * 32 + (swz % 64) / 2; }
__host__ __device__ __forceinline__ int perm32(int rho) { const int n = rho >> 4, i = rho & 15; return 8 * (i >> 2) + 4 * n + (i & 3); }

struct Unit { int pm, pn; };
struct Gemm { const bf16_t* A; const bf16_t* Bt; int M, N, K; };

struct StaticOrder {
    int nM, nN, nwg, G, c;
    __host__ __device__ void init(int M, int N, int G_, int c_) { nM = M / BM; nN = N / BM; nwg = nM * nN; G = G_; c = c_; }
    __host__ __device__ bool next(int i, Unit& u) const {
        const long L = (long)i * G + c; if (L >= nwg) return false;
        int wgid = (int)L; { const int q = nwg / NXCD, r = nwg % NXCD, xcd = wgid % NXCD, off = wgid / NXCD; wgid = (xcd < r ? xcd * (q + 1) : r * (q + 1) + (xcd - r) * q) + off; }
        const int nig = WGM * nN, gid = wgid / nig, fm = gid * WGM, gsz = (nM - fm) < WGM ? (nM - fm) : WGM;
        u.pm = fm + ((wgid % nig) % gsz); u.pn = (wgid % nig) / gsz; return true;
    }
    __device__ __forceinline__ void a_ready(const Unit&) const {}
    __device__ __forceinline__ void done(const Unit&) const {}
};
__device__ __forceinline__ unsigned cvt_pk_bf16(float lo, float hi) { unsigned r; asm volatile("v_cvt_pk_bf16_f32 %0, %1, %2" : "=v"(r) : "v"(lo), "v"(hi)); return r; }
typedef float f32x2 __attribute__((ext_vector_type(2)));
template <class Epi, class Sched>
__device__ __forceinline__ void gemm_phase(PG8_LAS unsigned char* lds, const Gemm g, const Sched& S, const Epi& E) {
    int tid_ = threadIdx.x; asm volatile("" : "+v"(tid_)); const int tid = tid_, wid = __builtin_amdgcn_readfirstlane(tid >> 6), lane = tid & 63, wr = wid >> 2, wc = wid & 3, fr = lane & 15, fq = lane >> 4;
    const int K = g.K, nt = K / BK;
    unsigned voffA[2], voffB[2];
#pragma unroll
    for (int i = 0; i < 2; ++i) { int R, C; stage_rc(tid * 16 + i * 8192, R, C); const int Rb = Epi::PERM ? ((R & ~31) + perm32(R & 31)) : R;
        voffA[i] = (unsigned)(R * K + C) * 2u; voffB[i] = (unsigned)(Rb * K + C) * 2u; }
    const size_t kstep = (size_t)(BK * 2);
    const size_t hstep = (size_t)HALF * K * 2;
    const size_t tstep = 2 * hstep;
    const unsigned ldsw = (unsigned)wid * 1024u;
    const int aoff = lds_byte(wr * 64 + fr, fq * 8), boff = lds_byte(wc * 32 + fr, fq * 8);
#define PG8_SA(b, h) (((b) * 2 + (h)) * HTB)
#define PG8_SB(b, h) ((4 + (b) * 2 + (h)) * HTB)
#define PG8_STAGE(bufoff, gbase, voff) do { _Pragma("unroll") for (int _i = 0; _i < 2; ++_i) \
        __builtin_amdgcn_global_load_lds((const unsigned*)((const char*)(gbase) + (voff)[_i]), (PG8_LAS unsigned*)(lds + (bufoff) + ldsw + _i * 8192), 16, 0, 0); } while (0)
#define PG8_LDA(dst, b, h) do { _Pragma("unroll") for (int m = 0; m < 4; ++m) _Pragma("unroll") for (int k = 0; k < 2; ++k) dst[m][k] = *(const PG8_LAS bf16x8*)(lds + PG8_SA(b, h) + aoff + m * 2048 + k * 1024); } while (0)
#define PG8_LDB(dst, b, h) do { _Pragma("unroll") for (int n = 0; n < 2; ++n) _Pragma("unroll") for (int k = 0; k < 2; ++k) dst[n][k] = *(const PG8_LAS bf16x8*)(lds + PG8_SB(b, h) + boff + n * 2048 + k * 1024); } while (0)
#define PG8_MMA(ai, bj, At, Bt) do { __builtin_amdgcn_s_setprio(1); _Pragma("unroll") for (int m = 0; m < 4; ++m) _Pragma("unroll") for (int n = 0; n < 2; ++n) _Pragma("unroll") for (int k = 0; k < 2; ++k) \
        acc[ai][bj][m][n] = __builtin_amdgcn_mfma_f32_16x16x32_bf16(Bt[n][k], At[m][k], acc[ai][bj][m][n], 0, 0, 0); __builtin_amdgcn_s_setprio(0); } while (0)
#define PG8_WAIT_V(n) asm volatile("s_waitcnt vmcnt(" #n ")" ::: "memory")
#define PG8_WAIT_L(n) asm volatile("s_waitcnt lgkmcnt(" #n ")" ::: "memory")
#define PG8_BAR __builtin_amdgcn_s_barrier()
#define PG8_SCHED __builtin_amdgcn_sched_barrier(0)
    Unit cur, nxt; int ui = 0;
    if (!S.next(0, cur)) return;
    f32x4 acc[2][2][4][2];
#pragma unroll
    for (int a = 0; a < 2; ++a)
#pragma unroll
        for (int b = 0; b < 2; ++b)
#pragma unroll
            for (int m = 0; m < 4; ++m)
#pragma unroll
                for (int n = 0; n < 2; ++n) acc[a][b][m][n] = (f32x4){0.f, 0.f, 0.f, 0.f};
    bf16x8 At[4][2], B0[2][2], B1[2][2];
    const char* cA = (const char*)g.A + (size_t)cur.pm * tstep; const char* cB = (const char*)g.Bt + (size_t)cur.pn * tstep;
    S.a_ready(cur);
    PG8_STAGE(PG8_SB(0, 0), cB, voffB); PG8_STAGE(PG8_SA(0, 0), cA, voffA); PG8_STAGE(PG8_SB(0, 1), cB + hstep, voffB); PG8_STAGE(PG8_SA(0, 1), cA + hstep, voffA);
    if (wr == 1) PG8_BAR;
    PG8_WAIT_V(4); PG8_BAR;
    PG8_STAGE(PG8_SB(1, 0), cB + kstep, voffB); PG8_STAGE(PG8_SA(1, 0), cA + kstep, voffA); PG8_STAGE(PG8_SB(1, 1), cB + hstep + kstep, voffB);
    PG8_WAIT_V(6); PG8_BAR;
    for (;;) {
        const bool has_next = S.next(ui + 1, nxt);
        const char* nA = has_next ? (const char*)g.A + (size_t)nxt.pm * tstep : cA; const char* nB = has_next ? (const char*)g.Bt + (size_t)nxt.pn * tstep : cB;
        int t = 0;
#pragma unroll
        for (int seg = 0; seg < (Epi::KHOOK > 0 ? 2 : 1); ++seg) {
        const int tend = (Epi::KHOOK > 0 && seg == 0) ? Epi::KHOOK : nt;
        for (; t < tend; t += 2) {
            const bool last = (t == nt - 2);
            const char* a1 = cA + (size_t)(t + 1) * kstep;
            const char* a2 = last ? nA : cA + (size_t)(t + 2) * kstep; const char* b2 = last ? nB : cB + (size_t)(t + 2) * kstep;
            const char* a3 = a2 + kstep; const char* b3 = b2 + kstep;
            if (last && has_next) S.a_ready(nxt);
            PG8_LDB(B0, 0, 0); PG8_SCHED; PG8_LDA(At, 0, 0); PG8_STAGE(PG8_SA(1, 1), a1 + hstep, voffA);
            PG8_WAIT_L(8); PG8_BAR; PG8_WAIT_L(0); PG8_MMA(0, 0, At, B0); PG8_BAR; PG8_SCHED;
            PG8_LDB(B1, 0, 1); PG8_STAGE(PG8_SB(0, 0), b2, voffB);
            PG8_BAR; PG8_WAIT_L(0); PG8_MMA(0, 1, At, B1); PG8_BAR;
            PG8_LDA(At, 0, 1); PG8_STAGE(PG8_SA(0, 0), a2, voffA);
            PG8_BAR; PG8_WAIT_L(0); PG8_MMA(1, 0, At, B0); PG8_BAR; PG8_SCHED;
            PG8_STAGE(PG8_SB(0, 1), b2 + hstep, voffB);
            PG8_WAIT_V(6); PG8_BAR; PG8_MMA(1, 1, At, B1); PG8_BAR;
            PG8_LDB(B0, 1, 0); PG8_SCHED; PG8_LDA(At, 1, 0); PG8_STAGE(PG8_SA(0, 1), a2 + hstep, voffA);
            PG8_WAIT_L(8); PG8_BAR; PG8_WAIT_L(0); PG8_MMA(0, 0, At, B0); PG8_BAR; PG8_SCHED;
            PG8_LDB(B1, 1, 1); PG8_STAGE(PG8_SB(1, 0), b3, voffB);
            PG8_BAR; PG8_WAIT_L(0); PG8_MMA(0, 1, At, B1); PG8_BAR;
            PG8_LDA(At, 1, 1); PG8_STAGE(PG8_SA(1, 0), a3, voffA);
            PG8_BAR; PG8_WAIT_L(0); PG8_MMA(1, 0, At, B0); PG8_BAR; PG8_SCHED;
            PG8_STAGE(PG8_SB(1, 1), b3 + hstep, voffB);
            PG8_WAIT_V(6); PG8_BAR; PG8_MMA(1, 1, At, B1); PG8_BAR;
        }
        if constexpr (Epi::KHOOK > 0) { if (seg == 0) E.mid(acc, cur, wr, wc, fr, fq); }
        }
        if constexpr (!Epi::AFTER_DRAIN) { E(acc, cur, wr, wc, fr, fq); S.done(cur); }
        if (!has_next) break;
#pragma unroll
        for (int a = 0; a < 2; ++a)
#pragma unroll
            for (int b = 0; b < 2; ++b)
#pragma unroll
                for (int m = 0; m < 4; ++m)
#pragma unroll
                    for (int n = 0; n < 2; ++n) acc[a][b][m][n] = (f32x4){0.f, 0.f, 0.f, 0.f};
        cur = nxt; cA = nA; cB = nB; ++ui;
    }
    PG8_WAIT_V(0);
    if (wr == 0) PG8_BAR;
    PG8_BAR;
    if constexpr (Epi::AFTER_DRAIN) { E.fused(acc, cur, wr, wc, fr, fq, lds, wid, lane); S.done(cur); }
#undef PG8_SA
#undef PG8_SB
#undef PG8_STAGE
#undef PG8_LDA
#undef PG8_LDB
#undef PG8_MMA
#undef PG8_WAIT_V
#undef PG8_WAIT_L
#undef PG8_BAR
#undef PG8_SCHED
}
}

#define LAS __attribute__((address_space(3)))
using pg8::bf16_t; using pg8::bf16x8; using pg8::f32x4; using pg8::u32x4;
typedef unsigned u32x2 __attribute__((ext_vector_type(2)));
typedef float f32x2 __attribute__((ext_vector_type(2)));
typedef short bf16x4 __attribute__((ext_vector_type(4)));

constexpr int DM = 1024, TB = 16384, NPROJ = 11008, DFF = 2816, NUP = 5632;
constexpr int C_QA = 0, C_KA = 1536, C_VA = 3072, C_QD = 4608, C_KD = 5632, C_VD = 6656, C_ZD = 7680, C_GA = 8704, C_GD = 9728, C_AB = 10752;
constexpr float EPSF = 1e-6f;
constexpr int LDS_BYTES = 147456;

constexpr size_t al256(size_t x) { return (x + 255) & ~(size_t)255; }
constexpr size_t WS_CTL = 0;
constexpr size_t WS_MOD = 20480;
constexpr size_t WS_ROPE = WS_MOD + al256((size_t)16 * 6144 * 4);
constexpr size_t WS_WIN = WS_ROPE + (size_t)4096 * 32 * 8;
constexpr size_t WS_WA = WS_WIN + (size_t)NPROJ * 1024 * 2;
constexpr size_t WS_WD = WS_WA + (size_t)1024 * 512 * 2;
constexpr size_t WS_WO = WS_WD + (size_t)1024 * 1024 * 2;
constexpr size_t WS_WUP = WS_WO + (size_t)1024 * 1024 * 2;
constexpr size_t WS_WDN = WS_WUP + (size_t)NUP * 1024 * 2;
constexpr size_t WS_XN = WS_WDN + (size_t)1024 * DFF * 2;
constexpr size_t WS_PROJ = WS_XN + (size_t)TB * 1024 * 2;
constexpr size_t WS_QKVD = WS_PROJ + (size_t)TB * NPROJ * 2;
constexpr size_t WS_TP = WS_QKVD + (size_t)TB * 3072 * 2;
constexpr size_t WS_EG = WS_TP + (size_t)4096 * 16384;
constexpr size_t WS_OD = WS_EG + (size_t)4096 * 512;
constexpr size_t WS_LSE = WS_OD + (size_t)2 * TB * 1024 * 2;
constexpr size_t WS_END = WS_LSE + (size_t)TB * 24 * 4;
static_assert(WS_END <= ((size_t)700 << 20), "workspace");

struct Params {
    const float* x_prompt; const float* x_sample; const float* c_prompt; const float* c_sample;
    const float* w_ada; const float* b_ada; const float* norm1_g; const float* w_in; const float* conv_qkv_w;
    const float* a_log; const float* dt_bias; const float* dn_norm_g; const float* w_br_attn; const float* w_br_dn;
    const float* w_out; const float* norm2_g; const float* w_up; const float* ffn_conv_w; const float* ffn_conv_b;
    const float* w_down; const float* norm_f_g;
    float* out; unsigned char* ws;
    int ph_lo, ph_hi;
};

__constant__ double INVF[32] = {1.0, 0.7498942093324559, 0.5623413251903491, 0.4216965034285822, 0.31622776601683794, 0.23713737056616552, 0.1778279410038923, 0.1333521432163324, 0.1, 0.07498942093324558, 0.05623413251903491, 0.042169650342858224, 0.03162277660168379, 0.023713737056616554, 0.01778279410038923, 0.01333521432163324, 0.01, 0.007498942093324558, 0.005623413251903491, 0.004216965034285823, 0.0031622776601683794, 0.0023713737056616554, 0.0017782794100389228, 0.001333521432163324, 0.001, 0.0007498942093324559, 0.0005623413251903491, 0.00042169650342858224, 0.00031622776601683794, 0.00023713737056616554, 0.00017782794100389227, 0.0001333521432163324};

__device__ __forceinline__ float bf2f(unsigned short b) { return __uint_as_float(((unsigned)b) << 16); }
__device__ __forceinline__ float bflo(unsigned w) { return __uint_as_float(w << 16); }
__device__ __forceinline__ float bfhi(unsigned w) { return __uint_as_float(w & 0xffff0000u); }
typedef __bf16 bf16x2n_t __attribute__((ext_vector_type(2)));
__device__ __forceinline__ unsigned pk2(float lo, float hi) { const f32x2 v = {lo, hi}; const bf16x2n_t r = __builtin_convertvector(v, bf16x2n_t); return __builtin_bit_cast(unsigned, r); }
__device__ __forceinline__ unsigned short f2bf(float f) { return (unsigned short)(pk2(f, 0.f) & 0xffffu); }
__device__ __forceinline__ float sigmoidf_(float x) { return 1.0f / (1.0f + __expf(-x)); }
__device__ __forceinline__ float siluf_(float x) { return x / (1.0f + __expf(-x)); }
__device__ __forceinline__ float wave_sum(float v) {
#pragma unroll
    for (int o = 32; o >= 1; o >>= 1) v += __shfl_xor(v, o);
    return v;
}
__device__ __forceinline__ int ltid() { int t = threadIdx.x; asm volatile("" : "+v"(t)); return t; }
struct Batch { int b, L, lgL, nseq; const float* x; float* out; };
__device__ __forceinline__ Batch make_batch(const Params& p, int b) {
    Batch B; B.b = b; B.L = b == 0 ? 2048 : 4096; B.lgL = b == 0 ? 11 : 12; B.nseq = TB >> B.lgL;
    B.x = b == 0 ? p.x_prompt : p.x_sample + (size_t)(b - 1) * TB * DM; B.out = p.out + (size_t)b * TB * DM; return B;
}
__device__ __forceinline__ int cond_index(const Batch& B, int row) { const int s = row >> B.lgL; return B.b == 0 ? s : 8 + (B.b - 1) * 4 + s; }

__device__ __forceinline__ float bf_el8(const u32x4& a, int e) { const unsigned w = a[(e >> 1) & 3]; return (e & 1) ? bfhi(w) : bflo(w); }
__device__ __forceinline__ void transpose_tile(const float* __restrict__ src, int Nsrc, bf16_t* __restrict__ dst, int K, int kt, int nt, int mode, LAS float* T, int koff = 0) {
    const int tid = ltid();
    const int c4 = (tid & 15) * 4, r0 = tid >> 4;
    const int j = nt * 64 + c4; int sj = j;
    if (mode == 1) sj = (j < 8704) ? j : (j < 10752) ? j + 32 : (j < 10784) ? j - 2048 : -1;
    if (mode == 2) { const int pn = j >> 8, jj = j & 255; sj = jj < 128 ? 128 * pn + jj : DFF + 128 * pn + (jj - 128); }
#pragma unroll
    for (int i = 0; i < 2; ++i) {
        const int r = r0 + 32 * i;
        f32x4 v = {0.f, 0.f, 0.f, 0.f};
        if (sj >= 0) v = *(const f32x4*)(src + (size_t)(kt * 64 + r) * Nsrc + sj);
        T[r * 65 + c4 + 0] = v[0]; T[r * 65 + c4 + 1] = v[1]; T[r * 65 + c4 + 2] = v[2]; T[r * 65 + c4 + 3] = v[3];
    }
    __syncthreads();
    const int n = tid >> 3, kp = (tid & 7) * 8;
    u32x4 w;
    w.x = pk2(T[(kp + 0) * 65 + n], T[(kp + 1) * 65 + n]); w.y = pk2(T[(kp + 2) * 65 + n], T[(kp + 3) * 65 + n]);
    w.z = pk2(T[(kp + 4) * 65 + n], T[(kp + 5) * 65 + n]); w.w = pk2(T[(kp + 6) * 65 + n], T[(kp + 7) * 65 + n]);
    *(u32x4*)(dst + (size_t)(nt * 64 + n) * K + koff + kt * 64 + kp) = w;
    __syncthreads();
}

__device__ __forceinline__ void mod_item(const Params& p, int item, LAS unsigned char* L) {
    LAS float* sc = (LAS float*)L;
    LAS float* red = (LAS float*)(L + 65536);
    const int tid = ltid(), lane = tid & 63, wid = tid >> 6;
    for (int e = tid; e < 16384; e += 512) { const int r = e >> 10, k = e & 1023; const float c = r < 8 ? p.c_prompt[r * 1024 + k] : p.c_sample[(r - 8) * 1024 + k]; sc[k * 16 + r] = siluf_(c); }
    __syncthreads();
    const int j = item * 64 + lane;
    float acc[16];
#pragma unroll
    for (int r = 0; r < 16; ++r) acc[r] = 0.f;
    for (int k = wid * 128; k < wid * 128 + 128; ++k) {
        const float w = p.w_ada[(size_t)k * 6144 + j];
#pragma unroll
        for (int q = 0; q < 4; ++q) { const f32x4 s = *(const LAS f32x4*)(sc + k * 16 + 4 * q);
            acc[4 * q + 0] += w * s[0]; acc[4 * q + 1] += w * s[1]; acc[4 * q + 2] += w * s[2]; acc[4 * q + 3] += w * s[3]; }
    }
#pragma unroll
    for (int r = 0; r < 16; ++r) red[(wid * 16 + r) * 64 + lane] = acc[r];
    __syncthreads();
    float* MOD = (float*)(p.ws + WS_MOD);
    for (int e = tid; e < 1024; e += 512) { const int r = e >> 6, l = e & 63; float s = 0.f;
#pragma unroll
        for (int w = 0; w < 8; ++w) s += red[(w * 16 + r) * 64 + l];
        MOD[r * 6144 + item * 64 + l] = s + p.b_ada[item * 64 + l]; }
    __syncthreads();
}

__device__ __forceinline__ void phase0(const Params& p, LAS unsigned char* L) {
    const int G = gridDim.x, bid = blockIdx.x, tid = ltid();
    { f32x2* R = (f32x2*)(p.ws + WS_ROPE);
      for (int e = bid * 512 + tid; e < 4096 * 32; e += G * 512) { const int pos = e >> 5, i = e & 31;
          const double rev = (double)pos * INVF[i] * 0.15915494309189535; const double fr = rev - __builtin_rint(rev);
          f32x2 cs; cs.x = __builtin_amdgcn_cosf((float)fr); cs.y = __builtin_amdgcn_sinf((float)fr); R[e] = cs; } }
    if (bid >= G - 96) mod_item(p, bid - (G - 96), L);
    constexpr int I_IN = 16 * 172, I_A = 8 * 16, I_D = 16 * 16, I_O = 16 * 16, I_UP = 16 * 88, I_DN = 44 * 16;
    constexpr int NIT = I_IN + I_A + I_D + I_O + I_UP + I_DN;
    LAS float* T = (LAS float*)L;
    const int tid_ = ltid(), c4 = (tid_ & 15) * 4, r0 = tid_ >> 4, n_ = tid_ >> 3, kp = (tid_ & 7) * 8;
    for (int it0 = bid; it0 < NIT; it0 += 2 * G) {
        const float* src[2]; bf16_t* dst[2]; int Nsrc[2], K[2], kt[2], nt[2], mode[2], koff[2]; bool on[2];
#pragma unroll
        for (int u = 0; u < 2; ++u) { int r = it0 + u * G; on[u] = r < NIT; if (!on[u]) r = it0; koff[u] = 0; mode[u] = 0;
            if (r < I_IN) { src[u] = p.w_in; Nsrc[u] = 10784; dst[u] = (bf16_t*)(p.ws + WS_WIN); K[u] = 1024; kt[u] = r & 15; nt[u] = r >> 4; mode[u] = 1; }
            else if ((r -= I_IN) < I_A) { src[u] = p.w_br_attn; Nsrc[u] = 1024; dst[u] = (bf16_t*)(p.ws + WS_WA); K[u] = 1536; kt[u] = r & 7; nt[u] = r >> 3; }
            else if ((r -= I_A) < I_D) { src[u] = p.w_br_dn; Nsrc[u] = 1024; dst[u] = (bf16_t*)(p.ws + WS_WA); K[u] = 1536; kt[u] = r & 15; nt[u] = r >> 4; koff[u] = 512; }
            else if ((r -= I_D) < I_O) { src[u] = p.w_out; Nsrc[u] = 1024; dst[u] = (bf16_t*)(p.ws + WS_WO); K[u] = 1024; kt[u] = r & 15; nt[u] = r >> 4; }
            else if ((r -= I_O) < I_UP) { src[u] = p.w_up; Nsrc[u] = NUP; dst[u] = (bf16_t*)(p.ws + WS_WUP); K[u] = 1024; kt[u] = r & 15; nt[u] = r >> 4; mode[u] = 2; }
            else { r -= I_UP; src[u] = p.w_down; Nsrc[u] = 1024; dst[u] = (bf16_t*)(p.ws + WS_WDN); K[u] = DFF; kt[u] = r % 44; nt[u] = r / 44; } }
        f32x4 v[2][2];
#pragma unroll
        for (int u = 0; u < 2; ++u) { const int j = nt[u] * 64 + c4; int sj = j;
            if (mode[u] == 1) sj = (j < 8704) ? j : (j < 10752) ? j + 32 : (j < 10784) ? j - 2048 : -1;
            if (mode[u] == 2) { const int pn = j >> 8, jj = j & 255; sj = jj < 128 ? 128 * pn + jj : DFF + 128 * pn + (jj - 128); }
#pragma unroll
            for (int i = 0; i < 2; ++i) { v[u][i] = (f32x4){0.f, 0.f, 0.f, 0.f}; if (sj >= 0) v[u][i] = *(const f32x4*)(src[u] + (size_t)(kt[u] * 64 + r0 + 32 * i) * Nsrc[u] + sj); } }
#pragma unroll
        for (int u = 0; u < 2; ++u)
#pragma unroll
            for (int i = 0; i < 2; ++i) { LAS float* tp = T + u * 4160 + (r0 + 32 * i) * 65 + c4; tp[0] = v[u][i][0]; tp[1] = v[u][i][1]; tp[2] = v[u][i][2]; tp[3] = v[u][i][3]; }
        __syncthreads();
#pragma unroll
        for (int u = 0; u < 2; ++u) if (on[u]) { const LAS float* tq = T + u * 4160 + kp * 65 + n_; u32x4 w;
            w.x = pk2(tq[0], tq[65]); w.y = pk2(tq[130], tq[195]); w.z = pk2(tq[260], tq[325]); w.w = pk2(tq[390], tq[455]);
            *(u32x4*)(dst[u] + (size_t)(nt[u] * 64 + n_) * K[u] + koff[u] + kt[u] * 64 + kp) = w; }
        __syncthreads();
    }
}

__device__ __forceinline__ void norm_mod_rows(const Params& p, const Batch& B, const float* __restrict__ xin, const float* __restrict__ g, int sh_off, int sc_off, bf16_t* __restrict__ out) {
    const int lane = ltid() & 63, gw = blockIdx.x * 8 + (ltid() >> 6), NGW = gridDim.x * 8;
    const float* MOD = (const float*)(p.ws + WS_MOD);
    f32x4 gv[4];
#pragma unroll
    for (int i = 0; i < 4; ++i) gv[i] = *(const f32x4*)(g + 4 * lane + 256 * i);
    for (int r = gw; r < TB; r += 2 * NGW) {
        const int r1 = r + NGW; const bool has1 = r1 < TB; const int rb = has1 ? r1 : r;
        const float* xa = xin + (size_t)r * DM; const float* xb = xin + (size_t)rb * DM;
        f32x4 va[4], vb[4]; float sa = 0.f, sb = 0.f;
#pragma unroll
        for (int i = 0; i < 4; ++i) { va[i] = *(const f32x4*)(xa + 4 * lane + 256 * i); vb[i] = *(const f32x4*)(xb + 4 * lane + 256 * i); }
#pragma unroll
        for (int i = 0; i < 4; ++i) { sa += va[i][0] * va[i][0] + va[i][1] * va[i][1] + va[i][2] * va[i][2] + va[i][3] * va[i][3]; sb += vb[i][0] * vb[i][0] + vb[i][1] * vb[i][1] + vb[i][2] * vb[i][2] + vb[i][3] * vb[i][3]; }
        const float rsa = rsqrtf(wave_sum(sa) * (1.0f / DM) + EPSF), rsb = rsqrtf(wave_sum(sb) * (1.0f / DM) + EPSF);
        const float* ma = MOD + (size_t)cond_index(B, r) * 6144; const float* mb = MOD + (size_t)cond_index(B, rb) * 6144;
#pragma unroll
        for (int i = 0; i < 4; ++i) { const f32x4 sc = *(const f32x4*)(ma + sc_off + 4 * lane + 256 * i), sh = *(const f32x4*)(ma + sh_off + 4 * lane + 256 * i);
            const f32x4 y = va[i] * rsa * gv[i] * (sc + 1.0f) + sh; u32x2 w; w.x = pk2(y[0], y[1]); w.y = pk2(y[2], y[3]);
            *(u32x2*)(out + (size_t)r * DM + 4 * lane + 256 * i) = w; }
        if (has1) {
#pragma unroll
            for (int i = 0; i < 4; ++i) { const f32x4 sc = *(const f32x4*)(mb + sc_off + 4 * lane + 256 * i), sh = *(const f32x4*)(mb + sh_off + 4 * lane + 256 * i);
                const f32x4 y = vb[i] * rsb * gv[i] * (sc + 1.0f) + sh; u32x2 w; w.x = pk2(y[0], y[1]); w.y = pk2(y[2], y[3]);
                *(u32x2*)(out + (size_t)r1 * DM + 4 * lane + 256 * i) = w; } }
    }
}
__device__ __forceinline__ void final_norm_rows(float* __restrict__ io, const float* __restrict__ g) {
    const int lane = ltid() & 63, gw = blockIdx.x * 8 + (ltid() >> 6), NGW = gridDim.x * 8;
    f32x4 gv[4];
#pragma unroll
    for (int i = 0; i < 4; ++i) gv[i] = *(const f32x4*)(g + 4 * lane + 256 * i);
    for (int r = gw; r < TB; r += 2 * NGW) {
        const int r1 = r + NGW; const bool has1 = r1 < TB; const int rb = has1 ? r1 : r;
        float* xa = io + (size_t)r * DM; float* xb = io + (size_t)rb * DM; f32x4 va[4], vb[4]; float sa = 0.f, sb = 0.f;
#pragma unroll
        for (int i = 0; i < 4; ++i) { va[i] = *(const f32x4*)(xa + 4 * lane + 256 * i); vb[i] = *(const f32x4*)(xb + 4 * lane + 256 * i); }
#pragma unroll
        for (int i = 0; i < 4; ++i) { sa += va[i][0] * va[i][0] + va[i][1] * va[i][1] + va[i][2] * va[i][2] + va[i][3] * va[i][3]; sb += vb[i][0] * vb[i][0] + vb[i][1] * vb[i][1] + vb[i][2] * vb[i][2] + vb[i][3] * vb[i][3]; }
        const float rsa = rsqrtf(wave_sum(sa) * (1.0f / DM) + EPSF), rsb = rsqrtf(wave_sum(sb) * (1.0f / DM) + EPSF);
#pragma unroll
        for (int i = 0; i < 4; ++i) *(f32x4*)(xa + 4 * lane + 256 * i) = va[i] * rsa * gv[i];
        if (has1) {
#pragma unroll
            for (int i = 0; i < 4; ++i) *(f32x4*)(xb + 4 * lane + 256 * i) = vb[i] * rsb * gv[i]; }
    }
}

struct EpiBf16S {
    static constexpr bool PERM = true, AFTER_DRAIN = false; static constexpr int KHOOK = 0;
    bf16_t* O; int ldc;
    __device__ __forceinline__ void operator()(const f32x4 (&acc)[2][2][4][2], const pg8::Unit& u, int wr, int wc, int fr, int fq) const {
        const int row0 = u.pm * 256 + wr * 64 + fr, col0 = u.pn * 256 + wc * 32 + 8 * fq;
#pragma unroll
        for (int ai = 0; ai < 2; ++ai)
#pragma unroll
            for (int m = 0; m < 4; ++m) { bf16_t* rowp = O + (size_t)(row0 + ai * 128 + m * 16) * ldc + col0;
#pragma unroll
                for (int bj = 0; bj < 2; ++bj) { const f32x4 v0 = acc[ai][bj][m][0], v1 = acc[ai][bj][m][1];
                    u32x4 w; w.x = pk2(v0[0], v0[1]); w.y = pk2(v0[2], v0[3]); w.z = pk2(v1[0], v1[1]); w.w = pk2(v1[2], v1[3]);
                    *(u32x4*)(rowp + bj * 128) = w; } }
    }
};
struct EpiMerge {
    static constexpr bool PERM = true, AFTER_DRAIN = false; static constexpr int KHOOK = 8;
    const bf16_t* ga; const bf16_t* gd; int ldg; bf16_t* O;
    __device__ __forceinline__ void mid(f32x4 (&acc)[2][2][4][2], const pg8::Unit& u, int wr, int wc, int fr, int fq) const {
        const int row0 = u.pm * 256 + wr * 64 + fr, col0 = u.pn * 256 + wc * 32 + 8 * fq;
        size_t ro = (size_t)row0 * ldg + col0;
#pragma unroll
        for (int ai = 0; ai < 2; ++ai) {
#pragma unroll
            for (int m = 0; m < 4; ++m) {
#pragma unroll
                for (int bj = 0; bj < 2; ++bj) { const u32x4 a = *(const u32x4*)(ga + ro + bj * 128), d = *(const u32x4*)(gd + ro + bj * 128);
#pragma unroll
                    for (int q = 0; q < 4; ++q) { const float r0 = (1.0f + __expf(-bflo(d[q]))) * __builtin_amdgcn_rcpf(1.0f + __expf(-bflo(a[q]))), r1 = (1.0f + __expf(-bfhi(d[q]))) * __builtin_amdgcn_rcpf(1.0f + __expf(-bfhi(a[q])));
                        acc[ai][bj][m][q >> 1][2 * (q & 1)] *= r0; acc[ai][bj][m][q >> 1][2 * (q & 1) + 1] *= r1; }
                    asm volatile("" : "+v"(ro) :: "memory"); }
                ro += (size_t)16 * ldg; }
            ro += (size_t)64 * ldg; }
    }
    __device__ __forceinline__ void operator()(const f32x4 (&acc)[2][2][4][2], const pg8::Unit& u, int wr, int wc, int fr, int fq) const {
        const int row0 = u.pm * 256 + wr * 64 + fr, col0 = u.pn * 256 + wc * 32 + 8 * fq;
#pragma unroll
        for (int ai = 0; ai < 2; ++ai)
#pragma unroll
            for (int m = 0; m < 4; ++m) { const int row = row0 + ai * 128 + m * 16;
#pragma unroll
                for (int bj = 0; bj < 2; ++bj) { const u32x4 d = *(const u32x4*)(gd + (size_t)row * ldg + col0 + bj * 128); const f32x4 v0 = acc[ai][bj][m][0], v1 = acc[ai][bj][m][1];
                    u32x4 w; w.x = pk2(v0[0] * sigmoidf_(bflo(d.x)), v0[1] * sigmoidf_(bfhi(d.x))); w.y = pk2(v0[2] * sigmoidf_(bflo(d.y)), v0[3] * sigmoidf_(bfhi(d.y)));
                    w.z = pk2(v1[0] * sigmoidf_(bflo(d.z)), v1[1] * sigmoidf_(bfhi(d.z))); w.w = pk2(v1[2] * sigmoidf_(bflo(d.w)), v1[3] * sigmoidf_(bfhi(d.w)));
                    *(u32x4*)(O + (size_t)row * DM + col0 + bj * 128) = w; }
                asm volatile("" ::: "memory"); }
    }
};
struct OneUnit {
    pg8::Unit u0;
    __device__ __forceinline__ bool next(int i, pg8::Unit& u) const { if (i != 0) return false; u = u0; return true; }
    __device__ __forceinline__ void a_ready(const pg8::Unit&) const {}
    __device__ __forceinline__ void done(const pg8::Unit&) const {}
};
struct EpiConvFfn {
    static constexpr bool PERM = false, AFTER_DRAIN = true; static constexpr int KHOOK = 0;
    bf16_t* ACT; const float* cw; const float* cb; int rowstart, Lseq;
    __device__ __forceinline__ void fused(f32x4 (&acc)[2][2][4][2], const pg8::Unit& u, int wr, int wc, int fr, int fq, LAS unsigned char* lds, int wid, int lane) const {
        LAS bf16_t* T = (LAS bf16_t*)lds;
        LAS float* W = (LAS float*)(lds + 135168);
        const int tid = wid * 64 + lane;
        for (int e = tid; e < 1024; e += 512) { const int k = e >> 7, c = e & 127, cg_ = 128 * u.pn + c; float v;
            if (k < 3) v = cw[k * NUP + cg_]; else if (k < 6) v = cw[(k - 3) * NUP + DFF + cg_]; else if (k == 6) v = cb[cg_]; else v = cb[DFF + cg_];
            W[e] = v; }
#pragma unroll
        for (int ai = 0; ai < 2; ++ai)
#pragma unroll
            for (int m = 0; m < 4; ++m) { const int row = ai * 128 + wr * 64 + m * 16 + fr;
#pragma unroll
                for (int bj = 0; bj < 2; ++bj)
#pragma unroll
                    for (int n = 0; n < 2; ++n) { const int col = bj * 128 + wc * 32 + n * 16 + 4 * fq; const f32x4 v = acc[ai][bj][m][n];
                        u32x2 w; w.x = pk2(v[0], v[1]); w.y = pk2(v[2], v[3]); *(LAS u32x2*)(T + row * 264 + col) = w; } }
        __syncthreads();
        const u32x4 z4 = {0u, 0u, 0u, 0u};
#pragma unroll 1
        for (int i = 0; i < 8; ++i) { const int t = tid + 512 * i; if (t >= 4064) break;
            const int r = 1 + (t >> 4), c8 = (t & 15) * 8, grow = rowstart + r; if (grow < 0 || grow >= TB) continue;
            const int s_ = grow & (Lseq - 1);
            const LAS bf16_t* tp = T + r * 264 + c8;
            u32x4 vp = *(const LAS u32x4*)(tp - 264), vc = *(const LAS u32x4*)tp, vn = *(const LAS u32x4*)(tp + 264);
            u32x4 gp = *(const LAS u32x4*)(tp - 264 + 128), gc = *(const LAS u32x4*)(tp + 128), gn = *(const LAS u32x4*)(tp + 264 + 128);
            if (s_ == 0) { vp = z4; gp = z4; }
            if (s_ == Lseq - 1) { vn = z4; gn = z4; }
            float o[8];
#pragma unroll
            for (int q = 0; q < 2; ++q) { const f32x4 wv0 = *(const LAS f32x4*)(W + c8 + 4 * q), wv1 = *(const LAS f32x4*)(W + 128 + c8 + 4 * q), wv2 = *(const LAS f32x4*)(W + 256 + c8 + 4 * q);
                const f32x4 wg0 = *(const LAS f32x4*)(W + 384 + c8 + 4 * q), wg1 = *(const LAS f32x4*)(W + 512 + c8 + 4 * q), wg2 = *(const LAS f32x4*)(W + 640 + c8 + 4 * q);
                const f32x4 bv = *(const LAS f32x4*)(W + 768 + c8 + 4 * q), bg = *(const LAS f32x4*)(W + 896 + c8 + 4 * q);
#pragma unroll
                for (int k = 0; k < 4; ++k) { const int e = 4 * q + k;
                    const float val = bf_el8(vp, e) * wv0[k] + bf_el8(vc, e) * wv1[k] + bf_el8(vn, e) * wv2[k] + bv[k];
                    const float gt = bf_el8(gp, e) * wg0[k] + bf_el8(gc, e) * wg1[k] + bf_el8(gn, e) * wg2[k] + bg[k];
                    o[e] = siluf_(gt) * val; } }
            u32x4 w; w.x = pk2(o[0], o[1]); w.y = pk2(o[2], o[3]); w.z = pk2(o[4], o[5]); w.w = pk2(o[6], o[7]);
            *(u32x4*)(ACT + (size_t)grow * DFF + 128 * u.pn + c8) = w; }
        __syncthreads();
    }
};
struct EpiResid {
    static constexpr bool PERM = false, AFTER_DRAIN = false; static constexpr int KHOOK = 0;
    const float* xin; float* out; const float* gt; int lgL, cbase;
    __device__ __forceinline__ void operator()(const f32x4 (&acc)[2][2][4][2], const pg8::Unit& u, int wr, int wc, int fr, int fq) const {
        const int row0 = u.pm * 256 + wr * 64 + fr, col0 = u.pn * 256 + wc * 32 + 4 * fq;
#pragma unroll
        for (int ai = 0; ai < 2; ++ai)
#pragma unroll
            for (int m = 0; m < 4; ++m) { const int row = row0 + ai * 128 + m * 16; const float* gr = gt + (size_t)(cbase + (row >> lgL)) * 6144;
#pragma unroll
                for (int bj = 0; bj < 2; ++bj)
#pragma unroll
                    for (int n = 0; n < 2; ++n) { const int col = col0 + bj * 128 + n * 16;
                        const f32x4 xv = *(const f32x4*)(xin + (size_t)row * DM + col), gv = *(const f32x4*)(gr + col);
                        *(f32x4*)(out + (size_t)row * DM + col) = xv + gv * acc[ai][bj][m][n]; } }
    }
};

__device__ __forceinline__ bf16x8 permfrag_sw(const LAS bf16_t* base, int row, int stride, int kbase, int g, int sw) {
    const u32x2 lo = *(const LAS u32x2*)(base + row * stride + ((kbase + 4 * g) ^ sw)), hi = *(const LAS u32x2*)(base + row * stride + ((kbase + 16 + 4 * g) ^ sw));
    u32x4 w; w.x = lo.x; w.y = lo.y; w.z = hi.x; w.w = hi.y; return __builtin_bit_cast(bf16x8, w);
}
#define MFMA16(a, b, c) __builtin_amdgcn_mfma_f32_16x16x32_bf16((a), (b), (c), 0, 0, 0)
__device__ __forceinline__ float bf_el(const u32x4& a, const u32x4& b, int e) { const unsigned w = (e < 8) ? a[(e >> 1) & 3] : b[(e >> 1) & 3]; return (e & 1) ? bfhi(w) : bflo(w); }

__device__ __forceinline__ void prep_item(const Params& p, const Batch& B, int item, LAS unsigned char* L) {
    const int tid = ltid(), lane = tid & 63, wid = tid >> 6, g = lane >> 4, fr = lane & 15;
    const int NC = B.L >> 6;
    const int hp = item & 3, sn = item >> 2, n = sn & (NC - 1), seq = sn >> (B.lgL - 6);
    const int r0 = seq * B.L + n * 64;
    LAS bf16_t* KS = (LAS bf16_t*)L;
    LAS bf16_t* QS = (LAS bf16_t*)(L + 34816);
    LAS float* AA = (LAS float*)L;
    LAS float* KK = (LAS float*)(L + 69632);
    LAS float* QK = (LAS float*)(L + 102912);
    LAS float* GS = (LAS float*)(L + 136192);
    const bf16_t* PROJ = (const bf16_t*)(p.ws + WS_PROJ);
    bf16_t* QKVD = (bf16_t*)(p.ws + WS_QKVD);
    LAS float* CW = (LAS float*)(L + 69632);
    for (int e = tid; e < 2304; e += 512) { const int hh = e / 1152, rem = e - hh * 1152, mat = rem / 384, rem2 = rem - mat * 384, tap = rem2 >> 7, c = rem2 & 127;
        CW[e] = p.conv_qkv_w[tap * 3072 + mat * 1024 + (hp * 2 + hh) * 128 + c]; }
    float al_pre = 0.f, be_pre = 0.f;
    if (wid < 4) { const int hh = wid >> 1, dir = wid & 1, h = hp * 2 + hh; const int c = dir ? 63 - lane : lane; const int row = r0 + c;
        al_pre = bf2f(PROJ[(size_t)row * NPROJ + C_AB + dir * 8 + h]); be_pre = bf2f(PROJ[(size_t)row * NPROJ + C_AB + 16 + dir * 8 + h]); }
    __syncthreads();
    {
        const int r = tid >> 3, pc = (tid & 7) * 16; const int row = r0 + r; const int s = n * 64 + r;
        const bool hasp = s > 0, hasn = s < B.L - 1;
        const u32x4 z4 = {0u, 0u, 0u, 0u};
#pragma unroll
        for (int hh = 0; hh < 2; ++hh) {
            const int h = hp * 2 + hh;
            u32x4 xc[3][2], xp[3][2], xn[3][2];
#pragma unroll
            for (int mat = 0; mat < 3; ++mat) { const bf16_t* src = PROJ + (size_t)row * NPROJ + C_QD + mat * 1024 + h * 128 + pc;
                xc[mat][0] = *(const u32x4*)src; xc[mat][1] = *(const u32x4*)(src + 8); xp[mat][0] = z4; xp[mat][1] = z4; xn[mat][0] = z4; xn[mat][1] = z4;
                if (hasp) { xp[mat][0] = *(const u32x4*)(src - NPROJ); xp[mat][1] = *(const u32x4*)(src - NPROJ + 8); }
                if (hasn) { xn[mat][0] = *(const u32x4*)(src + NPROJ); xn[mat][1] = *(const u32x4*)(src + NPROJ + 8); } }
#pragma unroll
            for (int mat = 0; mat < 3; ++mat) {
                const int col = mat * 1024 + h * 128 + pc;
                const LAS float* cw = CW + (hh * 3 + mat) * 384 + pc;
                float y[16]; float ss = 0.f;
#pragma unroll
                for (int q = 0; q < 4; ++q) {
                    const f32x4 w0 = *(const LAS f32x4*)(cw + 4 * q), w1 = *(const LAS f32x4*)(cw + 128 + 4 * q), w2 = *(const LAS f32x4*)(cw + 256 + 4 * q);
#pragma unroll
                    for (int e = 0; e < 4; ++e) { const int ee = 4 * q + e;
                        float v = bf_el(xp[mat][0], xp[mat][1], ee) * w0[e] + bf_el(xc[mat][0], xc[mat][1], ee) * w1[e] + bf_el(xn[mat][0], xn[mat][1], ee) * w2[e];
                        v = siluf_(v); y[ee] = v; ss += v * v; }
                }
                if (mat < 2) {
                    ss += __shfl_xor(ss, 1); ss += __shfl_xor(ss, 2); ss += __shfl_xor(ss, 4);
                    float sc = rsqrtf(ss + EPSF); if (mat == 0) sc *= 0.08838834764831845f;
#pragma unroll
                    for (int e = 0; e < 16; ++e) y[e] *= sc;
                }
                u32x4 o0, o1;
                o0.x = pk2(y[0], y[1]); o0.y = pk2(y[2], y[3]); o0.z = pk2(y[4], y[5]); o0.w = pk2(y[6], y[7]);
                o1.x = pk2(y[8], y[9]); o1.y = pk2(y[10], y[11]); o1.z = pk2(y[12], y[13]); o1.w = pk2(y[14], y[15]);
                bf16_t* dst = QKVD + (size_t)row * 3072 + col;
                *(u32x4*)dst = o0; *(u32x4*)(dst + 8) = o1;
                if (mat == 0) { *(LAS u32x4*)(QS + (hh * 64 + r) * 136 + pc) = o0; *(LAS u32x4*)(QS + (hh * 64 + r) * 136 + pc + 8) = o1; }
                if (mat == 1) { *(LAS u32x4*)(KS + (hh * 64 + r) * 136 + pc) = o0; *(LAS u32x4*)(KS + (hh * 64 + r) * 136 + pc + 8) = o1; }
            }
        }
    }
    __syncthreads();
    {
        const int hh = wid >> 2, ct = wid & 3; const LAS bf16_t* Kh = KS + hh * 64 * 136; const LAS bf16_t* Qh = QS + hh * 64 * 136;
        bf16x8 ak[4], aq[4];
#pragma unroll
        for (int ks = 0; ks < 4; ++ks) { ak[ks] = *(const LAS bf16x8*)(Kh + (16 * ct + fr) * 136 + 32 * ks + 8 * g); aq[ks] = *(const LAS bf16x8*)(Qh + (16 * ct + fr) * 136 + 32 * ks + 8 * g); }
#pragma unroll
        for (int dt = 0; dt < 4; ++dt) {
            f32x4 c0 = {0.f, 0.f, 0.f, 0.f}, c1 = {0.f, 0.f, 0.f, 0.f};
#pragma unroll
            for (int ks = 0; ks < 4; ++ks) { const bf16x8 b = *(const LAS bf16x8*)(Kh + (16 * dt + fr) * 136 + 32 * ks + 8 * g); c0 = MFMA16(ak[ks], b, c0); c1 = MFMA16(aq[ks], b, c1); }
#pragma unroll
            for (int j = 0; j < 4; ++j) { KK[hh * 4160 + (16 * ct + 4 * g + j) * 65 + 16 * dt + fr] = c0[j]; QK[hh * 4160 + (16 * ct + 4 * g + j) * 65 + 16 * dt + fr] = c1[j]; }
        }
    }
    if (wid < 4) {
        const int hh = wid >> 1, dir = wid & 1, h = hp * 2 + hh; const int c = dir ? 63 - lane : lane; const int row = r0 + c;
        const float al = al_pre, be = be_pre; (void)row;
        const float xx = al + p.dt_bias[dir * 8 + h]; const float sp = fmaxf(xx, 0.f) + log1pf(__expf(-fabsf(xx)));
        float G = -__expf(p.a_log[dir * 8 + h]) * sp;
#pragma unroll
        for (int o = 1; o < 64; o <<= 1) { const float t = __shfl_up(G, o); if (lane >= o) G += t; }
        const float G63 = __shfl(G, 63);
        GS[wid * 128 + lane] = G; GS[wid * 128 + 64 + lane] = sigmoidf_(be);
        const int np = dir ? NC - 1 - n : n; const size_t cid = ((size_t)((seq * 2 + dir) * 8 + h)) * NC + np;
        float* EG = (float*)(p.ws + WS_EG) + cid * 128; EG[lane] = __expf(G); EG[64 + lane] = __expf(G63 - G);
    }
    __syncthreads();
    for (int e = tid; e < 16384; e += 512) { const int sv = e >> 12, hh = sv >> 1, dir = sv & 1, j = (e >> 6) & 63, i = e & 63; float a = 0.f;
        if (i > j) { const int ci = dir ? 63 - i : i, cj = dir ? 63 - j : j; a = GS[sv * 128 + 64 + i] * KK[hh * 4160 + ci * 65 + cj] * __expf(GS[sv * 128 + i] - GS[sv * 128 + j]); }
        AA[(sv * 64 + j) * 68 + i] = a; }
    __syncthreads();
    if (wid < 4) {
        const int sv = wid, hh = sv >> 1, dir = sv & 1, h = hp * 2 + hh; const LAS float* Ad = AA + sv * 64 * 68;
        float acc[64];
#pragma unroll
        for (int i = 0; i < 64; ++i) acc[i] = (lane == i) ? 1.f : 0.f;
#pragma unroll
        for (int j = 0; j < 63; ++j) { const float tj = acc[j];
#pragma unroll
            for (int i4 = ((j + 1) & ~3); i4 < 64; i4 += 4) { const f32x4 a = *(const LAS f32x4*)(Ad + j * 68 + i4);
#pragma unroll
                for (int e = 0; e < 4; ++e) if (i4 + e > j) acc[i4 + e] -= a[e] * tj; } }
        const int np = dir ? NC - 1 - n : n; const size_t cid = ((size_t)((seq * 2 + dir) * 8 + h)) * NC + np;
        bf16_t* Tg = (bf16_t*)(p.ws + WS_TP) + cid * 8192; const float bl = GS[sv * 128 + 64 + lane];
#pragma unroll
        for (int i = 0; i < 64; ++i) Tg[i * 64 + lane] = f2bf(acc[i] * bl);
    } else {
        bf16_t* TPg = (bf16_t*)(p.ws + WS_TP);
        for (int t = tid - 256; t < 2048; t += 256) { const int sv = t >> 9, hh = sv >> 1, dir = sv & 1, h = hp * 2 + hh, i = (t >> 3) & 63, j0 = (t & 7) * 8;
            const int np = dir ? NC - 1 - n : n; const size_t cid = ((size_t)((seq * 2 + dir) * 8 + h)) * NC + np;
            float v[8]; const int ci = dir ? 63 - i : i; const float Gi = GS[sv * 128 + i];
#pragma unroll
            for (int e = 0; e < 8; ++e) { const int j = j0 + e, cj = dir ? 63 - j : j; v[e] = (i >= j) ? QK[hh * 4160 + ci * 65 + cj] * __expf(Gi - GS[sv * 128 + j]) : 0.f; }
            u32x4 w; w.x = pk2(v[0], v[1]); w.y = pk2(v[2], v[3]); w.z = pk2(v[4], v[5]); w.w = pk2(v[6], v[7]);
            *(u32x4*)(TPg + cid * 8192 + 4096 + i * 64 + j0) = w; }
    }
    __syncthreads();
}

__device__ __forceinline__ bf16x8 pack8(const f32x4& a, const f32x4& b) { u32x4 w; w.x = pk2(a[0], a[1]); w.y = pk2(a[2], a[3]); w.z = pk2(b[0], b[1]); w.w = pk2(b[2], b[3]); return __builtin_bit_cast(bf16x8, w); }
__device__ __forceinline__ bf16x8 permfrag(const LAS bf16_t* base, int row, int stride, int kbase, int g) {
    const u32x2 lo = *(const LAS u32x2*)(base + row * stride + kbase + 4 * g), hi = *(const LAS u32x2*)(base + row * stride + kbase + 16 + 4 * g);
    u32x4 w; w.x = lo.x; w.y = lo.y; w.z = hi.x; w.w = hi.y; return __builtin_bit_cast(bf16x8, w);
}

__device__ __forceinline__ void scan_chain(const Params& p, const Batch& B, int chain, int vs, int lgVS, LAS unsigned char* L) {
    const int tid = ltid(), lane = tid & 63, wid = tid >> 6, g = lane >> 4, fr = lane & 15;
    const int NC = B.L >> 6;
    const int h = chain & 7, dir = (chain >> 3) & 1, seq = chain >> 4;
    LAS bf16_t* KS = (LAS bf16_t*)L;
    LAS bf16_t* KT = (LAS bf16_t*)(L + 124416);
    LAS bf16_t* QS = (LAS bf16_t*)(L + 35840);
    LAS bf16_t* VS = (LAS bf16_t*)(L + 53248);
    LAS bf16_t* TS = (LAS bf16_t*)(L + 70656);
    LAS bf16_t* PS = (LAS bf16_t*)(L + 79872);
    LAS float* EGS = (LAS float*)(L + 89088);
    LAS bf16_t* OS = (LAS bf16_t*)(L + 89600);
    const bf16_t* QKVD = (const bf16_t*)(p.ws + WS_QKVD);
    const bf16_t* TPg = (const bf16_t*)(p.ws + WS_TP);
    const float* EGg = (const float*)(p.ws + WS_EG);
    bf16_t* OD = (bf16_t*)(p.ws + WS_OD) + (size_t)dir * TB * 1024;
    const size_t cid0 = ((size_t)((seq * 2 + dir) * 8 + h)) * NC;
    const int cp = tid >> 3, pc = tid & 7;
    u32x4 rq0, rq1, rk0, rk1, rv0, rv1, rt, rp; float reg_eg = 0.f;
#define SC_LOAD(np_) do { const int tok_ = dir ? (B.L - 1 - ((np_) * 64 + cp)) : ((np_) * 64 + cp); const bf16_t* src_ = QKVD + (size_t)(seq * B.L + tok_) * 3072 + h * 128 + 16 * pc; \
        rq0 = *(const u32x4*)src_; rq1 = *(const u32x4*)(src_ + 8); rk0 = *(const u32x4*)(src_ + 1024); rk1 = *(const u32x4*)(src_ + 1032); rv0 = *(const u32x4*)(src_ + 2048); rv1 = *(const u32x4*)(src_ + 2056); \
        const bf16_t* tp_ = TPg + (cid0 + (np_)) * 8192 + cp * 64 + 8 * pc; rt = *(const u32x4*)tp_; rp = *(const u32x4*)(tp_ + 4096); \
        if (tid < 128) reg_eg = EGg[(cid0 + (np_)) * 128 + tid]; } while (0)
    if (__builtin_amdgcn_readfirstlane(wid) < (8 >> lgVS)) {
    f32x4 S[8];
#pragma unroll
    for (int i = 0; i < 8; ++i) S[i] = (f32x4){0.f, 0.f, 0.f, 0.f};
    SC_LOAD(0);
    for (int np = 0; np < NC; ++np) {
        *(LAS u32x4*)(QS + cp * 136 + 16 * pc) = rq0; *(LAS u32x4*)(QS + cp * 136 + 16 * pc + 8) = rq1;
        *(LAS u32x4*)(KS + cp * 136 + 16 * pc) = rk0; *(LAS u32x4*)(KS + cp * 136 + 16 * pc + 8) = rk1;
        *(LAS u32x4*)(VS + cp * 136 + 16 * pc) = rv0; *(LAS u32x4*)(VS + cp * 136 + 16 * pc + 8) = rv1;
        *(LAS u32x4*)(TS + cp * 72 + 8 * pc) = rt; *(LAS u32x4*)(PS + cp * 72 + 8 * pc) = rp;
#pragma unroll
        for (int e = 0; e < 8; ++e) { const unsigned w0 = rk0[e >> 1], w1 = rk1[e >> 1];
            KT[(17 * pc + e) * 72 + cp] = (bf16_t)((e & 1) ? (w0 >> 16) : (w0 & 0xffffu));
            KT[(17 * pc + 8 + e) * 72 + cp] = (bf16_t)((e & 1) ? (w1 >> 16) : (w1 & 0xffffu)); }
        if (tid < 128) EGS[tid] = reg_eg;
        __syncthreads();
        if (np + 1 < NC) SC_LOAD(np + 1);
        if (np > 0 && (pc >> (3 - lgVS)) == vs) { const LAS bf16_t* os = OS + ((np - 1) & 1) * 8704 + cp * 136 + 16 * pc; const u32x4 o0 = *(const LAS u32x4*)os, o1 = *(const LAS u32x4*)(os + 8);
            const int c_ = (np - 1) * 64 + cp; const int tok_ = dir ? (B.L - 1 - c_) : c_; bf16_t* dst = OD + (size_t)(seq * B.L + tok_) * 1024 + h * 128 + 16 * pc;
            *(u32x4*)dst = o0; *(u32x4*)(dst + 8) = o1; }
        const int vcol = vs * (128 >> lgVS) + 16 * wid;
#define SCHED_FENCE() __builtin_amdgcn_sched_barrier(0)
        bf16x8 Sb[4];
#pragma unroll
        for (int ks = 0; ks < 4; ++ks) Sb[ks] = pack8(S[2 * ks], S[2 * ks + 1]);
        f32x4 X[4], Q[4];
#pragma unroll
        for (int ct = 0; ct < 4; ++ct) { X[ct] = (f32x4){0.f, 0.f, 0.f, 0.f}; Q[ct] = (f32x4){0.f, 0.f, 0.f, 0.f}; }
        bf16x8 fk[2][4], fq[2][4], ft[2][4];
#pragma unroll
        for (int ct = 0; ct < 4; ++ct) { fk[0][ct] = permfrag(KS, 16 * ct + fr, 136, 0, g); fq[0][ct] = permfrag(QS, 16 * ct + fr, 136, 0, g); }
        SCHED_FENCE();
#pragma unroll
        for (int ks = 0; ks < 4; ++ks) {
            if (ks < 3) {
#pragma unroll
                for (int ct = 0; ct < 4; ++ct) { fk[(ks + 1) & 1][ct] = permfrag(KS, 16 * ct + fr, 136, 32 * (ks + 1), g); fq[(ks + 1) & 1][ct] = permfrag(QS, 16 * ct + fr, 136, 32 * (ks + 1), g); }
            } else {
#pragma unroll
                for (int ct = 0; ct < 4; ++ct) { ft[0][ct] = permfrag(TS, 16 * ct + fr, 72, 0, g); ft[1][ct] = permfrag(TS, 16 * ct + fr, 72, 32, g); }
            }
            SCHED_FENCE();
#pragma unroll
            for (int ct = 0; ct < 4; ++ct) { X[ct] = MFMA16(fk[ks & 1][ct], Sb[ks], X[ct]); Q[ct] = MFMA16(fq[ks & 1][ct], Sb[ks], Q[ct]); }
            SCHED_FENCE();
        }
        f32x4 EGv[4], R[4];
#pragma unroll
        for (int ct = 0; ct < 4; ++ct) { EGv[ct] = *(const LAS f32x4*)(EGS + 16 * ct + 4 * g);
#pragma unroll
            for (int j = 0; j < 4; ++j) { const unsigned w = *(const LAS unsigned*)(VS + (16 * ct + 4 * g + j) * 136 + vcol + (fr & ~1)); R[ct][j] = (fr & 1) ? bfhi(w) : bflo(w); } }
        bf16x8 fp[2][4];
#pragma unroll
        for (int ct = 0; ct < 4; ++ct) { fp[0][ct] = permfrag(PS, 16 * ct + fr, 72, 0, g); fp[1][ct] = permfrag(PS, 16 * ct + fr, 72, 32, g); }
        SCHED_FENCE();
#pragma unroll
        for (int ct = 0; ct < 4; ++ct) R[ct] = R[ct] - EGv[ct] * X[ct];
        bf16x8 Rb[2]; Rb[0] = pack8(R[0], R[1]); Rb[1] = pack8(R[2], R[3]);
        f32x4 Vn[4];
#pragma unroll
        for (int ct = 0; ct < 4; ++ct) Vn[ct] = (f32x4){0.f, 0.f, 0.f, 0.f};
#pragma unroll
        for (int k2 = 0; k2 < 2; ++k2)
#pragma unroll
            for (int ct = 0; ct < 4; ++ct) Vn[ct] = MFMA16(ft[k2][ct], Rb[k2], Vn[ct]);
        bf16x8 fkt[2][8];
#pragma unroll
        for (int i = 0; i < 8; ++i) fkt[0][i] = permfrag(KT, 17 * i + fr, 72, 0, g);
        SCHED_FENCE();
        bf16x8 Vb[2]; Vb[0] = pack8(Vn[0], Vn[1]); Vb[1] = pack8(Vn[2], Vn[3]);
        f32x4 O[4];
#pragma unroll
        for (int ct = 0; ct < 4; ++ct) O[ct] = EGv[ct] * Q[ct];
#pragma unroll
        for (int k2 = 0; k2 < 2; ++k2)
#pragma unroll
            for (int ct = 0; ct < 4; ++ct) O[ct] = MFMA16(fp[k2][ct], Vb[k2], O[ct]);
#pragma unroll
        for (int i = 0; i < 8; ++i) fkt[1][i] = permfrag(KT, 17 * i + fr, 72, 32, g);
        SCHED_FENCE();
#pragma unroll
        for (int ct = 0; ct < 4; ++ct) { const f32x4 egd = *(const LAS f32x4*)(EGS + 64 + 16 * ct + 4 * g); Vn[ct] = Vn[ct] * egd; }
        Vb[0] = pack8(Vn[0], Vn[1]); Vb[1] = pack8(Vn[2], Vn[3]);
        const float egl = EGS[63];
#pragma unroll
        for (int i = 0; i < 8; ++i) S[i] = S[i] * egl;
#pragma unroll
        for (int k2 = 0; k2 < 2; ++k2)
#pragma unroll
            for (int i = 0; i < 8; ++i) S[i] = MFMA16(fkt[k2][i], Vb[k2], S[i]);
#pragma unroll
        for (int ct = 0; ct < 4; ++ct)
#pragma unroll
            for (int j = 0; j < 4; ++j) OS[(np & 1) * 8704 + (16 * ct + 4 * g + j) * 136 + vcol + fr] = f2bf(O[ct][j]);
#undef SCHED_FENCE
        __syncthreads();
    }
    } else {
    SC_LOAD(0);
    for (int np = 0; np < NC; ++np) {
        *(LAS u32x4*)(QS + cp * 136 + 16 * pc) = rq0; *(LAS u32x4*)(QS + cp * 136 + 16 * pc + 8) = rq1;
        *(LAS u32x4*)(KS + cp * 136 + 16 * pc) = rk0; *(LAS u32x4*)(KS + cp * 136 + 16 * pc + 8) = rk1;
        *(LAS u32x4*)(VS + cp * 136 + 16 * pc) = rv0; *(LAS u32x4*)(VS + cp * 136 + 16 * pc + 8) = rv1;
        *(LAS u32x4*)(TS + cp * 72 + 8 * pc) = rt; *(LAS u32x4*)(PS + cp * 72 + 8 * pc) = rp;
#pragma unroll
        for (int e = 0; e < 8; ++e) { const unsigned w0 = rk0[e >> 1], w1 = rk1[e >> 1];
            KT[(17 * pc + e) * 72 + cp] = (bf16_t)((e & 1) ? (w0 >> 16) : (w0 & 0xffffu));
            KT[(17 * pc + 8 + e) * 72 + cp] = (bf16_t)((e & 1) ? (w1 >> 16) : (w1 & 0xffffu)); }
        if (tid < 128) EGS[tid] = reg_eg;
        __syncthreads();
        if (np + 1 < NC) SC_LOAD(np + 1);
        if (np > 0 && (pc >> (3 - lgVS)) == vs) { const LAS bf16_t* os = OS + ((np - 1) & 1) * 8704 + cp * 136 + 16 * pc; const u32x4 o0 = *(const LAS u32x4*)os, o1 = *(const LAS u32x4*)(os + 8);
            const int c_ = (np - 1) * 64 + cp; const int tok_ = dir ? (B.L - 1 - c_) : c_; bf16_t* dst = OD + (size_t)(seq * B.L + tok_) * 1024 + h * 128 + 16 * pc;
            *(u32x4*)dst = o0; *(u32x4*)(dst + 8) = o1; }
        __syncthreads();
    }
    }
    if ((pc >> (3 - lgVS)) == vs) { const LAS bf16_t* os = OS + ((NC - 1) & 1) * 8704 + cp * 136 + 16 * pc; const u32x4 o0 = *(const LAS u32x4*)os, o1 = *(const LAS u32x4*)(os + 8);
      const int c_ = (NC - 1) * 64 + cp; const int tok_ = dir ? (B.L - 1 - c_) : c_; bf16_t* dst = OD + (size_t)(seq * B.L + tok_) * 1024 + h * 128 + 16 * pc;
      *(u32x4*)dst = o0; *(u32x4*)(dst + 8) = o1; }
    __syncthreads();
#undef SC_LOAD
}

__device__ __forceinline__ void attn_item(const Params& p, const Batch& B, int item, LAS unsigned char* L) {
    const int tid = ltid(), lane = tid & 63, wid = tid >> 6, g = lane >> 4, fr = lane & 15;
    const int lgper = B.lgL - 7;
    const int x = item & ((1 << lgper) - 1), sgh = item >> lgper, h = sgh & 7, sg = sgh >> 3, grp = sg % 3, seq = sg / 3;
    const int lgd = 2 * grp, r = x & ((1 << lgd) - 1), pb = x >> lgd, Lr = B.L >> lgd;
    const int mq0 = pb * 128, mk0 = mq0 - 64, hcol = (grp * 8 + h) * 64;
    LAS bf16_t* KL = (LAS bf16_t*)L;
    LAS bf16_t* VT = (LAS bf16_t*)(L + 36864);
    bf16_t* PROJ = (bf16_t*)(p.ws + WS_PROJ);
    const f32x2* ROPE = (const f32x2*)(p.ws + WS_ROPE);
    const size_t rowbase = (size_t)seq * B.L;
    const u32x4 z4 = {0u, 0u, 0u, 0u};
    const int mq = mq0 + 16 * wid + fr, sq = (mq << lgd) + r;
    bf16_t* qptr = PROJ + (rowbase + sq) * NPROJ + C_QA + hcol;
    const u32x4 qa = *(const u32x4*)(qptr + 8 * g), qb = *(const u32x4*)(qptr + 32 + 8 * g);
    f32x4 qcs[4];
    { const f32x4* rp = (const f32x4*)(ROPE + (size_t)sq * 32 + 8 * g);
#pragma unroll
      for (int q = 0; q < 4; ++q) qcs[q] = rp[q]; }
    u32x4 ka[2], kb[2]; f32x4 kcs[2][4]; u32x4 va[4];
#pragma unroll
    for (int i = 0; i < 2; ++i) { const int t = tid + 512 * i, kk = t >> 2, pp = t & 3, m = mk0 + kk; ka[i] = z4; kb[i] = z4;
#pragma unroll
        for (int q = 0; q < 4; ++q) kcs[i][q] = (f32x4){0.f, 0.f, 0.f, 0.f};
        if (m >= 0 && m < Lr) { const int s = (m << lgd) + r; const bf16_t* src = PROJ + (rowbase + s) * NPROJ + C_KA + hcol + 8 * pp;
            ka[i] = *(const u32x4*)src; kb[i] = *(const u32x4*)(src + 32); const f32x4* rp = (const f32x4*)(ROPE + (size_t)s * 32 + 8 * pp);
#pragma unroll
            for (int q = 0; q < 4; ++q) kcs[i][q] = rp[q]; } }
#pragma unroll
    for (int i = 0; i < 4; ++i) { const int kk = tid & 255, p8 = (tid >> 8) + 2 * i, m = mk0 + kk; va[i] = z4;
        if (m >= 0 && m < Lr) { const int s = (m << lgd) + r; va[i] = *(const u32x4*)(PROJ + (rowbase + s) * NPROJ + C_VA + hcol + 8 * p8); } }
#pragma unroll
    for (int i = 0; i < 2; ++i) { const int t = tid + 512 * i, kk = t >> 2, pp = t & 3; u32x4 lo, hi;
#pragma unroll
        for (int q = 0; q < 4; ++q) { const f32x4 cs = kcs[i][q]; const float x1a = bflo(ka[i][q]), x1b = bfhi(ka[i][q]), x2a = bflo(kb[i][q]), x2b = bfhi(kb[i][q]);
            lo[q] = pk2(x1a * cs[0] - x2a * cs[1], x1b * cs[2] - x2b * cs[3]); hi[q] = pk2(x2a * cs[0] + x1a * cs[1], x2b * cs[2] + x1b * cs[3]); }
        *(LAS u32x4*)(KL + kk * 72 + 8 * pp) = lo; *(LAS u32x4*)(KL + kk * 72 + 32 + 8 * pp) = hi; }
#pragma unroll
    for (int i = 0; i < 4; ++i) { const int kk = tid & 255, p8 = (tid >> 8) + 2 * i;
#pragma unroll
        for (int e = 0; e < 8; ++e) { const unsigned w = va[i][e >> 1]; VT[(8 * p8 + e) * 264 + kk] = (bf16_t)((e & 1) ? (w >> 16) : (w & 0xffffu)); } }
    __syncthreads();
    {
        u32x4 lo, hi;
#pragma unroll
        for (int q = 0; q < 4; ++q) { const f32x4 cs = qcs[q] * 0.125f; const float x1a = bflo(qa[q]), x1b = bfhi(qa[q]), x2a = bflo(qb[q]), x2b = bfhi(qb[q]);
            lo[q] = pk2(x1a * cs[0] - x2a * cs[1], x1b * cs[2] - x2b * cs[3]); hi[q] = pk2(x2a * cs[0] + x1a * cs[1], x2b * cs[2] + x1b * cs[3]); }
        bf16x8 qf[2]; qf[0] = __builtin_bit_cast(bf16x8, lo); qf[1] = __builtin_bit_cast(bf16x8, hi);
        f32x4 st[9]; float mx = -3.0e38f;
#pragma unroll
        for (int t = 0; t < 9; ++t) { f32x4 acc = {0.f, 0.f, 0.f, 0.f};
#pragma unroll
            for (int ks = 0; ks < 2; ++ks) acc = MFMA16(*(const LAS bf16x8*)(KL + (16 * (wid + t) + fr) * 72 + 32 * ks + 8 * g), qf[ks], acc);
#pragma unroll
            for (int j = 0; j < 4; ++j) { const int m = mk0 + 16 * (wid + t) + 4 * g + j; const int dq = mq - m; const bool ok = (dq <= 64) && (dq >= -64) && (m >= 0) && (m < Lr);
                acc[j] = ok ? acc[j] : -1.0e30f; mx = fmaxf(mx, acc[j]); }
            st[t] = acc; }
        mx = fmaxf(mx, __shfl_xor(mx, 16)); mx = fmaxf(mx, __shfl_xor(mx, 32));
        float den = 0.f;
#pragma unroll
        for (int t = 0; t < 9; ++t)
#pragma unroll
            for (int j = 0; j < 4; ++j) { const float e = __expf(st[t][j] - mx); st[t][j] = e; den += e; }
        den += __shfl_xor(den, 16); den += __shfl_xor(den, 32);
        bf16x8 pbf[5];
#pragma unroll
        for (int ks = 0; ks < 4; ++ks) pbf[ks] = pack8(st[2 * ks], st[2 * ks + 1]);
        pbf[4] = pack8(st[8], (f32x4){0.f, 0.f, 0.f, 0.f});
        const float rden = 1.0f / den;
#pragma unroll
        for (int dt = 0; dt < 4; ++dt) { f32x4 o = {0.f, 0.f, 0.f, 0.f};
#pragma unroll
            for (int ks = 0; ks < 5; ++ks) { const LAS bf16_t* vp = VT + (16 * dt + fr) * 264 + 16 * (wid + 2 * ks) + 4 * g;
                const u32x2 vl = *(const LAS u32x2*)vp; u32x2 vh = {0u, 0u}; if (ks < 4) vh = *(const LAS u32x2*)(vp + 16);
                u32x4 w; w.x = vl.x; w.y = vl.y; w.z = vh.x; w.w = vh.y; o = MFMA16(__builtin_bit_cast(bf16x8, w), pbf[ks], o); }
            u32x2 ow; ow.x = pk2(o[0] * rden, o[1] * rden); ow.y = pk2(o[2] * rden, o[3] * rden);
            *(u32x2*)((bf16_t*)B.out + (rowbase + sq) * 1536 + hcol + 16 * dt + 4 * g) = ow; }
        if (g == 0) ((float*)(p.ws + WS_LSE))[(rowbase + sq) * 24 + grp * 8 + h] = mx + __logf(den);
    }
    __syncthreads();
}

__device__ __forceinline__ void post_mixer(const Params& p, const Batch& B) {
    const int lane = ltid() & 63, gw = blockIdx.x * 8 + (ltid() >> 6), NGW = gridDim.x * 8;
    const bf16_t* PROJ = (const bf16_t*)(p.ws + WS_PROJ); const float* LSE = (const float*)(p.ws + WS_LSE);
    const bf16_t* OD0 = (const bf16_t*)(p.ws + WS_OD); const bf16_t* OD1 = OD0 + (size_t)TB * 1024;
    bf16_t* YAD = (bf16_t*)(p.ws + WS_QKVD);
    float dg[16];
#pragma unroll
    for (int e = 0; e < 16; ++e) dg[e] = p.dn_norm_g[(16 * lane + e) & 127];
    const int hh = lane >> 3;
    for (int r0 = gw; r0 < TB; r0 += 2 * NGW) {
        float l0[2], l1[2], l2[2]; u32x4 a[2], b[2], c[2], a0[2], a1[2], b0[2], b1[2], z0[2], z1[2];
#pragma unroll
        for (int u = 0; u < 2; ++u) { const int r = r0 + u * NGW;
            l0[u] = LSE[(size_t)r * 24 + hh]; l1[u] = LSE[(size_t)r * 24 + 8 + hh]; l2[u] = LSE[(size_t)r * 24 + 16 + hh];
            const bf16_t* src = (const bf16_t*)B.out + (size_t)r * 1536 + 8 * lane;
            a[u] = *(const u32x4*)src; b[u] = *(const u32x4*)(src + 512); c[u] = *(const u32x4*)(src + 1024);
            const bf16_t* s0 = OD0 + (size_t)r * 1024 + 16 * lane; const bf16_t* s1 = OD1 + (size_t)r * 1024 + 16 * lane; const bf16_t* zp = PROJ + (size_t)r * NPROJ + C_ZD + 16 * lane;
            a0[u] = *(const u32x4*)s0; a1[u] = *(const u32x4*)(s0 + 8); b0[u] = *(const u32x4*)s1; b1[u] = *(const u32x4*)(s1 + 8); z0[u] = *(const u32x4*)zp; z1[u] = *(const u32x4*)(zp + 8); }
#pragma unroll
        for (int u = 0; u < 2; ++u) { const int r = r0 + u * NGW;
            { const float mx = fmaxf(l0[u], fmaxf(l1[u], l2[u])); float w0 = __expf(l0[u] - mx), w1 = __expf(l1[u] - mx), w2 = __expf(l2[u] - mx); const float inv = 1.0f / (w0 + w1 + w2); w0 *= inv; w1 *= inv; w2 *= inv;
              u32x4 o;
#pragma unroll
              for (int q = 0; q < 4; ++q) o[q] = pk2(w0 * bflo(a[u][q]) + w1 * bflo(b[u][q]) + w2 * bflo(c[u][q]), w0 * bfhi(a[u][q]) + w1 * bfhi(b[u][q]) + w2 * bfhi(c[u][q]));
              *(u32x4*)(YAD + (size_t)r * 1536 + 8 * lane) = o; }
            { float v[16]; float ss = 0.f;
#pragma unroll
              for (int e = 0; e < 16; ++e) { v[e] = bf_el(a0[u], a1[u], e) + bf_el(b0[u], b1[u], e); ss += v[e] * v[e]; }
              ss += __shfl_xor(ss, 1); ss += __shfl_xor(ss, 2); ss += __shfl_xor(ss, 4);
              const float rs = rsqrtf(ss * (1.0f / 128.0f) + EPSF);
#pragma unroll
              for (int e = 0; e < 16; ++e) v[e] = v[e] * rs * dg[e] * siluf_(bf_el(z0[u], z1[u], e));
              u32x4 o0, o1; o0.x = pk2(v[0], v[1]); o0.y = pk2(v[2], v[3]); o0.z = pk2(v[4], v[5]); o0.w = pk2(v[6], v[7]);
              o1.x = pk2(v[8], v[9]); o1.y = pk2(v[10], v[11]); o1.z = pk2(v[12], v[13]); o1.w = pk2(v[14], v[15]);
              *(u32x4*)(YAD + (size_t)r * 1536 + 512 + 16 * lane) = o0; *(u32x4*)(YAD + (size_t)r * 1536 + 512 + 16 * lane + 8) = o1; }
        }
    }
}

__device__ __forceinline__ void conv_act(const Params& p, const Batch& B) {
    const bf16_t* UP = (const bf16_t*)(p.ws + WS_PROJ); bf16_t* ACT = (bf16_t*)(p.ws + WS_PROJ + (size_t)TB * NUP * 2);
    const u32x4 z4 = {0u, 0u, 0u, 0u};
    constexpr int RB = 16;
    for (int t = blockIdx.x * 512 + ltid(); t < (TB / RB) * 352; t += gridDim.x * 512) {
        const int rb = t / 352, cg8 = (t - rb * 352) * 8, row0 = rb * RB; const int s0 = row0 & (B.L - 1);
        f32x4 wv[3][2], wg[3][2], bv[2], bg[2];
#pragma unroll
        for (int q = 0; q < 2; ++q) {
#pragma unroll
            for (int j = 0; j < 3; ++j) { wv[j][q] = *(const f32x4*)(p.ffn_conv_w + j * NUP + cg8 + 4 * q); wg[j][q] = *(const f32x4*)(p.ffn_conv_w + j * NUP + DFF + cg8 + 4 * q); }
            bv[q] = *(const f32x4*)(p.ffn_conv_b + cg8 + 4 * q); bg[q] = *(const f32x4*)(p.ffn_conv_b + DFF + cg8 + 4 * q); }
        const bf16_t* src = UP + (size_t)row0 * NUP + cg8;
        u32x4 vp = z4, gp = z4, vc, gc, vn, gn;
        if (s0 > 0) { vp = *(const u32x4*)(src - NUP); gp = *(const u32x4*)(src - NUP + DFF); }
        vc = *(const u32x4*)src; gc = *(const u32x4*)(src + DFF);
#pragma unroll
        for (int i = 0; i < RB; ++i) {
            vn = z4; gn = z4;
            if (i < RB - 1 || s0 + RB < B.L) { vn = *(const u32x4*)(src + (size_t)(i + 1) * NUP); gn = *(const u32x4*)(src + (size_t)(i + 1) * NUP + DFF); }
            float o[8];
#pragma unroll
            for (int e = 0; e < 8; ++e) { const int q = e >> 2, k = e & 3;
                const float val = bf_el(vp, z4, e) * wv[0][q][k] + bf_el(vc, z4, e) * wv[1][q][k] + bf_el(vn, z4, e) * wv[2][q][k] + bv[q][k];
                const float gt = bf_el(gp, z4, e) * wg[0][q][k] + bf_el(gc, z4, e) * wg[1][q][k] + bf_el(gn, z4, e) * wg[2][q][k] + bg[q][k];
                o[e] = siluf_(gt) * val; }
            u32x4 w; w.x = pk2(o[0], o[1]); w.y = pk2(o[2], o[3]); w.z = pk2(o[4], o[5]); w.w = pk2(o[6], o[7]);
            *(u32x4*)(ACT + (size_t)(row0 + i) * DFF + cg8) = w;
            vp = vc; gp = gc; vc = vn; gc = gn;
        }
    }
}

#ifndef EN_P0
#define EN_P0 1
#endif
#ifndef EN_PREP
#define EN_PREP 1
#endif
#ifndef EN_SCAN
#define EN_SCAN 1
#endif
#ifndef EN_ATT
#define EN_ATT 1
#endif
#ifndef EN_POST
#define EN_POST 1
#endif
#ifndef EN_CONV
#define EN_CONV 1
#endif
#ifndef EN_G1
#define EN_G1 1
#endif
#ifndef EN_G2
#define EN_G2 1
#endif
#ifndef EN_G3
#define EN_G3 1
#endif
#ifndef EN_G4
#define EN_G4 1
#endif
#ifndef EN_G5
#define EN_G5 1
#endif
#ifndef PROBE_POS
#define PROBE_POS -100
#endif
#ifndef REP_ATT
#define REP_ATT 1
#endif
#ifndef REP_P0
#define REP_P0 1
#endif
#ifndef REP_P3
#define REP_P3 1
#endif
#ifndef REP_SCAN
#define REP_SCAN 1
#endif
#ifndef REP_P5
#define REP_P5 1
#endif
#ifndef REP_P11
#define REP_P11 1
#endif
#ifndef REP_G1
#define REP_G1 1
#endif
#ifndef REP_G4
#define REP_G4 1
#endif
#ifndef REP_P9
#define REP_P9 1
#endif
#ifndef REP_SYNC
#define REP_SYNC 1
#endif
#define XB_TMO      128
#define XB_XCNT(j)  (256  + 64 * (j))
#define XB_XSUB(j)  (1280 + 64 * (j))
#define XB_XGEN(j)  (2304 + 64 * (j))
#define XB_TOP      3328
#define XB_TOPGEN   3392
#define XCD_BAR_WORDS 3456
#define XB_SPIN_CAP (1u << 18)

__device__ __forceinline__ unsigned xb_ld(unsigned* p)              { return __hip_atomic_load(p, __ATOMIC_RELAXED, __HIP_MEMORY_SCOPE_AGENT); }
__device__ __forceinline__ unsigned xb_add(unsigned* p, unsigned v) { return __hip_atomic_fetch_add(p, v, __ATOMIC_RELAXED, __HIP_MEMORY_SCOPE_AGENT); }
__device__ __forceinline__ unsigned xb_xcc_id() { return (unsigned)__builtin_amdgcn_s_getreg((3 << 11) | 20) & 0xFu; }
#define XB_SPIN(cond, bar) do { unsigned _sp = 0; while (cond) { __builtin_amdgcn_s_sleep(1); \
    if ((++_sp & 255u) == 0u) { if (xb_ld(&(bar)[XB_TMO])) break; if (_sp > XB_SPIN_CAP) { atomicAdd(&(bar)[XB_TMO], 1u); break; } } } } while (0)

struct XcdBarrier {
    unsigned* bar; unsigned x;
    volatile LAS unsigned* st;
};

__device__ __forceinline__ XcdBarrier xcd_barrier_post(unsigned* bar, volatile LAS unsigned* st) {
    XcdBarrier b; b.bar = bar; b.x = xb_xcc_id(); b.st = st;
    if (threadIdx.x == 0) (void)xb_add(&bar[XB_XCNT(b.x)], 1u);
    return b;
}
__device__ __forceinline__ void xcd_barrier_complete(unsigned* bar, unsigned x, unsigned& nloc, unsigned& nx) {
    const unsigned G = gridDim.x * gridDim.y * gridDim.z;
    unsigned sum, cnt, mine, sp = 0u;
    for (;;) {
        sum = 0u; cnt = 0u; mine = 0u;
#pragma unroll
        for (unsigned j = 0; j < 16; ++j) { const unsigned c = xb_ld(&bar[XB_XCNT(j)]); sum += c; cnt += (c > 0u) ? 1u : 0u; mine = (j == x) ? c : mine; }
        if (sum == G) break;
        __builtin_amdgcn_s_sleep(1);
        if ((++sp & 255u) == 0u) { if (xb_ld(&bar[XB_TMO])) break; if (sp > XB_SPIN_CAP) { atomicAdd(&bar[XB_TMO], 1u); break; } }
    }
    nloc = mine > 0u ? mine : 1u; nx = cnt > 0u ? cnt : 1u;
}

__device__ __forceinline__ void xcd_barrier(const XcdBarrier& b) {
    asm volatile("s_waitcnt vmcnt(0)" ::: "memory");
    __syncthreads();
    if (threadIdx.x == 0) {
        unsigned* bar = b.bar;
        __builtin_amdgcn_s_waitcnt(0);
        unsigned nloc = b.st[0], nx = b.st[1];
        if (nloc == 0u) { xcd_barrier_complete(bar, b.x, nloc, nx); b.st[0] = nloc; b.st[1] = nx; }
        const unsigned old = xb_add(&bar[XB_XSUB(b.x)], 1u);
        const unsigned gen = old / nloc;
        if (old + 1u == (gen + 1u) * nloc) {
            __builtin_amdgcn_fence(__ATOMIC_RELEASE, "agent");
            asm volatile("s_waitcnt vmcnt(0)" ::: "memory");
            const unsigned og = xb_add(&bar[XB_TOP], 1u);
            const unsigned tg = og / nx;
            if (og + 1u == (tg + 1u) * nx) xb_add(&bar[XB_TOPGEN], 1u);
            else XB_SPIN(xb_ld(&bar[XB_TOPGEN]) == tg, bar);
            __builtin_amdgcn_fence(__ATOMIC_ACQUIRE, "agent");
            xb_add(&bar[XB_XGEN(b.x)], 1u);
            asm volatile("s_waitcnt vmcnt(0)" ::: "memory");
        } else {
            XB_SPIN(xb_ld(&bar[XB_XGEN(b.x)]) == gen, bar);
            __builtin_amdgcn_fence(__ATOMIC_ACQUIRE, "agent");
            asm volatile("s_waitcnt vmcnt(0)" ::: "memory");
        }
    }
    __syncthreads();
}


__device__ __forceinline__ void grid_bar(unsigned* ctr, unsigned target) {
    asm volatile("s_waitcnt vmcnt(0) lgkmcnt(0)" ::: "memory");
    __syncthreads();
    if (threadIdx.x == 0) {
        __builtin_amdgcn_fence(__ATOMIC_RELEASE, "agent");
        asm volatile("s_waitcnt vmcnt(0)" ::: "memory");
        __hip_atomic_fetch_add(ctr, 1u, __ATOMIC_RELAXED, __HIP_MEMORY_SCOPE_AGENT);
        while (__hip_atomic_load(ctr, __ATOMIC_RELAXED, __HIP_MEMORY_SCOPE_AGENT) < target) __builtin_amdgcn_s_sleep(2);
        __builtin_amdgcn_fence(__ATOMIC_ACQUIRE, "agent");
        asm volatile("s_waitcnt vmcnt(0)" ::: "memory");
    }
    __syncthreads();
}
__global__ void __launch_bounds__(512) mega(Params p) {
    extern __shared__ __attribute__((aligned(16))) unsigned char lds_raw[];
    LAS unsigned char* L = (LAS unsigned char*)lds_raw;
    const int G = gridDim.x, bid = blockIdx.x, tid = ltid();
    int ph = 0;
#define PHASE_ON (ph >= p.ph_lo && ph < p.ph_hi)
#define SEAM() do { if (ph >= p.ph_lo && ph + 1 < p.ph_hi) { for (int rep_ = 0; rep_ < REP_SYNC; ++rep_) { xcd_barrier(xbar); } } PROBE_TICK(); ++ph; } while (0)
    unsigned nbar = 0;
#if PROBE_POS > -10
    unsigned long long t_prev = __builtin_amdgcn_s_memrealtime(), t_acc = 0;
#define PROBE_TICK() do { const unsigned long long t_now = __builtin_amdgcn_s_memrealtime(); const int pos_ = ph < 2 ? -1 - ph : (ph - 2) % 11; if (pos_ == PROBE_POS) t_acc += t_now - t_prev; t_prev = t_now; } while (0)
#else
#define PROBE_TICK() do {} while (0)
#endif
    unsigned* ctl = (unsigned*)(p.ws + WS_CTL);
    volatile LAS unsigned* xst = (volatile LAS unsigned*)(L + LDS_BYTES - 32);
    if (tid == 0) { xst[0] = 0u; xst[1] = 0u; }
    __syncthreads();
    XcdBarrier xbar = xcd_barrier_post(ctl + 1024, xst);
    float* MOD = (float*)(p.ws + WS_MOD);
    bf16_t* XN = (bf16_t*)(p.ws + WS_XN); bf16_t* PROJ = (bf16_t*)(p.ws + WS_PROJ);
    if (EN_P0 && PHASE_ON) for (int rep = 0; rep < REP_P0; ++rep) phase0(p, L);
    SEAM();
    if (PHASE_ON) { const Batch B0 = make_batch(p, 0); norm_mod_rows(p, B0, B0.x, p.norm1_g, 0, 1024, XN); }
    SEAM();
    for (int b = 0; b < 3; ++b) {
        const Batch B = make_batch(p, b);
        const int cbase = b == 0 ? 0 : 8 + (b - 1) * 4;
        if (EN_G1 && PHASE_ON) for (int rep = 0; rep < REP_G1; ++rep) { pg8::Gemm g{XN, (const bf16_t*)(p.ws + WS_WIN), TB, NPROJ, 1024}; pg8::StaticOrder S; S.init(TB, NPROJ, G, bid); EpiBf16S E{PROJ, NPROJ}; pg8::gemm_phase<EpiBf16S, pg8::StaticOrder>(L, g, S, E); }
        SEAM();
        if (EN_PREP && PHASE_ON) for (int rep = 0; rep < REP_P3; ++rep) { const int nit = (TB >> 6) * 4; for (int it = bid; it < nit; it += G) prep_item(p, B, it, L); }
        SEAM();
        if (PHASE_ON) {
            const int lgVS = b == 0 ? 0 : 1; const int nscan = (B.nseq * 16) << lgVS, natt = B.nseq * 24 * (B.L >> 7);
            LAS int* slot = (LAS int*)(L + LDS_BYTES - 16);
            for (;;) {
                if (tid == 0) *slot = (int)atomicAdd(ctl + 64 * b, 1u);
                __syncthreads();
                const int idx = *slot;
                __syncthreads();
                if (idx >= nscan + natt) break;
                if (idx < nscan) { if (EN_SCAN) for (int rep = 0; rep < REP_SCAN; ++rep) scan_chain(p, B, idx >> lgVS, idx & ((1 << lgVS) - 1), lgVS, L); } else { if (EN_ATT) for (int rep = 0; rep < REP_ATT; ++rep) attn_item(p, B, idx - nscan, L); }
            }
        }
        SEAM();
        if (EN_POST && PHASE_ON) for (int rep = 0; rep < REP_P5; ++rep) post_mixer(p, B);
        SEAM();
        if (EN_G2 && PHASE_ON) {
            bf16_t* MERGED = (bf16_t*)(p.ws + WS_QKVD + (size_t)TB * 1536 * 2);
            pg8::Gemm g{(const bf16_t*)(p.ws + WS_QKVD), (const bf16_t*)(p.ws + WS_WA), TB, 1024, 1536}; pg8::StaticOrder S; S.init(TB, 1024, G, bid); EpiMerge E{PROJ + C_GA, PROJ + C_GD, NPROJ, MERGED}; pg8::gemm_phase<EpiMerge, pg8::StaticOrder>(L, g, S, E);
        }
        SEAM();
        if (EN_G3 && PHASE_ON) { const bf16_t* MERGED = (const bf16_t*)(p.ws + WS_QKVD + (size_t)TB * 1536 * 2);
            pg8::Gemm g{MERGED, (const bf16_t*)(p.ws + WS_WO), TB, 1024, 1024}; pg8::StaticOrder S; S.init(TB, 1024, G, bid); EpiResid E{B.x, B.out, MOD + 2048, B.lgL, cbase}; pg8::gemm_phase<EpiResid, pg8::StaticOrder>(L, g, S, E); }
        SEAM();
        if (PHASE_ON) for (int rep = 0; rep < REP_P9; ++rep) norm_mod_rows(p, B, B.out, p.norm2_g, 3072, 4096, XN);
        SEAM();
        if (EN_G4 && PHASE_ON) {
            pg8::StaticOrder S; S.init(65 * 256, NUP, G, bid);
            for (int i = 0; ; ++i) { pg8::Unit u; if (!S.next(i, u)) break;
                const int rowstart = 254 * u.pm - 1;
                pg8::Gemm g{XN + (ptrdiff_t)rowstart * 1024, (const bf16_t*)(p.ws + WS_WUP), 256, NUP, 1024};
                OneUnit S1{pg8::Unit{0, u.pn}};
                EpiConvFfn E{(bf16_t*)(p.ws + WS_PROJ + (size_t)TB * NUP * 2), p.ffn_conv_w, p.ffn_conv_b, rowstart, B.L};
                pg8::gemm_phase<EpiConvFfn, OneUnit>(L, g, S1, E); }
        }
        SEAM();
        if (EN_G5 && PHASE_ON) { pg8::Gemm g{(const bf16_t*)(p.ws + WS_PROJ + (size_t)TB * NUP * 2), (const bf16_t*)(p.ws + WS_WDN), TB, 1024, DFF}; pg8::StaticOrder S; S.init(TB, 1024, G, bid);
            EpiResid E{B.out, B.out, MOD + 5120, B.lgL, cbase}; pg8::gemm_phase<EpiResid, pg8::StaticOrder>(L, g, S, E); }
        SEAM();
        if (PHASE_ON) { final_norm_rows(B.out, p.norm_f_g); if (b < 2) { const Batch Bn = make_batch(p, b + 1); norm_mod_rows(p, Bn, Bn.x, p.norm1_g, 0, 1024, XN); } }
        SEAM();
    }
#if PROBE_POS > -10
    if (bid == 0 && tid == 0) { const unsigned long long t0 = __builtin_amdgcn_s_memrealtime(); while (__builtin_amdgcn_s_memrealtime() - t0 < 4ull * t_acc) __builtin_amdgcn_s_sleep(8); }
#endif
}
constexpr int N_PHASES = 2 + 3 * 10;

#ifndef MULTI_LAUNCH
#define MULTI_LAUNCH 0
#endif
extern "C" void kernel_launch(void* const* d_in, const int* in_sizes, int n_in, void* d_out, int out_size, void* d_ws, size_t ws_size, hipStream_t stream) {
    static int grid = 0;
    if (grid == 0) {
        if (n_in != 21 || ws_size < WS_END) { fprintf(stderr, "kernel_launch: need 21 inputs and %zu bytes of workspace (got %d, %zu)\n", (size_t)WS_END, n_in, ws_size); grid = -1; return; }
        int dev = 0, cus = 0, per_cu = 0;
        hipGetDevice(&dev); hipDeviceGetAttribute(&cus, hipDeviceAttributeMultiprocessorCount, dev);
        if (hipFuncSetAttribute((const void*)mega, hipFuncAttributeMaxDynamicSharedMemorySize, LDS_BYTES) != hipSuccess) { fprintf(stderr, "kernel_launch: hipFuncSetAttribute failed\n"); grid = -1; return; }
        if (hipOccupancyMaxActiveBlocksPerMultiprocessor(&per_cu, (const void*)mega, 512, LDS_BYTES) != hipSuccess || per_cu < 1) { fprintf(stderr, "kernel_launch: occupancy query says %d blocks/CU\n", per_cu); grid = -1; return; }
        grid = cus;
    }
    if (grid < 0) return;
    hipMemsetAsync((char*)d_ws + WS_CTL, 0, 20480, stream);
    Params p{};
    const float** pp = (const float**)&p;
    for (int i = 0; i < 21; ++i) pp[i] = (const float*)d_in[i];
    p.out = (float*)d_out; p.ws = (unsigned char*)d_ws;
#if MULTI_LAUNCH
    for (int ph = 0; ph < N_PHASES; ++ph) { p.ph_lo = ph; p.ph_hi = ph + 1; hipLaunchKernelGGL(mega, dim3(grid), dim3(512), LDS_BYTES, stream, p); }
#else
    p.ph_lo = 0; p.ph_hi = N_PHASES;
    void* args[] = {&p};
    hipError_t e = hipLaunchCooperativeKernel((const void*)mega, dim3(grid), dim3(512), args, LDS_BYTES, stream);
    if (e != hipSuccess) fprintf(stderr, "cooperative launch failed: %s (grid %d)\n", hipGetErrorString(e), grid);
#endif
}
```

```cpp
#include <hip/hip_runtime.h>
#include <cstdio>
namespace pg8 {
#define PG8_LAS __attribute__((address_space(3)))
typedef unsigned short bf16_t;
typedef short bf16x8 __attribute__((ext_vector_type(8)));
typedef float f32x4 __attribute__((ext_vector_type(4)));
typedef unsigned u32x4 __attribute__((ext_vector_type(4)));
constexpr int BM = 256, BK = 64, HALF = 128, HTB = HALF * BK * 2  , STAGE_BYTES = 8 * HTB, NXCD = 8, WGM = 8;

__host__ __device__ __forceinline__ int lds_byte(int r, int c) { const int st = (r >> 4) * 2 + (c >> 5), rr = r & 15, cc = c & 31, ob = rr * 64 + cc * 2; return st * 1024 + (ob ^ (((ob >> 9) & 1) << 5)); }
__host__ __device__ __forceinline__ void stage_rc(int b, int& R, int& C) { const int st = b / 1024, sb = b % 1024, swz = sb ^ (((sb >> 9) & 1) << 5); R = (st >> 1) * 16 + swz / 64; C = (st & 1) * 32 + (swz % 64) / 2; }
__host__ __device__ __forceinline__ int perm32(int rho) { const int n = rho >> 4, i = rho & 15; return 8 * (i >> 2) + 4 * n + (i & 3); }

struct Unit { int pm, pn; };
struct Gemm { const bf16_t* A; const bf16_t* Bt; int M, N, K; };

struct StaticOrder {
    int nM, nN, nwg, G, c;
    __host__ __device__ void init(int M, int N, int G_, int c_) { nM = M / BM; nN = N / BM; nwg = nM * nN; G = G_; c = c_; }
    __host__ __device__ bool next(int i, Unit& u) const {
        const long L = (long)i * G + c; if (L >= nwg) return false;
        int wgid = (int)L; { const int q = nwg / NXCD, r = nwg % NXCD, xcd = wgid % NXCD, off = wgid / NXCD; wgid = (xcd < r ? xcd * (q + 1) : r * (q + 1) + (xcd - r) * q) + off; }
        const int nig = WGM * nN, gid = wgid / nig, fm = gid * WGM, gsz = (nM - fm) < WGM ? (nM - fm) : WGM;
        u.pm = fm + ((wgid % nig) % gsz); u.pn = (wgid % nig) / gsz; return true;
    }
    __device__ __forceinline__ void a_ready(const Unit&) const {}
    __device__ __forceinline__ void done(const Unit&) const {}
};
__device__ __forceinline__ unsigned cvt_pk_bf16(float lo, float hi) { unsigned r; asm volatile("v_cvt_pk_bf16_f32 %0, %1, %2" : "=v"(r) : "v"(lo), "v"(hi)); return r; }
typedef float f32x2 __attribute__((ext_vector_type(2)));
template <class Epi, class Sched>
__device__ __forceinline__ void gemm_phase(PG8_LAS unsigned char* lds, const Gemm g, const Sched& S, const Epi& E) {
    int tid_ = threadIdx.x; asm volatile("" : "+v"(tid_)); const int tid = tid_, wid = __builtin_amdgcn_readfirstlane(tid >> 6), lane = tid & 63, wr = wid >> 2, wc = wid & 3, fr = lane & 15, fq = lane >> 4;
    const int K = g.K, nt = K / BK;
    unsigned voffA[2], voffB[2];
#pragma unroll
    for (int i = 0; i < 2; ++i) { int R, C; stage_rc(tid * 16 + i * 8192, R, C); const int Rb = Epi::PERM ? ((R & ~31) + perm32(R & 31)) : R;
        voffA[i] = (unsigned)(R * K + C) * 2u; voffB[i] = (unsigned)(Rb * K + C) * 2u; }
    const size_t kstep = (size_t)(BK * 2);
    const size_t hstep = (size_t)HALF * K * 2;
    const size_t tstep = 2 * hstep;
    const unsigned ldsw = (unsigned)wid * 1024u;
    const int aoff = lds_byte(wr * 64 + fr, fq * 8), boff = lds_byte(wc * 32 + fr, fq * 8);
#define PG8_SA(b, h) (((b) * 2 + (h)) * HTB)
#define PG8_SB(b, h) ((4 + (b) * 2 + (h)) * HTB)
#define PG8_STAGE(bufoff, gbase, voff) do { _Pragma("unroll") for (int _i = 0; _i < 2; ++_i) \
        __builtin_amdgcn_global_load_lds((const unsigned*)((const char*)(gbase) + (voff)[_i]), (PG8_LAS unsigned*)(lds + (bufoff) + ldsw + _i * 8192), 16, 0, 0); } while (0)
#define PG8_LDA(dst, b, h) do { _Pragma("unroll") for (int m = 0; m < 4; ++m) _Pragma("unroll") for (int k = 0; k < 2; ++k) dst[m][k] = *(const PG8_LAS bf16x8*)(lds + PG8_SA(b, h) + aoff + m * 2048 + k * 1024); } while (0)
#define PG8_LDB(dst, b, h) do { _Pragma("unroll") for (int n = 0; n < 2; ++n) _Pragma("unroll") for (int k = 0; k < 2; ++k) dst[n][k] = *(const PG8_LAS bf16x8*)(lds + PG8_SB(b, h) + boff + n * 2048 + k * 1024); } while (0)
#define PG8_MMA(ai, bj, At, Bt) do { __builtin_amdgcn_s_setprio(1); _Pragma("unroll") for (int m = 0; m < 4; ++m) _Pragma("unroll") for (int n = 0; n < 2; ++n) _Pragma("unroll") for (int k = 0; k < 2; ++k) \
        acc[ai][bj][m][n] = __builtin_amdgcn_mfma_f32_16x16x32_bf16(Bt[n][k], At[m][k], acc[ai][bj][m][n], 0, 0, 0); __builtin_amdgcn_s_setprio(0); } while (0)
#define PG8_WAIT_V(n) asm volatile("s_waitcnt vmcnt(" #n ")" ::: "memory")
#define PG8_WAIT_L(n) asm volatile("s_waitcnt lgkmcnt(" #n ")" ::: "memory")
#define PG8_BAR __builtin_amdgcn_s_barrier()
#define PG8_SCHED __builtin_amdgcn_sched_barrier(0)
    Unit cur, nxt; int ui = 0;
    if (!S.next(0, cur)) return;
    f32x4 acc[2][2][4][2];
#pragma unroll
    for (int a = 0; a < 2; ++a)
#pragma unroll
        for (int b = 0; b < 2; ++b)
#pragma unroll
            for (int m = 0; m < 4; ++m)
#pragma unroll
                for (int n = 0; n < 2; ++n) acc[a][b][m][n] = (f32x4){0.f, 0.f, 0.f, 0.f};
    bf16x8 At[4][2], B0[2][2], B1[2][2];
    const char* cA = (const char*)g.A + (size_t)cur.pm * tstep; const char* cB = (const char*)g.Bt + (size_t)cur.pn * tstep;
    S.a_ready(cur);
    PG8_STAGE(PG8_SB(0, 0), cB, voffB); PG8_STAGE(PG8_SA(0, 0), cA, voffA); PG8_STAGE(PG8_SB(0, 1), cB + hstep, voffB); PG8_STAGE(PG8_SA(0, 1), cA + hstep, voffA);
    if (wr == 1) PG8_BAR;
    PG8_WAIT_V(4); PG8_BAR;
    PG8_STAGE(PG8_SB(1, 0), cB + kstep, voffB); PG8_STAGE(PG8_SA(1, 0), cA + kstep, voffA); PG8_STAGE(PG8_SB(1, 1), cB + hstep + kstep, voffB);
    PG8_WAIT_V(6); PG8_BAR;
    for (;;) {
        const bool has_next = S.next(ui + 1, nxt);
        const char* nA = has_next ? (const char*)g.A + (size_t)nxt.pm * tstep : cA; const char* nB = has_next ? (const char*)g.Bt + (size_t)nxt.pn * tstep : cB;
        int t = 0;
#pragma unroll
        for (int seg = 0; seg < (Epi::KHOOK > 0 ? 2 : 1); ++seg) {
        const int tend = (Epi::KHOOK > 0 && seg == 0) ? Epi::KHOOK : nt;
        for (; t < tend; t += 2) {
            const bool last = (t == nt - 2);
            const char* a1 = cA + (size_t)(t + 1) * kstep;
            const char* a2 = last ? nA : cA + (size_t)(t + 2) * kstep; const char* b2 = last ? nB : cB + (size_t)(t + 2) * kstep;
            const char* a3 = a2 + kstep; const char* b3 = b2 + kstep;
            if (last && has_next) S.a_ready(nxt);
            PG8_LDB(B0, 0, 0); PG8_SCHED; PG8_LDA(At, 0, 0); PG8_STAGE(PG8_SA(1, 1), a1 + hstep, voffA);
            PG8_WAIT_L(8); PG8_BAR; PG8_WAIT_L(0); PG8_MMA(0, 0, At, B0); PG8_BAR; PG8_SCHED;
            PG8_LDB(B1, 0, 1); PG8_STAGE(PG8_SB(0, 0), b2, voffB);
            PG8_BAR; PG8_WAIT_L(0); PG8_MMA(0, 1, At, B1); PG8_BAR;
            PG8_LDA(At, 0, 1); PG8_STAGE(PG8_SA(0, 0), a2, voffA);
            PG8_BAR; PG8_WAIT_L(0); PG8_MMA(1, 0, At, B0); PG8_BAR; PG8_SCHED;
            PG8_STAGE(PG8_SB(0, 1), b2 + hstep, voffB);
            PG8_WAIT_V(6); PG8_BAR; PG8_MMA(1, 1, At, B1); PG8_BAR;
            PG8_LDB(B0, 1, 0); PG8_SCHED; PG8_LDA(At, 1, 0); PG8_STAGE(PG8_SA(0, 1), a2 + hstep, voffA);
            PG8_WAIT_L(8); PG8_BAR; PG8_WAIT_L(0); PG8_MMA(0, 0, At, B0); PG8_BAR; PG8_SCHED;
            PG8_LDB(B1, 1, 1); PG8_STAGE(PG8_SB(1, 0), b3, voffB);
            PG8_BAR; PG8_WAIT_L(0); PG8_MMA(0, 1, At, B1); PG8_BAR;
            PG8_LDA(At, 1, 1); PG8_STAGE(PG8_SA(1, 0), a3, voffA);
            PG8_BAR; PG8_WAIT_L(0); PG8_MMA(1, 0, At, B0); PG8_BAR; PG8_SCHED;
            PG8_STAGE(PG8_SB(1, 1), b3 + hstep, voffB);
            PG8_WAIT_V(6); PG8_BAR; PG8_MMA(1, 1, At, B1); PG8_BAR;
        }
        if constexpr (Epi::KHOOK > 0) { if (seg == 0) E.mid(acc, cur, wr, wc, fr, fq); }
        }
        if constexpr (!Epi::AFTER_DRAIN) { E(acc, cur, wr, wc, fr, fq); S.done(cur); }
        if (!has_next) break;
#pragma unroll
        for (int a = 0; a < 2; ++a)
#pragma unroll
            for (int b = 0; b < 2; ++b)
#pragma unroll
                for (int m = 0; m < 4; ++m)
#pragma unroll
                    for (int n = 0; n < 2; ++n) acc[a][b][m][n] = (f32x4){0.f, 0.f, 0.f, 0.f};
        cur = nxt; cA = nA; cB = nB; ++ui;
    }
    PG8_WAIT_V(0);
    if (wr == 0) PG8_BAR;
    PG8_BAR;
    if constexpr (Epi::AFTER_DRAIN) { E.fused(acc, cur, wr, wc, fr, fq, lds, wid, lane); S.done(cur); }
#undef PG8_SA
#undef PG8_SB
#undef PG8_STAGE
#undef PG8_LDA
#undef PG8_LDB
#undef PG8_MMA
#undef PG8_WAIT_V
#undef PG8_WAIT_L
#undef PG8_BAR
#undef PG8_SCHED
}
}

#define LAS __attribute__((address_space(3)))
using pg8::bf16_t; using pg8::bf16x8; using pg8::f32x4; using pg8::u32x4;
typedef unsigned u32x2 __attribute__((ext_vector_type(2)));
typedef float f32x2 __attribute__((ext_vector_type(2)));
typedef short bf16x4 __attribute__((ext_vector_type(4)));

constexpr int DM = 1024, TB = 16384, NPROJ = 11008, DFF = 2816, NUP = 5632;
constexpr int C_QA = 0, C_KA = 1536, C_VA = 3072, C_QD = 4608, C_KD = 5632, C_VD = 6656, C_ZD = 7680, C_GA = 8704, C_GD = 9728, C_AB = 10752;
constexpr float EPSF = 1e-6f;
constexpr int LDS_BYTES = 147456;

constexpr size_t al256(size_t x) { return (x + 255) & ~(size_t)255; }
constexpr size_t WS_CTL = 0;
constexpr size_t WS_MOD = 20480;
constexpr size_t WS_ROPE = WS_MOD + al256((size_t)16 * 6144 * 4);
constexpr size_t WS_WIN = WS_ROPE + (size_t)4096 * 32 * 8;
constexpr size_t WS_WA = WS_WIN + (size_t)NPROJ * 1024 * 2;
constexpr size_t WS_WD = WS_WA + (size_t)1024 * 512 * 2;
constexpr size_t WS_WO = WS_WD + (size_t)1024 * 1024 * 2;
constexpr size_t WS_WUP = WS_WO + (size_t)1024 * 1024 * 2;
constexpr size_t WS_WDN = WS_WUP + (size_t)NUP * 1024 * 2;
constexpr size_t WS_XN = WS_WDN + (size_t)1024 * DFF * 2;
constexpr size_t WS_PROJ = WS_XN + (size_t)TB * 1024 * 2;
constexpr size_t WS_QKVD = WS_PROJ + (size_t)TB * NPROJ * 2;
constexpr size_t WS_TP = WS_QKVD + (size_t)TB * 3072 * 2;
constexpr size_t WS_EG = WS_TP + (size_t)4096 * 16384;
constexpr size_t WS_OD = WS_EG + (size_t)4096 * 512;
constexpr size_t WS_LSE = WS_OD + (size_t)2 * TB * 1024 * 2;
constexpr size_t WS_END = WS_LSE + (size_t)TB * 24 * 4;
static_assert(WS_END <= ((size_t)700 << 20), "workspace");

struct Params {
    const float* x_prompt; const float* x_sample; const float* c_prompt; const float* c_sample;
    const float* w_ada; const float* b_ada; const float* norm1_g; const float* w_in; const float* conv_qkv_w;
    const float* a_log; const float* dt_bias; const float* dn_norm_g; const float* w_br_attn; const float* w_br_dn;
    const float* w_out; const float* norm2_g; const float* w_up; const float* ffn_conv_w; const float* ffn_conv_b;
    const float* w_down; const float* norm_f_g;
    float* out; unsigned char* ws;
    int ph_lo, ph_hi;
};

__constant__ double INVF[32] = {1.0, 0.7498942093324559, 0.5623413251903491, 0.4216965034285822, 0.31622776601683794, 0.23713737056616552, 0.1778279410038923, 0.1333521432163324, 0.1, 0.07498942093324558, 0.05623413251903491, 0.042169650342858224, 0.03162277660168379, 0.023713737056616554, 0.01778279410038923, 0.01333521432163324, 0.01, 0.007498942093324558, 0.005623413251903491, 0.004216965034285823, 0.0031622776601683794, 0.0023713737056616554, 0.0017782794100389228, 0.001333521432163324, 0.001, 0.0007498942093324559, 0.0005623413251903491, 0.00042169650342858224, 0.00031622776601683794, 0.00023713737056616554, 0.00017782794100389227, 0.0001333521432163324};

__device__ __forceinline__ float bf2f(unsigned short b) { return __uint_as_float(((unsigned)b) << 16); }
__device__ __forceinline__ float bflo(unsigned w) { return __uint_as_float(w << 16); }
__device__ __forceinline__ float bfhi(unsigned w) { return __uint_as_float(w & 0xffff0000u); }
typedef __bf16 bf16x2n_t __attribute__((ext_vector_type(2)));
__device__ __forceinline__ unsigned pk2(float lo, float hi) { const f32x2 v = {lo, hi}; const bf16x2n_t r = __builtin_convertvector(v, bf16x2n_t); return __builtin_bit_cast(unsigned, r); }
__device__ __forceinline__ unsigned short f2bf(float f) { return (unsigned short)(pk2(f, 0.f) & 0xffffu); }
__device__ __forceinline__ float sigmoidf_(float x) { return 1.0f / (1.0f + __expf(-x)); }
__device__ __forceinline__ float siluf_(float x) { return x / (1.0f + __expf(-x)); }
__device__ __forceinline__ float wave_sum(float v) {
#pragma unroll
    for (int o = 32; o >= 1; o >>= 1) v += __shfl_xor(v, o);
    return v;
}
__device__ __forceinline__ int ltid() { int t = threadIdx.x; asm volatile("" : "+v"(t)); return t; }
struct Batch { int b, L, lgL, nseq; const float* x; float* out; };
__device__ __forceinline__ Batch make_batch(const Params& p, int b) {
    Batch B; B.b = b; B.L = b == 0 ? 2048 : 4096; B.lgL = b == 0 ? 11 : 12; B.nseq = TB >> B.lgL;
    B.x = b == 0 ? p.x_prompt : p.x_sample + (size_t)(b - 1) * TB * DM; B.out = p.out + (size_t)b * TB * DM; return B;
}
__device__ __forceinline__ int cond_index(const Batch& B, int row) { const int s = row >> B.lgL; return B.b == 0 ? s : 8 + (B.b - 1) * 4 + s; }

__device__ __forceinline__ float bf_el8(const u32x4& a, int e) { const unsigned w = a[(e >> 1) & 3]; return (e & 1) ? bfhi(w) : bflo(w); }
__device__ __forceinline__ void transpose_tile(const float* __restrict__ src, int Nsrc, bf16_t* __restrict__ dst, int K, int kt, int nt, int mode, LAS float* T, int koff = 0) {
    const int tid = ltid();
    const int c4 = (tid & 15) * 4, r0 = tid >> 4;
    const int j = nt * 64 + c4; int sj = j;
    if (mode == 1) sj = (j < 8704) ? j : (j < 10752) ? j + 32 : (j < 10784) ? j - 2048 : -1;
    if (mode == 2) { const int pn = j >> 8, jj = j & 255; sj = jj < 128 ? 128 * pn + jj : DFF + 128 * pn + (jj - 128); }
#pragma unroll
    for (int i = 0; i < 2; ++i) {
        const int r = r0 + 32 * i;
        f32x4 v = {0.f, 0.f, 0.f, 0.f};
        if (sj >= 0) v = *(const f32x4*)(src + (size_t)(kt * 64 + r) * Nsrc + sj);
        T[r * 65 + c4 + 0] = v[0]; T[r * 65 + c4 + 1] = v[1]; T[r * 65 + c4 + 2] = v[2]; T[r * 65 + c4 + 3] = v[3];
    }
    __syncthreads();
    const int n = tid >> 3, kp = (tid & 7) * 8;
    u32x4 w;
    w.x = pk2(T[(kp + 0) * 65 + n], T[(kp + 1) * 65 + n]); w.y = pk2(T[(kp + 2) * 65 + n], T[(kp + 3) * 65 + n]);
    w.z = pk2(T[(kp + 4) * 65 + n], T[(kp + 5) * 65 + n]); w.w = pk2(T[(kp + 6) * 65 + n], T[(kp + 7) * 65 + n]);
    *(u32x4*)(dst + (size_t)(nt * 64 + n) * K + koff + kt * 64 + kp) = w;
    __syncthreads();
}

__device__ __forceinline__ void mod_item(const Params& p, int item, LAS unsigned char* L) {
    LAS float* sc = (LAS float*)L;
    LAS float* red = (LAS float*)(L + 65536);
    const int tid = ltid(), lane = tid & 63, wid = tid >> 6;
    for (int e = tid; e < 16384; e += 512) { const int r = e >> 10, k = e & 1023; const float c = r < 8 ? p.c_prompt[r * 1024 + k] : p.c_sample[(r - 8) * 1024 + k]; sc[k * 16 + r] = siluf_(c); }
    __syncthreads();
    const int j = item * 64 + lane;
    float acc[16];
#pragma unroll
    for (int r = 0; r < 16; ++r) acc[r] = 0.f;
    for (int k = wid * 128; k < wid * 128 + 128; ++k) {
        const float w = p.w_ada[(size_t)k * 6144 + j];
#pragma unroll
        for (int q = 0; q < 4; ++q) { const f32x4 s = *(const LAS f32x4*)(sc + k * 16 + 4 * q);
            acc[4 * q + 0] += w * s[0]; acc[4 * q + 1] += w * s[1]; acc[4 * q + 2] += w * s[2]; acc[4 * q + 3] += w * s[3]; }
    }
#pragma unroll
    for (int r = 0; r < 16; ++r) red[(wid * 16 + r) * 64 + lane] = acc[r];
    __syncthreads();
    float* MOD = (float*)(p.ws + WS_MOD);
    for (int e = tid; e < 1024; e += 512) { const int r = e >> 6, l = e & 63; float s = 0.f;
#pragma unroll
        for (int w = 0; w < 8; ++w) s += red[(w * 16 + r) * 64 + l];
        MOD[r * 6144 + item * 64 + l] = s + p.b_ada[item * 64 + l]; }
    __syncthreads();
}

__device__ __forceinline__ void phase0(const Params& p, LAS unsigned char* L) {
    const int G = gridDim.x, bid = blockIdx.x, tid = ltid();
    { f32x2* R = (f32x2*)(p.ws + WS_ROPE);
      for (int e = bid * 512 + tid; e < 4096 * 32; e += G * 512) { const int pos = e >> 5, i = e & 31;
          const double rev = (double)pos * INVF[i] * 0.15915494309189535; const double fr = rev - __builtin_rint(rev);
          f32x2 cs; cs.x = __builtin_amdgcn_cosf((float)fr); cs.y = __builtin_amdgcn_sinf((float)fr); R[e] = cs; } }
    if (bid >= G - 96) mod_item(p, bid - (G - 96), L);
    constexpr int I_IN = 16 * 172, I_A = 8 * 16, I_D = 16 * 16, I_O = 16 * 16, I_UP = 16 * 88, I_DN = 44 * 16;
    constexpr int NIT = I_IN + I_A + I_D + I_O + I_UP + I_DN;
    LAS float* T = (LAS float*)L;
    const int tid_ = ltid(), c4 = (tid_ & 15) * 4, r0 = tid_ >> 4, n_ = tid_ >> 3, kp = (tid_ & 7) * 8;
    for (int it0 = bid; it0 < NIT; it0 += 2 * G) {
        const float* src[2]; bf16_t* dst[2]; int Nsrc[2], K[2], kt[2], nt[2], mode[2], koff[2]; bool on[2];
#pragma unroll
        for (int u = 0; u < 2; ++u) { int r = it0 + u * G; on[u] = r < NIT; if (!on[u]) r = it0; koff[u] = 0; mode[u] = 0;
            if (r < I_IN) { src[u] = p.w_in; Nsrc[u] = 10784; dst[u] = (bf16_t*)(p.ws + WS_WIN); K[u] = 1024; kt[u] = r & 15; nt[u] = r >> 4; mode[u] = 1; }
            else if ((r -= I_IN) < I_A) { src[u] = p.w_br_attn; Nsrc[u] = 1024; dst[u] = (bf16_t*)(p.ws + WS_WA); K[u] = 1536; kt[u] = r & 7; nt[u] = r >> 3; }
            else if ((r -= I_A) < I_D) { src[u] = p.w_br_dn; Nsrc[u] = 1024; dst[u] = (bf16_t*)(p.ws + WS_WA); K[u] = 1536; kt[u] = r & 15; nt[u] = r >> 4; koff[u] = 512; }
            else if ((r -= I_D) < I_O) { src[u] = p.w_out; Nsrc[u] = 1024; dst[u] = (bf16_t*)(p.ws + WS_WO); K[u] = 1024; kt[u] = r & 15; nt[u] = r >> 4; }
            else if ((r -= I_O) < I_UP) { src[u] = p.w_up; Nsrc[u] = NUP; dst[u] = (bf16_t*)(p.ws + WS_WUP); K[u] = 1024; kt[u] = r & 15; nt[u] = r >> 4; mode[u] = 2; }
            else { r -= I_UP; src[u] = p.w_down; Nsrc[u] = 1024; dst[u] = (bf16_t*)(p.ws + WS_WDN); K[u] = DFF; kt[u] = r % 44; nt[u] = r / 44; } }
        f32x4 v[2][2];
#pragma unroll
        for (int u = 0; u < 2; ++u) { const int j = nt[u] * 64 + c4; int sj = j;
            if (mode[u] == 1) sj = (j < 8704) ? j : (j < 10752) ? j + 32 : (j < 10784) ? j - 2048 : -1;
            if (mode[u] == 2) { const int pn = j >> 8, jj = j & 255; sj = jj < 128 ? 128 * pn + jj : DFF + 128 * pn + (jj - 128); }
#pragma unroll
            for (int i = 0; i < 2; ++i) { v[u][i] = (f32x4){0.f, 0.f, 0.f, 0.f}; if (sj >= 0) v[u][i] = *(const f32x4*)(src[u] + (size_t)(kt[u] * 64 + r0 + 32 * i) * Nsrc[u] + sj); } }
#pragma unroll
        for (int u = 0; u < 2; ++u)
#pragma unroll
            for (int i = 0; i < 2; ++i) { LAS float* tp = T + u * 4160 + (r0 + 32 * i) * 65 + c4; tp[0] = v[u][i][0]; tp[1] = v[u][i][1]; tp[2] = v[u][i][2]; tp[3] = v[u][i][3]; }
        __syncthreads();
#pragma unroll
        for (int u = 0; u < 2; ++u) if (on[u]) { const LAS float* tq = T + u * 4160 + kp * 65 + n_; u32x4 w;
            w.x = pk2(tq[0], tq[65]); w.y = pk2(tq[130], tq[195]); w.z = pk2(tq[260], tq[325]); w.w = pk2(tq[390], tq[455]);
            *(u32x4*)(dst[u] + (size_t)(nt[u] * 64 + n_) * K[u] + koff[u] + kt[u] * 64 + kp) = w; }
        __syncthreads();
    }
}

__device__ __forceinline__ void norm_mod_rows(const Params& p, const Batch& B, const float* __restrict__ xin, const float* __restrict__ g, int sh_off, int sc_off, bf16_t* __restrict__ out) {
    const int lane = ltid() & 63, gw = blockIdx.x * 8 + (ltid() >> 6), NGW = gridDim.x * 8;
    const float* MOD = (const float*)(p.ws + WS_MOD);
    f32x4 gv[4];
#pragma unroll
    for (int i = 0; i < 4; ++i) gv[i] = *(const f32x4*)(g + 4 * lane + 256 * i);
    for (int r = gw; r < TB; r += 2 * NGW) {
        const int r1 = r + NGW; const bool has1 = r1 < TB; const int rb = has1 ? r1 : r;
        const float* xa = xin + (size_t)r * DM; const float* xb = xin + (size_t)rb * DM;
        f32x4 va[4], vb[4]; float sa = 0.f, sb = 0.f;
#pragma unroll
        for (int i = 0; i < 4; ++i) { va[i] = *(const f32x4*)(xa + 4 * lane + 256 * i); vb[i] = *(const f32x4*)(xb + 4 * lane + 256 * i); }
#pragma unroll
        for (int i = 0; i < 4; ++i) { sa += va[i][0] * va[i][0] + va[i][1] * va[i][1] + va[i][2] * va[i][2] + va[i][3] * va[i][3]; sb += vb[i][0] * vb[i][0] + vb[i][1] * vb[i][1] + vb[i][2] * vb[i][2] + vb[i][3] * vb[i][3]; }
        const float rsa = rsqrtf(wave_sum(sa) * (1.0f / DM) + EPSF), rsb = rsqrtf(wave_sum(sb) * (1.0f / DM) + EPSF);
        const float* ma = MOD + (size_t)cond_index(B, r) * 6144; const float* mb = MOD + (size_t)cond_index(B, rb) * 6144;
#pragma unroll
        for (int i = 0; i < 4; ++i) { const f32x4 sc = *(const f32x4*)(ma + sc_off + 4 * lane + 256 * i), sh = *(const f32x4*)(ma + sh_off + 4 * lane + 256 * i);
            const f32x4 y = va[i] * rsa * gv[i] * (sc + 1.0f) + sh; u32x2 w; w.x = pk2(y[0], y[1]); w.y = pk2(y[2], y[3]);
            *(u32x2*)(out + (size_t)r * DM + 4 * lane + 256 * i) = w; }
        if (has1) {
#pragma unroll
            for (int i = 0; i < 4; ++i) { const f32x4 sc = *(const f32x4*)(mb + sc_off + 4 * lane + 256 * i), sh = *(const f32x4*)(mb + sh_off + 4 * lane + 256 * i);
                const f32x4 y = vb[i] * rsb * gv[i] * (sc + 1.0f) + sh; u32x2 w; w.x = pk2(y[0], y[1]); w.y = pk2(y[2], y[3]);
                *(u32x2*)(out + (size_t)r1 * DM + 4 * lane + 256 * i) = w; } }
    }
}
__device__ __forceinline__ void final_norm_rows(float* __restrict__ io, const float* __restrict__ g) {
    const int lane = ltid() & 63, gw = blockIdx.x * 8 + (ltid() >> 6), NGW = gridDim.x * 8;
    f32x4 gv[4];
#pragma unroll
    for (int i = 0; i < 4; ++i) gv[i] = *(const f32x4*)(g + 4 * lane + 256 * i);
    for (int r = gw; r < TB; r += 2 * NGW) {
        const int r1 = r + NGW; const bool has1 = r1 < TB; const int rb = has1 ? r1 : r;
        float* xa = io + (size_t)r * DM; float* xb = io + (size_t)rb * DM; f32x4 va[4], vb[4]; float sa = 0.f, sb = 0.f;
#pragma unroll
        for (int i = 0; i < 4; ++i) { va[i] = *(const f32x4*)(xa + 4 * lane + 256 * i); vb[i] = *(const f32x4*)(xb + 4 * lane + 256 * i); }
#pragma unroll
        for (int i = 0; i < 4; ++i) { sa += va[i][0] * va[i][0] + va[i][1] * va[i][1] + va[i][2] * va[i][2] + va[i][3] * va[i][3]; sb += vb[i][0] * vb[i][0] + vb[i][1] * vb[i][1] + vb[i][2] * vb[i][2] + vb[i][3] * vb[i][3]; }
        const float rsa = rsqrtf(wave_sum(sa) * (1.0f / DM) + EPSF), rsb = rsqrtf(wave_sum(sb) * (1.0f / DM) + EPSF);
#pragma unroll
        for (int i = 0; i < 4; ++i) *(f32x4*)(xa + 4 * lane + 256 * i) = va[i] * rsa * gv[i];
        if (has1) {
#pragma unroll
            for (int i = 0; i < 4; ++i) *(f32x4*)(xb + 4 * lane + 256 * i) = vb[i] * rsb * gv[i]; }
    }
}

struct EpiBf16S {
    static constexpr bool PERM = true, AFTER_DRAIN = false; static constexpr int KHOOK = 0;
    bf16_t* O; int ldc;
    __device__ __forceinline__ void operator()(const f32x4 (&acc)[2][2][4][2], const pg8::Unit& u, int wr, int wc, int fr, int fq) const {
        const int row0 = u.pm * 256 + wr * 64 + fr, col0 = u.pn * 256 + wc * 32 + 8 * fq;
#pragma unroll
        for (int ai = 0; ai < 2; ++ai)
#pragma unroll
            for (int m = 0; m < 4; ++m) { bf16_t* rowp = O + (size_t)(row0 + ai * 128 + m * 16) * ldc + col0;
#pragma unroll
                for (int bj = 0; bj < 2; ++bj) { const f32x4 v0 = acc[ai][bj][m][0], v1 = acc[ai][bj][m][1];
                    u32x4 w; w.x = pk2(v0[0], v0[1]); w.y = pk2(v0[2], v0[3]); w.z = pk2(v1[0], v1[1]); w.w = pk2(v1[2], v1[3]);
                    *(u32x4*)(rowp + bj * 128) = w; } }
    }
};
struct EpiMerge {
    static constexpr bool PERM = true, AFTER_DRAIN = false; static constexpr int KHOOK = 8;
    const bf16_t* ga; const bf16_t* gd; int ldg; bf16_t* O;
    __device__ __forceinline__ void mid(f32x4 (&acc)[2][2][4][2], const pg8::Unit& u, int wr, int wc, int fr, int fq) const {
        const int row0 = u.pm * 256 + wr * 64 + fr, col0 = u.pn * 256 + wc * 32 + 8 * fq;
        size_t ro = (size_t)row0 * ldg + col0;
        u32x4 ca[2], cd[2], na[2], nd[2];
#pragma unroll
        for (int bj = 0; bj < 2; ++bj) { ca[bj] = *(const u32x4*)(ga + ro + bj * 128); cd[bj] = *(const u32x4*)(gd + ro + bj * 128); na[bj] = ca[bj]; nd[bj] = cd[bj]; }
#pragma unroll
        for (int k = 0; k < 8; ++k) { const int ai = k >> 2, m = k & 3;
            const size_t rn = ro + (size_t)(m == 3 ? 80 : 16) * ldg;
            if (k < 7) {
#pragma unroll
                for (int bj = 0; bj < 2; ++bj) { na[bj] = *(const u32x4*)(ga + rn + bj * 128); nd[bj] = *(const u32x4*)(gd + rn + bj * 128); } }
#pragma unroll
            for (int bj = 0; bj < 2; ++bj)
#pragma unroll
                for (int q = 0; q < 4; ++q) { const float r0 = (1.0f + __expf(-bflo(cd[bj][q]))) * __builtin_amdgcn_rcpf(1.0f + __expf(-bflo(ca[bj][q]))), r1 = (1.0f + __expf(-bfhi(cd[bj][q]))) * __builtin_amdgcn_rcpf(1.0f + __expf(-bfhi(ca[bj][q])));
                    acc[ai][bj][m][q >> 1][2 * (q & 1)] *= r0; acc[ai][bj][m][q >> 1][2 * (q & 1) + 1] *= r1; }
            asm volatile("" ::: "memory");
#pragma unroll
            for (int bj = 0; bj < 2; ++bj) { ca[bj] = na[bj]; cd[bj] = nd[bj]; }
            ro = rn; }
    }
    __device__ __forceinline__ void operator()(const f32x4 (&acc)[2][2][4][2], const pg8::Unit& u, int wr, int wc, int fr, int fq) const {
        const int row0 = u.pm * 256 + wr * 64 + fr, col0 = u.pn * 256 + wc * 32 + 8 * fq;
        u32x4 cd[2], nd[2];
#pragma unroll
        for (int bj = 0; bj < 2; ++bj) { cd[bj] = *(const u32x4*)(gd + (size_t)row0 * ldg + col0 + bj * 128); nd[bj] = cd[bj]; }
#pragma unroll
        for (int k = 0; k < 8; ++k) { const int ai = k >> 2, m = k & 3; const int row = row0 + ai * 128 + m * 16;
            if (k < 7) { const int rown = row0 + ((k + 1) >> 2) * 128 + ((k + 1) & 3) * 16;
#pragma unroll
                for (int bj = 0; bj < 2; ++bj) nd[bj] = *(const u32x4*)(gd + (size_t)rown * ldg + col0 + bj * 128); }
#pragma unroll
            for (int bj = 0; bj < 2; ++bj) { const u32x4 d = cd[bj]; const f32x4 v0 = acc[ai][bj][m][0], v1 = acc[ai][bj][m][1];
                u32x4 w; w.x = pk2(v0[0] * sigmoidf_(bflo(d.x)), v0[1] * sigmoidf_(bfhi(d.x))); w.y = pk2(v0[2] * sigmoidf_(bflo(d.y)), v0[3] * sigmoidf_(bfhi(d.y)));
                w.z = pk2(v1[0] * sigmoidf_(bflo(d.z)), v1[1] * sigmoidf_(bfhi(d.z))); w.w = pk2(v1[2] * sigmoidf_(bflo(d.w)), v1[3] * sigmoidf_(bfhi(d.w)));
                *(u32x4*)(O + (size_t)row * DM + col0 + bj * 128) = w; }
            asm volatile("" ::: "memory");
#pragma unroll
            for (int bj = 0; bj < 2; ++bj) cd[bj] = nd[bj]; }
    }
};
struct OneUnit {
    pg8::Unit u0;
    __device__ __forceinline__ bool next(int i, pg8::Unit& u) const { if (i != 0) return false; u = u0; return true; }
    __device__ __forceinline__ void a_ready(const pg8::Unit&) const {}
    __device__ __forceinline__ void done(const pg8::Unit&) const {}
};
struct EpiConvFfn {
    static constexpr bool PERM = false, AFTER_DRAIN = true; static constexpr int KHOOK = 0;
    bf16_t* ACT; const float* cw; const float* cb; int rowstart, Lseq;
    __device__ __forceinline__ void fused(f32x4 (&acc)[2][2][4][2], const pg8::Unit& u, int wr, int wc, int fr, int fq, LAS unsigned char* lds, int wid, int lane) const {
        LAS bf16_t* T = (LAS bf16_t*)lds;
        LAS float* W = (LAS float*)(lds + 135168);
        const int tid = wid * 64 + lane;
        for (int e = tid; e < 1024; e += 512) { const int k = e >> 7, c = e & 127, cg_ = 128 * u.pn + c; float v;
            if (k < 3) v = cw[k * NUP + cg_]; else if (k < 6) v = cw[(k - 3) * NUP + DFF + cg_]; else if (k == 6) v = cb[cg_]; else v = cb[DFF + cg_];
            W[e] = v; }
#pragma unroll
        for (int ai = 0; ai < 2; ++ai)
#pragma unroll
            for (int m = 0; m < 4; ++m) { const int row = ai * 128 + wr * 64 + m * 16 + fr;
#pragma unroll
                for (int bj = 0; bj < 2; ++bj)
#pragma unroll
                    for (int n = 0; n < 2; ++n) { const int col = bj * 128 + wc * 32 + n * 16 + 4 * fq; const f32x4 v = acc[ai][bj][m][n];
                        u32x2 w; w.x = pk2(v[0], v[1]); w.y = pk2(v[2], v[3]); *(LAS u32x2*)(T + row * 264 + col) = w; } }
        __syncthreads();
        const u32x4 z4 = {0u, 0u, 0u, 0u};
#pragma unroll 1
        for (int i = 0; i < 8; ++i) { const int t = tid + 512 * i; if (t >= 4064) break;
            const int r = 1 + (t >> 4), c8 = (t & 15) * 8, grow = rowstart + r; if (grow < 0 || grow >= TB) continue;
            const int s_ = grow & (Lseq - 1);
            const LAS bf16_t* tp = T + r * 264 + c8;
            u32x4 vp = *(const LAS u32x4*)(tp - 264), vc = *(const LAS u32x4*)tp, vn = *(const LAS u32x4*)(tp + 264);
            u32x4 gp = *(const LAS u32x4*)(tp - 264 + 128), gc = *(const LAS u32x4*)(tp + 128), gn = *(const LAS u32x4*)(tp + 264 + 128);
            if (s_ == 0) { vp = z4; gp = z4; }
            if (s_ == Lseq - 1) { vn = z4; gn = z4; }
            float o[8];
#pragma unroll
            for (int q = 0; q < 2; ++q) { const f32x4 wv0 = *(const LAS f32x4*)(W + c8 + 4 * q), wv1 = *(const LAS f32x4*)(W + 128 + c8 + 4 * q), wv2 = *(const LAS f32x4*)(W + 256 + c8 + 4 * q);
                const f32x4 wg0 = *(const LAS f32x4*)(W + 384 + c8 + 4 * q), wg1 = *(const LAS f32x4*)(W + 512 + c8 + 4 * q), wg2 = *(const LAS f32x4*)(W + 640 + c8 + 4 * q);
                const f32x4 bv = *(const LAS f32x4*)(W + 768 + c8 + 4 * q), bg = *(const LAS f32x4*)(W + 896 + c8 + 4 * q);
#pragma unroll
                for (int k = 0; k < 4; ++k) { const int e = 4 * q + k;
                    const float val = bf_el8(vp, e) * wv0[k] + bf_el8(vc, e) * wv1[k] + bf_el8(vn, e) * wv2[k] + bv[k];
                    const float gt = bf_el8(gp, e) * wg0[k] + bf_el8(gc, e) * wg1[k] + bf_el8(gn, e) * wg2[k] + bg[k];
                    o[e] = siluf_(gt) * val; } }
            u32x4 w; w.x = pk2(o[0], o[1]); w.y = pk2(o[2], o[3]); w.z = pk2(o[4], o[5]); w.w = pk2(o[6], o[7]);
            *(u32x4*)(ACT + (size_t)grow * DFF + 128 * u.pn + c8) = w; }
        __syncthreads();
    }
};
struct EpiResid {
    static constexpr bool PERM = false, AFTER_DRAIN = false; static constexpr int KHOOK = 0;
    const float* xin; float* out; const float* gt; int lgL, cbase;
    __device__ __forceinline__ void operator()(const f32x4 (&acc)[2][2][4][2], const pg8::Unit& u, int wr, int wc, int fr, int fq) const {
        const int row0 = u.pm * 256 + wr * 64 + fr, col0 = u.pn * 256 + wc * 32 + 4 * fq;
        f32x4 xc[4], gc[4], xn[4], gn[4];
        { const float* gr = gt + (size_t)(cbase + (row0 >> lgL)) * 6144;
#pragma unroll
          for (int q = 0; q < 4; ++q) { const int col = col0 + (q >> 1) * 128 + (q & 1) * 16; xc[q] = *(const f32x4*)(xin + (size_t)row0 * DM + col); gc[q] = *(const f32x4*)(gr + col); xn[q] = xc[q]; gn[q] = gc[q]; } }
#pragma unroll
        for (int k = 0; k < 8; ++k) { const int ai = k >> 2, m = k & 3; const int row = row0 + ai * 128 + m * 16;
            if (k < 7) { const int rown = row0 + ((k + 1) >> 2) * 128 + ((k + 1) & 3) * 16; const float* gr = gt + (size_t)(cbase + (rown >> lgL)) * 6144;
#pragma unroll
                for (int q = 0; q < 4; ++q) { const int col = col0 + (q >> 1) * 128 + (q & 1) * 16; xn[q] = *(const f32x4*)(xin + (size_t)rown * DM + col); gn[q] = *(const f32x4*)(gr + col); } }
#pragma unroll
            for (int q = 0; q < 4; ++q) { const int col = col0 + (q >> 1) * 128 + (q & 1) * 16;
                *(f32x4*)(out + (size_t)row * DM + col) = xc[q] + gc[q] * acc[ai][q >> 1][m][q & 1]; }
            asm volatile("" ::: "memory");
#pragma unroll
            for (int q = 0; q < 4; ++q) { xc[q] = xn[q]; gc[q] = gn[q]; } }
    }
};

__device__ __forceinline__ bf16x8 permfrag_sw(const LAS bf16_t* base, int row, int stride, int kbase, int g, int sw) {
    const u32x2 lo = *(const LAS u32x2*)(base + row * stride + ((kbase + 4 * g) ^ sw)), hi = *(const LAS u32x2*)(base + row * stride + ((kbase + 16 + 4 * g) ^ sw));
    u32x4 w; w.x = lo.x; w.y = lo.y; w.z = hi.x; w.w = hi.y; return __builtin_bit_cast(bf16x8, w);
}
#define MFMA16(a, b, c) __builtin_amdgcn_mfma_f32_16x16x32_bf16((a), (b), (c), 0, 0, 0)
__device__ __forceinline__ float bf_el(const u32x4& a, const u32x4& b, int e) { const unsigned w = (e < 8) ? a[(e >> 1) & 3] : b[(e >> 1) & 3]; return (e & 1) ? bfhi(w) : bflo(w); }

__device__ __forceinline__ void prep_item(const Params& p, const Batch& B, int item, LAS unsigned char* L) {
    const int tid = ltid(), lane = tid & 63, wid = tid >> 6, g = lane >> 4, fr = lane & 15;
    const int NC = B.L >> 6;
    const int hp = item & 3, sn = item >> 2, n = sn & (NC - 1), seq = sn >> (B.lgL - 6);
    const int r0 = seq * B.L + n * 64;
    LAS bf16_t* KS = (LAS bf16_t*)L;
    LAS bf16_t* QS = (LAS bf16_t*)(L + 34816);
    LAS float* AA = (LAS float*)L;
    LAS float* KK = (LAS float*)(L + 69632);
    LAS float* QK = (LAS float*)(L + 102912);
    LAS float* GS = (LAS float*)(L + 136192);
    const bf16_t* PROJ = (const bf16_t*)(p.ws + WS_PROJ);
    bf16_t* QKVD = (bf16_t*)(p.ws + WS_QKVD);
    LAS float* CW = (LAS float*)(L + 69632);
    for (int e = tid; e < 2304; e += 512) { const int hh = e / 1152, rem = e - hh * 1152, mat = rem / 384, rem2 = rem - mat * 384, tap = rem2 >> 7, c = rem2 & 127;
        CW[e] = p.conv_qkv_w[tap * 3072 + mat * 1024 + (hp * 2 + hh) * 128 + c]; }
    float al_pre = 0.f, be_pre = 0.f;
    if (wid < 4) { const int hh = wid >> 1, dir = wid & 1, h = hp * 2 + hh; const int c = dir ? 63 - lane : lane; const int row = r0 + c;
        al_pre = bf2f(PROJ[(size_t)row * NPROJ + C_AB + dir * 8 + h]); be_pre = bf2f(PROJ[(size_t)row * NPROJ + C_AB + 16 + dir * 8 + h]); }
    __syncthreads();
    {
        const int r = tid >> 3, pc = (tid & 7) * 16; const int row = r0 + r; const int s = n * 64 + r;
        const bool hasp = s > 0, hasn = s < B.L - 1;
        const u32x4 z4 = {0u, 0u, 0u, 0u};
#pragma unroll
        for (int hh = 0; hh < 2; ++hh) {
            const int h = hp * 2 + hh;
            u32x4 xc[3][2], xp[3][2], xn[3][2];
#pragma unroll
            for (int mat = 0; mat < 3; ++mat) { const bf16_t* src = PROJ + (size_t)row * NPROJ + C_QD + mat * 1024 + h * 128 + pc;
                xc[mat][0] = *(const u32x4*)src; xc[mat][1] = *(const u32x4*)(src + 8); xp[mat][0] = z4; xp[mat][1] = z4; xn[mat][0] = z4; xn[mat][1] = z4;
                if (hasp) { xp[mat][0] = *(const u32x4*)(src - NPROJ); xp[mat][1] = *(const u32x4*)(src - NPROJ + 8); }
                if (hasn) { xn[mat][0] = *(const u32x4*)(src + NPROJ); xn[mat][1] = *(const u32x4*)(src + NPROJ + 8); } }
#pragma unroll
            for (int mat = 0; mat < 3; ++mat) {
                const int col = mat * 1024 + h * 128 + pc;
                const LAS float* cw = CW + (hh * 3 + mat) * 384 + pc;
                float y[16]; float ss = 0.f;
#pragma unroll
                for (int q = 0; q < 4; ++q) {
                    const f32x4 w0 = *(const LAS f32x4*)(cw + 4 * q), w1 = *(const LAS f32x4*)(cw + 128 + 4 * q), w2 = *(const LAS f32x4*)(cw + 256 + 4 * q);
#pragma unroll
                    for (int e = 0; e < 4; ++e) { const int ee = 4 * q + e;
                        float v = bf_el(xp[mat][0], xp[mat][1], ee) * w0[e] + bf_el(xc[mat][0], xc[mat][1], ee) * w1[e] + bf_el(xn[mat][0], xn[mat][1], ee) * w2[e];
                        v = siluf_(v); y[ee] = v; ss += v * v; }
                }
                if (mat < 2) {
                    ss += __shfl_xor(ss, 1); ss += __shfl_xor(ss, 2); ss += __shfl_xor(ss, 4);
                    float sc = rsqrtf(ss + EPSF); if (mat == 0) sc *= 0.08838834764831845f;
#pragma unroll
                    for (int e = 0; e < 16; ++e) y[e] *= sc;
                }
                u32x4 o0, o1;
                o0.x = pk2(y[0], y[1]); o0.y = pk2(y[2], y[3]); o0.z = pk2(y[4], y[5]); o0.w = pk2(y[6], y[7]);
                o1.x = pk2(y[8], y[9]); o1.y = pk2(y[10], y[11]); o1.z = pk2(y[12], y[13]); o1.w = pk2(y[14], y[15]);
                bf16_t* dst = QKVD + (size_t)row * 3072 + col;
                *(u32x4*)dst = o0; *(u32x4*)(dst + 8) = o1;
                if (mat == 0) { *(LAS u32x4*)(QS + (hh * 64 + r) * 136 + pc) = o0; *(LAS u32x4*)(QS + (hh * 64 + r) * 136 + pc + 8) = o1; }
                if (mat == 1) { *(LAS u32x4*)(KS + (hh * 64 + r) * 136 + pc) = o0; *(LAS u32x4*)(KS + (hh * 64 + r) * 136 + pc + 8) = o1; }
            }
        }
    }
    __syncthreads();
    {
        const int hh = wid >> 2, ct = wid & 3; const LAS bf16_t* Kh = KS + hh * 64 * 136; const LAS bf16_t* Qh = QS + hh * 64 * 136;
        bf16x8 ak[4], aq[4];
#pragma unroll
        for (int ks = 0; ks < 4; ++ks) { ak[ks] = *(const LAS bf16x8*)(Kh + (16 * ct + fr) * 136 + 32 * ks + 8 * g); aq[ks] = *(const LAS bf16x8*)(Qh + (16 * ct + fr) * 136 + 32 * ks + 8 * g); }
#pragma unroll
        for (int dt = 0; dt < 4; ++dt) {
            f32x4 c0 = {0.f, 0.f, 0.f, 0.f}, c1 = {0.f, 0.f, 0.f, 0.f};
#pragma unroll
            for (int ks = 0; ks < 4; ++ks) { const bf16x8 b = *(const LAS bf16x8*)(Kh + (16 * dt + fr) * 136 + 32 * ks + 8 * g); c0 = MFMA16(ak[ks], b, c0); c1 = MFMA16(aq[ks], b, c1); }
#pragma unroll
            for (int j = 0; j < 4; ++j) { KK[hh * 4160 + (16 * ct + 4 * g + j) * 65 + 16 * dt + fr] = c0[j]; QK[hh * 4160 + (16 * ct + 4 * g + j) * 65 + 16 * dt + fr] = c1[j]; }
        }
    }
    if (wid < 4) {
        const int hh = wid >> 1, dir = wid & 1, h = hp * 2 + hh; const int c = dir ? 63 - lane : lane; const int row = r0 + c;
        const float al = al_pre, be = be_pre; (void)row;
        const float xx = al + p.dt_bias[dir * 8 + h]; const float sp = fmaxf(xx, 0.f) + log1pf(__expf(-fabsf(xx)));
        float G = -__expf(p.a_log[dir * 8 + h]) * sp;
#pragma unroll
        for (int o = 1; o < 64; o <<= 1) { const float t = __shfl_up(G, o); if (lane >= o) G += t; }
        const float G63 = __shfl(G, 63);
        GS[wid * 128 + lane] = G; GS[wid * 128 + 64 + lane] = sigmoidf_(be);
        const int np = dir ? NC - 1 - n : n; const size_t cid = ((size_t)((seq * 2 + dir) * 8 + h)) * NC + np;
        float* EG = (float*)(p.ws + WS_EG) + cid * 128; EG[lane] = __expf(G); EG[64 + lane] = __expf(G63 - G);
    }
    __syncthreads();
    for (int e = tid; e < 16384; e += 512) { const int sv = e >> 12, hh = sv >> 1, dir = sv & 1, j = (e >> 6) & 63, i = e & 63; float a = 0.f;
        if (i > j) { const int ci = dir ? 63 - i : i, cj = dir ? 63 - j : j; a = GS[sv * 128 + 64 + i] * KK[hh * 4160 + ci * 65 + cj] * __expf(GS[sv * 128 + i] - GS[sv * 128 + j]); }
        AA[(sv * 64 + j) * 68 + i] = a; }
    __syncthreads();
    if (wid < 4) {
        const int sv = wid, hh = sv >> 1, dir = sv & 1, h = hp * 2 + hh; const LAS float* Ad = AA + sv * 64 * 68;
        float acc[64];
#pragma unroll
        for (int i = 0; i < 64; ++i) acc[i] = (lane == i) ? 1.f : 0.f;
#pragma unroll
        for (int j = 0; j < 63; ++j) { const float tj = acc[j];
#pragma unroll
            for (int i4 = ((j + 1) & ~3); i4 < 64; i4 += 4) { const f32x4 a = *(const LAS f32x4*)(Ad + j * 68 + i4);
#pragma unroll
                for (int e = 0; e < 4; ++e) if (i4 + e > j) acc[i4 + e] -= a[e] * tj; } }
        const int np = dir ? NC - 1 - n : n; const size_t cid = ((size_t)((seq * 2 + dir) * 8 + h)) * NC + np;
        bf16_t* Tg = (bf16_t*)(p.ws + WS_TP) + cid * 8192; const float bl = GS[sv * 128 + 64 + lane];
#pragma unroll
        for (int i = 0; i < 64; ++i) Tg[i * 64 + lane] = f2bf(acc[i] * bl);
    } else {
        bf16_t* TPg = (bf16_t*)(p.ws + WS_TP);
        for (int t = tid - 256; t < 2048; t += 256) { const int sv = t >> 9, hh = sv >> 1, dir = sv & 1, h = hp * 2 + hh, i = (t >> 3) & 63, j0 = (t & 7) * 8;
            const int np = dir ? NC - 1 - n : n; const size_t cid = ((size_t)((seq * 2 + dir) * 8 + h)) * NC + np;
            float v[8]; const int ci = dir ? 63 - i : i; const float Gi = GS[sv * 128 + i];
#pragma unroll
            for (int e = 0; e < 8; ++e) { const int j = j0 + e, cj = dir ? 63 - j : j; v[e] = (i >= j) ? QK[hh * 4160 + ci * 65 + cj] * __expf(Gi - GS[sv * 128 + j]) : 0.f; }
            u32x4 w; w.x = pk2(v[0], v[1]); w.y = pk2(v[2], v[3]); w.z = pk2(v[4], v[5]); w.w = pk2(v[6], v[7]);
            *(u32x4*)(TPg + cid * 8192 + 4096 + i * 64 + j0) = w; }
    }
    __syncthreads();
}

__device__ __forceinline__ bf16x8 pack8(const f32x4& a, const f32x4& b) { u32x4 w; w.x = pk2(a[0], a[1]); w.y = pk2(a[2], a[3]); w.z = pk2(b[0], b[1]); w.w = pk2(b[2], b[3]); return __builtin_bit_cast(bf16x8, w); }
__device__ __forceinline__ bf16x8 permfrag(const LAS bf16_t* base, int row, int stride, int kbase, int g) {
    const u32x2 lo = *(const LAS u32x2*)(base + row * stride + kbase + 4 * g), hi = *(const LAS u32x2*)(base + row * stride + kbase + 16 + 4 * g);
    u32x4 w; w.x = lo.x; w.y = lo.y; w.z = hi.x; w.w = hi.y; return __builtin_bit_cast(bf16x8, w);
}

__device__ __forceinline__ void scan_chain(const Params& p, const Batch& B, int chain, int vs, int lgVS, LAS unsigned char* L) {
    const int tid = ltid(), lane = tid & 63, wid = tid >> 6, g = lane >> 4, fr = lane & 15;
    const int NC = B.L >> 6;
    const int h = chain & 7, dir = (chain >> 3) & 1, seq = chain >> 4;
    LAS bf16_t* KS = (LAS bf16_t*)L;
    LAS bf16_t* KT = (LAS bf16_t*)(L + 124416);
    LAS bf16_t* QS = (LAS bf16_t*)(L + 35840);
    LAS bf16_t* VS = (LAS bf16_t*)(L + 53248);
    LAS bf16_t* TS = (LAS bf16_t*)(L + 70656);
    LAS bf16_t* PS = (LAS bf16_t*)(L + 79872);
    LAS float* EGS = (LAS float*)(L + 89088);
    LAS bf16_t* OS = (LAS bf16_t*)(L + 89600);
    const bf16_t* QKVD = (const bf16_t*)(p.ws + WS_QKVD);
    const bf16_t* TPg = (const bf16_t*)(p.ws + WS_TP);
    const float* EGg = (const float*)(p.ws + WS_EG);
    bf16_t* OD = (bf16_t*)(p.ws + WS_OD) + (size_t)dir * TB * 1024;
    const size_t cid0 = ((size_t)((seq * 2 + dir) * 8 + h)) * NC;
    const int cp = tid >> 3, pc = tid & 7;
    u32x4 rq0, rq1, rk0, rk1, rv0, rv1, rt, rp; float reg_eg = 0.f;
#define SC_LOAD(np_) do { const int tok_ = dir ? (B.L - 1 - ((np_) * 64 + cp)) : ((np_) * 64 + cp); const bf16_t* src_ = QKVD + (size_t)(seq * B.L + tok_) * 3072 + h * 128 + 16 * pc; \
        rq0 = *(const u32x4*)src_; rq1 = *(const u32x4*)(src_ + 8); rk0 = *(const u32x4*)(src_ + 1024); rk1 = *(const u32x4*)(src_ + 1032); rv0 = *(const u32x4*)(src_ + 2048); rv1 = *(const u32x4*)(src_ + 2056); \
        const bf16_t* tp_ = TPg + (cid0 + (np_)) * 8192 + cp * 64 + 8 * pc; rt = *(const u32x4*)tp_; rp = *(const u32x4*)(tp_ + 4096); \
        if (tid < 128) reg_eg = EGg[(cid0 + (np_)) * 128 + tid]; } while (0)
    if (__builtin_amdgcn_readfirstlane(wid) < (8 >> lgVS)) {
    f32x4 S[8];
#pragma unroll
    for (int i = 0; i < 8; ++i) S[i] = (f32x4){0.f, 0.f, 0.f, 0.f};
    SC_LOAD(0);
    for (int np = 0; np < NC; ++np) {
        *(LAS u32x4*)(QS + cp * 136 + 16 * pc) = rq0; *(LAS u32x4*)(QS + cp * 136 + 16 * pc + 8) = rq1;
        *(LAS u32x4*)(KS + cp * 136 + 16 * pc) = rk0; *(LAS u32x4*)(KS + cp * 136 + 16 * pc + 8) = rk1;
        *(LAS u32x4*)(VS + cp * 136 + 16 * pc) = rv0; *(LAS u32x4*)(VS + cp * 136 + 16 * pc + 8) = rv1;
        *(LAS u32x4*)(TS + cp * 72 + 8 * pc) = rt; *(LAS u32x4*)(PS + cp * 72 + 8 * pc) = rp;
#pragma unroll
        for (int e = 0; e < 8; ++e) { const unsigned w0 = rk0[e >> 1], w1 = rk1[e >> 1];
            KT[(17 * pc + e) * 72 + cp] = (bf16_t)((e & 1) ? (w0 >> 16) : (w0 & 0xffffu));
            KT[(17 * pc + 8 + e) * 72 + cp] = (bf16_t)((e & 1) ? (w1 >> 16) : (w1 & 0xffffu)); }
        if (tid < 128) EGS[tid] = reg_eg;
        __syncthreads();
        if (np + 1 < NC) SC_LOAD(np + 1);
        if (np > 0 && (pc >> (3 - lgVS)) == vs) { const LAS bf16_t* os = OS + ((np - 1) & 1) * 8704 + cp * 136 + 16 * pc; const u32x4 o0 = *(const LAS u32x4*)os, o1 = *(const LAS u32x4*)(os + 8);
            const int c_ = (np - 1) * 64 + cp; const int tok_ = dir ? (B.L - 1 - c_) : c_; bf16_t* dst = OD + (size_t)(seq * B.L + tok_) * 1024 + h * 128 + 16 * pc;
            *(u32x4*)dst = o0; *(u32x4*)(dst + 8) = o1; }
        const int vcol = vs * (128 >> lgVS) + 16 * wid;
#define SCHED_FENCE() __builtin_amdgcn_sched_barrier(0)
        bf16x8 Sb[4];
#pragma unroll
        for (int ks = 0; ks < 4; ++ks) Sb[ks] = pack8(S[2 * ks], S[2 * ks + 1]);
        f32x4 X[4], Q[4];
#pragma unroll
        for (int ct = 0; ct < 4; ++ct) { X[ct] = (f32x4){0.f, 0.f, 0.f, 0.f}; Q[ct] = (f32x4){0.f, 0.f, 0.f, 0.f}; }
        bf16x8 fk[2][4], fq[2][4], ft[2][4];
#pragma unroll
        for (int ct = 0; ct < 4; ++ct) { fk[0][ct] = permfrag(KS, 16 * ct + fr, 136, 0, g); fq[0][ct] = permfrag(QS, 16 * ct + fr, 136, 0, g); }
        SCHED_FENCE();
#pragma unroll
        for (int ks = 0; ks < 4; ++ks) {
            if (ks < 3) {
#pragma unroll
                for (int ct = 0; ct < 4; ++ct) { fk[(ks + 1) & 1][ct] = permfrag(KS, 16 * ct + fr, 136, 32 * (ks + 1), g); fq[(ks + 1) & 1][ct] = permfrag(QS, 16 * ct + fr, 136, 32 * (ks + 1), g); }
            } else {
#pragma unroll
                for (int ct = 0; ct < 4; ++ct) { ft[0][ct] = permfrag(TS, 16 * ct + fr, 72, 0, g); ft[1][ct] = permfrag(TS, 16 * ct + fr, 72, 32, g); }
            }
            SCHED_FENCE();
#pragma unroll
            for (int ct = 0; ct < 4; ++ct) { X[ct] = MFMA16(fk[ks & 1][ct], Sb[ks], X[ct]); Q[ct] = MFMA16(fq[ks & 1][ct], Sb[ks], Q[ct]); }
            SCHED_FENCE();
        }
        f32x4 EGv[4], R[4];
#pragma unroll
        for (int ct = 0; ct < 4; ++ct) { EGv[ct] = *(const LAS f32x4*)(EGS + 16 * ct + 4 * g);
#pragma unroll
            for (int j = 0; j < 4; ++j) { const unsigned w = *(const LAS unsigned*)(VS + (16 * ct + 4 * g + j) * 136 + vcol + (fr & ~1)); R[ct][j] = (fr & 1) ? bfhi(w) : bflo(w); } }
        bf16x8 fp[2][4];
#pragma unroll
        for (int ct = 0; ct < 4; ++ct) { fp[0][ct] = permfrag(PS, 16 * ct + fr, 72, 0, g); fp[1][ct] = permfrag(PS, 16 * ct + fr, 72, 32, g); }
        SCHED_FENCE();
#pragma unroll
        for (int ct = 0; ct < 4; ++ct) R[ct] = R[ct] - EGv[ct] * X[ct];
        bf16x8 Rb[2]; Rb[0] = pack8(R[0], R[1]); Rb[1] = pack8(R[2], R[3]);
        f32x4 Vn[4];
#pragma unroll
        for (int ct = 0; ct < 4; ++ct) Vn[ct] = (f32x4){0.f, 0.f, 0.f, 0.f};
#pragma unroll
        for (int k2 = 0; k2 < 2; ++k2)
#pragma unroll
            for (int ct = 0; ct < 4; ++ct) Vn[ct] = MFMA16(ft[k2][ct], Rb[k2], Vn[ct]);
        bf16x8 fkt[2][8];
#pragma unroll
        for (int i = 0; i < 8; ++i) fkt[0][i] = permfrag(KT, 17 * i + fr, 72, 0, g);
        SCHED_FENCE();
        bf16x8 Vb[2]; Vb[0] = pack8(Vn[0], Vn[1]); Vb[1] = pack8(Vn[2], Vn[3]);
        f32x4 O[4];
#pragma unroll
        for (int ct = 0; ct < 4; ++ct) O[ct] = EGv[ct] * Q[ct];
#pragma unroll
        for (int k2 = 0; k2 < 2; ++k2)
#pragma unroll
            for (int ct = 0; ct < 4; ++ct) O[ct] = MFMA16(fp[k2][ct], Vb[k2], O[ct]);
#pragma unroll
        for (int i = 0; i < 8; ++i) fkt[1][i] = permfrag(KT, 17 * i + fr, 72, 32, g);
        SCHED_FENCE();
#pragma unroll
        for (int ct = 0; ct < 4; ++ct) { const f32x4 egd = *(const LAS f32x4*)(EGS + 64 + 16 * ct + 4 * g); Vn[ct] = Vn[ct] * egd; }
        Vb[0] = pack8(Vn[0], Vn[1]); Vb[1] = pack8(Vn[2], Vn[3]);
        const float egl = EGS[63];
#pragma unroll
        for (int i = 0; i < 8; ++i) S[i] = S[i] * egl;
#pragma unroll
        for (int k2 = 0; k2 < 2; ++k2)
#pragma unroll
            for (int i = 0; i < 8; ++i) S[i] = MFMA16(fkt[k2][i], Vb[k2], S[i]);
#pragma unroll
        for (int ct = 0; ct < 4; ++ct)
#pragma unroll
            for (int j = 0; j < 4; ++j) OS[(np & 1) * 8704 + (16 * ct + 4 * g + j) * 136 + vcol + fr] = f2bf(O[ct][j]);
#undef SCHED_FENCE
        __syncthreads();
    }
    } else {
    SC_LOAD(0);
    for (int np = 0; np < NC; ++np) {
        *(LAS u32x4*)(QS + cp * 136 + 16 * pc) = rq0; *(LAS u32x4*)(QS + cp * 136 + 16 * pc + 8) = rq1;
        *(LAS u32x4*)(KS + cp * 136 + 16 * pc) = rk0; *(LAS u32x4*)(KS + cp * 136 + 16 * pc + 8) = rk1;
        *(LAS u32x4*)(VS + cp * 136 + 16 * pc) = rv0; *(LAS u32x4*)(VS + cp * 136 + 16 * pc + 8) = rv1;
        *(LAS u32x4*)(TS + cp * 72 + 8 * pc) = rt; *(LAS u32x4*)(PS + cp * 72 + 8 * pc) = rp;
#pragma unroll
        for (int e = 0; e < 8; ++e) { const unsigned w0 = rk0[e >> 1], w1 = rk1[e >> 1];
            KT[(17 * pc + e) * 72 + cp] = (bf16_t)((e & 1) ? (w0 >> 16) : (w0 & 0xffffu));
            KT[(17 * pc + 8 + e) * 72 + cp] = (bf16_t)((e & 1) ? (w1 >> 16) : (w1 & 0xffffu)); }
        if (tid < 128) EGS[tid] = reg_eg;
        __syncthreads();
        if (np + 1 < NC) SC_LOAD(np + 1);
        if (np > 0 && (pc >> (3 - lgVS)) == vs) { const LAS bf16_t* os = OS + ((np - 1) & 1) * 8704 + cp * 136 + 16 * pc; const u32x4 o0 = *(const LAS u32x4*)os, o1 = *(const LAS u32x4*)(os + 8);
            const int c_ = (np - 1) * 64 + cp; const int tok_ = dir ? (B.L - 1 - c_) : c_; bf16_t* dst = OD + (size_t)(seq * B.L + tok_) * 1024 + h * 128 + 16 * pc;
            *(u32x4*)dst = o0; *(u32x4*)(dst + 8) = o1; }
        __syncthreads();
    }
    }
    if ((pc >> (3 - lgVS)) == vs) { const LAS bf16_t* os = OS + ((NC - 1) & 1) * 8704 + cp * 136 + 16 * pc; const u32x4 o0 = *(const LAS u32x4*)os, o1 = *(const LAS u32x4*)(os + 8);
      const int c_ = (NC - 1) * 64 + cp; const int tok_ = dir ? (B.L - 1 - c_) : c_; bf16_t* dst = OD + (size_t)(seq * B.L + tok_) * 1024 + h * 128 + 16 * pc;
      *(u32x4*)dst = o0; *(u32x4*)(dst + 8) = o1; }
    __syncthreads();
#undef SC_LOAD
}

__device__ __forceinline__ void attn_item(const Params& p, const Batch& B, int item, LAS unsigned char* L) {
    const int tid = ltid(), lane = tid & 63, wid = tid >> 6, g = lane >> 4, fr = lane & 15;
    const int lgper = B.lgL - 7;
    const int x = item & ((1 << lgper) - 1), sgh = item >> lgper, h = sgh & 7, sg = sgh >> 3, grp = sg % 3, seq = sg / 3;
    const int lgd = 2 * grp, r = x & ((1 << lgd) - 1), pb = x >> lgd, Lr = B.L >> lgd;
    const int mq0 = pb * 128, mk0 = mq0 - 64, hcol = (grp * 8 + h) * 64;
    LAS bf16_t* KL = (LAS bf16_t*)L;
    LAS bf16_t* VT = (LAS bf16_t*)(L + 36864);
    bf16_t* PROJ = (bf16_t*)(p.ws + WS_PROJ);
    const f32x2* ROPE = (const f32x2*)(p.ws + WS_ROPE);
    const size_t rowbase = (size_t)seq * B.L;
    const u32x4 z4 = {0u, 0u, 0u, 0u};
    const int mq = mq0 + 16 * wid + fr, sq = (mq << lgd) + r;
    bf16_t* qptr = PROJ + (rowbase + sq) * NPROJ + C_QA + hcol;
    const u32x4 qa = *(const u32x4*)(qptr + 8 * g), qb = *(const u32x4*)(qptr + 32 + 8 * g);
    f32x4 qcs[4];
    { const f32x4* rp = (const f32x4*)(ROPE + (size_t)sq * 32 + 8 * g);
#pragma unroll
      for (int q = 0; q < 4; ++q) qcs[q] = rp[q]; }
    u32x4 ka[2], kb[2]; f32x4 kcs[2][4]; u32x4 va[4];
#pragma unroll
    for (int i = 0; i < 2; ++i) { const int t = tid + 512 * i, kk = t >> 2, pp = t & 3, m = mk0 + kk; ka[i] = z4; kb[i] = z4;
#pragma unroll
        for (int q = 0; q < 4; ++q) kcs[i][q] = (f32x4){0.f, 0.f, 0.f, 0.f};
        if (m >= 0 && m < Lr) { const int s = (m << lgd) + r; const bf16_t* src = PROJ + (rowbase + s) * NPROJ + C_KA + hcol + 8 * pp;
            ka[i] = *(const u32x4*)src; kb[i] = *(const u32x4*)(src + 32); const f32x4* rp = (const f32x4*)(ROPE + (size_t)s * 32 + 8 * pp);
#pragma unroll
            for (int q = 0; q < 4; ++q) kcs[i][q] = rp[q]; } }
#pragma unroll
    for (int i = 0; i < 4; ++i) { const int kk = tid & 255, p8 = (tid >> 8) + 2 * i, m = mk0 + kk; va[i] = z4;
        if (m >= 0 && m < Lr) { const int s = (m << lgd) + r; va[i] = *(const u32x4*)(PROJ + (rowbase + s) * NPROJ + C_VA + hcol + 8 * p8); } }
#pragma unroll
    for (int i = 0; i < 2; ++i) { const int t = tid + 512 * i, kk = t >> 2, pp = t & 3; u32x4 lo, hi;
#pragma unroll
        for (int q = 0; q < 4; ++q) { const f32x4 cs = kcs[i][q]; const float x1a = bflo(ka[i][q]), x1b = bfhi(ka[i][q]), x2a = bflo(kb[i][q]), x2b = bfhi(kb[i][q]);
            lo[q] = pk2(x1a * cs[0] - x2a * cs[1], x1b * cs[2] - x2b * cs[3]); hi[q] = pk2(x2a * cs[0] + x1a * cs[1], x2b * cs[2] + x1b * cs[3]); }
        *(LAS u32x4*)(KL + kk * 72 + 8 * pp) = lo; *(LAS u32x4*)(KL + kk * 72 + 32 + 8 * pp) = hi; }
#pragma unroll
    for (int i = 0; i < 4; ++i) { const int kk = tid & 255, p8 = (tid >> 8) + 2 * i;
#pragma unroll
        for (int e = 0; e < 8; ++e) { const unsigned w = va[i][e >> 1]; VT[(8 * p8 + e) * 264 + kk] = (bf16_t)((e & 1) ? (w >> 16) : (w & 0xffffu)); } }
    __syncthreads();
    {
        u32x4 lo, hi;
#pragma unroll
        for (int q = 0; q < 4; ++q) { const f32x4 cs = qcs[q] * 0.125f; const float x1a = bflo(qa[q]), x1b = bfhi(qa[q]), x2a = bflo(qb[q]), x2b = bfhi(qb[q]);
            lo[q] = pk2(x1a * cs[0] - x2a * cs[1], x1b * cs[2] - x2b * cs[3]); hi[q] = pk2(x2a * cs[0] + x1a * cs[1], x2b * cs[2] + x1b * cs[3]); }
        bf16x8 qf[2]; qf[0] = __builtin_bit_cast(bf16x8, lo); qf[1] = __builtin_bit_cast(bf16x8, hi);
        f32x4 st[9]; float mx = -3.0e38f;
#pragma unroll
        for (int t = 0; t < 9; ++t) { f32x4 acc = {0.f, 0.f, 0.f, 0.f};
#pragma unroll
            for (int ks = 0; ks < 2; ++ks) acc = MFMA16(*(const LAS bf16x8*)(KL + (16 * (wid + t) + fr) * 72 + 32 * ks + 8 * g), qf[ks], acc);
#pragma unroll
            for (int j = 0; j < 4; ++j) { const int m = mk0 + 16 * (wid + t) + 4 * g + j; const int dq = mq - m; const bool ok = (dq <= 64) && (dq >= -64) && (m >= 0) && (m < Lr);
                acc[j] = ok ? acc[j] : -1.0e30f; mx = fmaxf(mx, acc[j]); }
            st[t] = acc; }
        mx = fmaxf(mx, __shfl_xor(mx, 16)); mx = fmaxf(mx, __shfl_xor(mx, 32));
        float den = 0.f;
#pragma unroll
        for (int t = 0; t < 9; ++t)
#pragma unroll
            for (int j = 0; j < 4; ++j) { const float e = __expf(st[t][j] - mx); st[t][j] = e; den += e; }
        den += __shfl_xor(den, 16); den += __shfl_xor(den, 32);
        bf16x8 pbf[5];
#pragma unroll
        for (int ks = 0; ks < 4; ++ks) pbf[ks] = pack8(st[2 * ks], st[2 * ks + 1]);
        pbf[4] = pack8(st[8], (f32x4){0.f, 0.f, 0.f, 0.f});
        const float rden = 1.0f / den;
#pragma unroll
        for (int dt = 0; dt < 4; ++dt) { f32x4 o = {0.f, 0.f, 0.f, 0.f};
#pragma unroll
            for (int ks = 0; ks < 5; ++ks) { const LAS bf16_t* vp = VT + (16 * dt + fr) * 264 + 16 * (wid + 2 * ks) + 4 * g;
                const u32x2 vl = *(const LAS u32x2*)vp; u32x2 vh = {0u, 0u}; if (ks < 4) vh = *(const LAS u32x2*)(vp + 16);
                u32x4 w; w.x = vl.x; w.y = vl.y; w.z = vh.x; w.w = vh.y; o = MFMA16(__builtin_bit_cast(bf16x8, w), pbf[ks], o); }
            u32x2 ow; ow.x = pk2(o[0] * rden, o[1] * rden); ow.y = pk2(o[2] * rden, o[3] * rden);
            *(u32x2*)((bf16_t*)B.out + (rowbase + sq) * 1536 + hcol + 16 * dt + 4 * g) = ow; }
        if (g == 0) ((float*)(p.ws + WS_LSE))[(rowbase + sq) * 24 + grp * 8 + h] = mx + __logf(den);
    }
    __syncthreads();
}

__device__ __forceinline__ void post_mixer(const Params& p, const Batch& B) {
    const int lane = ltid() & 63, gw = blockIdx.x * 8 + (ltid() >> 6), NGW = gridDim.x * 8;
    const bf16_t* PROJ = (const bf16_t*)(p.ws + WS_PROJ); const float* LSE = (const float*)(p.ws + WS_LSE);
    const bf16_t* OD0 = (const bf16_t*)(p.ws + WS_OD); const bf16_t* OD1 = OD0 + (size_t)TB * 1024;
    bf16_t* YAD = (bf16_t*)(p.ws + WS_QKVD);
    float dg[16];
#pragma unroll
    for (int e = 0; e < 16; ++e) dg[e] = p.dn_norm_g[(16 * lane + e) & 127];
    const int hh = lane >> 3;
    for (int r0 = gw; r0 < TB; r0 += 2 * NGW) {
        float l0[2], l1[2], l2[2]; u32x4 a[2], b[2], c[2], a0[2], a1[2], b0[2], b1[2], z0[2], z1[2];
#pragma unroll
        for (int u = 0; u < 2; ++u) { const int r = r0 + u * NGW;
            l0[u] = LSE[(size_t)r * 24 + hh]; l1[u] = LSE[(size_t)r * 24 + 8 + hh]; l2[u] = LSE[(size_t)r * 24 + 16 + hh];
            const bf16_t* src = (const bf16_t*)B.out + (size_t)r * 1536 + 8 * lane;
            a[u] = *(const u32x4*)src; b[u] = *(const u32x4*)(src + 512); c[u] = *(const u32x4*)(src + 1024);
            const bf16_t* s0 = OD0 + (size_t)r * 1024 + 16 * lane; const bf16_t* s1 = OD1 + (size_t)r * 1024 + 16 * lane; const bf16_t* zp = PROJ + (size_t)r * NPROJ + C_ZD + 16 * lane;
            a0[u] = *(const u32x4*)s0; a1[u] = *(const u32x4*)(s0 + 8); b0[u] = *(const u32x4*)s1; b1[u] = *(const u32x4*)(s1 + 8); z0[u] = *(const u32x4*)zp; z1[u] = *(const u32x4*)(zp + 8); }
#pragma unroll
        for (int u = 0; u < 2; ++u) { const int r = r0 + u * NGW;
            { const float mx = fmaxf(l0[u], fmaxf(l1[u], l2[u])); float w0 = __expf(l0[u] - mx), w1 = __expf(l1[u] - mx), w2 = __expf(l2[u] - mx); const float inv = 1.0f / (w0 + w1 + w2); w0 *= inv; w1 *= inv; w2 *= inv;
              u32x4 o;
#pragma unroll
              for (int q = 0; q < 4; ++q) o[q] = pk2(w0 * bflo(a[u][q]) + w1 * bflo(b[u][q]) + w2 * bflo(c[u][q]), w0 * bfhi(a[u][q]) + w1 * bfhi(b[u][q]) + w2 * bfhi(c[u][q]));
              *(u32x4*)(YAD + (size_t)r * 1536 + 8 * lane) = o; }
            { float v[16]; float ss = 0.f;
#pragma unroll
              for (int e = 0; e < 16; ++e) { v[e] = bf_el(a0[u], a1[u], e) + bf_el(b0[u], b1[u], e); ss += v[e] * v[e]; }
              ss += __shfl_xor(ss, 1); ss += __shfl_xor(ss, 2); ss += __shfl_xor(ss, 4);
              const float rs = rsqrtf(ss * (1.0f / 128.0f) + EPSF);
#pragma unroll
              for (int e = 0; e < 16; ++e) v[e] = v[e] * rs * dg[e] * siluf_(bf_el(z0[u], z1[u], e));
              u32x4 o0, o1; o0.x = pk2(v[0], v[1]); o0.y = pk2(v[2], v[3]); o0.z = pk2(v[4], v[5]); o0.w = pk2(v[6], v[7]);
              o1.x = pk2(v[8], v[9]); o1.y = pk2(v[10], v[11]); o1.z = pk2(v[12], v[13]); o1.w = pk2(v[14], v[15]);
              *(u32x4*)(YAD + (size_t)r * 1536 + 512 + 16 * lane) = o0; *(u32x4*)(YAD + (size_t)r * 1536 + 512 + 16 * lane + 8) = o1; }
        }
    }
}

__device__ __forceinline__ void conv_act(const Params& p, const Batch& B) {
    const bf16_t* UP = (const bf16_t*)(p.ws + WS_PROJ); bf16_t* ACT = (bf16_t*)(p.ws + WS_PROJ + (size_t)TB * NUP * 2);
    const u32x4 z4 = {0u, 0u, 0u, 0u};
    constexpr int RB = 16;
    for (int t = blockIdx.x * 512 + ltid(); t < (TB / RB) * 352; t += gridDim.x * 512) {
        const int rb = t / 352, cg8 = (t - rb * 352) * 8, row0 = rb * RB; const int s0 = row0 & (B.L - 1);
        f32x4 wv[3][2], wg[3][2], bv[2], bg[2];
#pragma unroll
        for (int q = 0; q < 2; ++q) {
#pragma unroll
            for (int j = 0; j < 3; ++j) { wv[j][q] = *(const f32x4*)(p.ffn_conv_w + j * NUP + cg8 + 4 * q); wg[j][q] = *(const f32x4*)(p.ffn_conv_w + j * NUP + DFF + cg8 + 4 * q); }
            bv[q] = *(const f32x4*)(p.ffn_conv_b + cg8 + 4 * q); bg[q] = *(const f32x4*)(p.ffn_conv_b + DFF + cg8 + 4 * q); }
        const bf16_t* src = UP + (size_t)row0 * NUP + cg8;
        u32x4 vp = z4, gp = z4, vc, gc, vn, gn;
        if (s0 > 0) { vp = *(const u32x4*)(src - NUP); gp = *(const u32x4*)(src - NUP + DFF); }
        vc = *(const u32x4*)src; gc = *(const u32x4*)(src + DFF);
#pragma unroll
        for (int i = 0; i < RB; ++i) {
            vn = z4; gn = z4;
            if (i < RB - 1 || s0 + RB < B.L) { vn = *(const u32x4*)(src + (size_t)(i + 1) * NUP); gn = *(const u32x4*)(src + (size_t)(i + 1) * NUP + DFF); }
            float o[8];
#pragma unroll
            for (int e = 0; e < 8; ++e) { const int q = e >> 2, k = e & 3;
                const float val = bf_el(vp, z4, e) * wv[0][q][k] + bf_el(vc, z4, e) * wv[1][q][k] + bf_el(vn, z4, e) * wv[2][q][k] + bv[q][k];
                const float gt = bf_el(gp, z4, e) * wg[0][q][k] + bf_el(gc, z4, e) * wg[1][q][k] + bf_el(gn, z4, e) * wg[2][q][k] + bg[q][k];
                o[e] = siluf_(gt) * val; }
            u32x4 w; w.x = pk2(o[0], o[1]); w.y = pk2(o[2], o[3]); w.z = pk2(o[4], o[5]); w.w = pk2(o[6], o[7]);
            *(u32x4*)(ACT + (size_t)(row0 + i) * DFF + cg8) = w;
            vp = vc; gp = gc; vc = vn; gc = gn;
        }
    }
}

#ifndef EN_P0
#define EN_P0 1
#endif
#ifndef EN_PREP
#define EN_PREP 1
#endif
#ifndef EN_SCAN
#define EN_SCAN 1
#endif
#ifndef EN_ATT
#define EN_ATT 1
#endif
#ifndef EN_POST
#define EN_POST 1
#endif
#ifndef EN_CONV
#define EN_CONV 1
#endif
#ifndef EN_G1
#define EN_G1 1
#endif
#ifndef EN_G2
#define EN_G2 1
#endif
#ifndef EN_G3
#define EN_G3 1
#endif
#ifndef EN_G4
#define EN_G4 1
#endif
#ifndef EN_G5
#define EN_G5 1
#endif
#ifndef PROBE_POS
#define PROBE_POS -100
#endif
#ifndef REP_ATT
#define REP_ATT 1
#endif
#ifndef REP_P0
#define REP_P0 1
#endif
#ifndef REP_P3
#define REP_P3 1
#endif
#ifndef REP_SCAN
#define REP_SCAN 1
#endif
#ifndef REP_P5
#define REP_P5 1
#endif
#ifndef REP_P11
#define REP_P11 1
#endif
#ifndef REP_G1
#define REP_G1 1
#endif
#ifndef REP_G4
#define REP_G4 1
#endif
#ifndef REP_P9
#define REP_P9 1
#endif
#ifndef REP_SYNC
#define REP_SYNC 1
#endif
#define XB_TMO      128
#define XB_XCNT(j)  (256  + 64 * (j))
#define XB_XSUB(j)  (1280 + 64 * (j))
#define XB_XGEN(j)  (2304 + 64 * (j))
#define XB_TOP      3328
#define XB_TOPGEN   3392
#define XCD_BAR_WORDS 3456
#define XB_SPIN_CAP (1u << 18)

__device__ __forceinline__ unsigned xb_ld(unsigned* p)              { return __hip_atomic_load(p, __ATOMIC_RELAXED, __HIP_MEMORY_SCOPE_AGENT); }
__device__ __forceinline__ unsigned xb_add(unsigned* p, unsigned v) { return __hip_atomic_fetch_add(p, v, __ATOMIC_RELAXED, __HIP_MEMORY_SCOPE_AGENT); }
__device__ __forceinline__ unsigned xb_xcc_id() { return (unsigned)__builtin_amdgcn_s_getreg((3 << 11) | 20) & 0xFu; }
#define XB_SPIN(cond, bar) do { unsigned _sp = 0; while (cond) { __builtin_amdgcn_s_sleep(1); \
    if ((++_sp & 255u) == 0u) { if (xb_ld(&(bar)[XB_TMO])) break; if (_sp > XB_SPIN_CAP) { atomicAdd(&(bar)[XB_TMO], 1u); break; } } } } while (0)

struct XcdBarrier {
    unsigned* bar; unsigned x;
    volatile LAS unsigned* st;
};

__device__ __forceinline__ XcdBarrier xcd_barrier_post(unsigned* bar, volatile LAS unsigned* st) {
    XcdBarrier b; b.bar = bar; b.x = xb_xcc_id(); b.st = st;
    if (threadIdx.x == 0) (void)xb_add(&bar[XB_XCNT(b.x)], 1u);
    return b;
}
__device__ __forceinline__ void xcd_barrier_complete(unsigned* bar, unsigned x, unsigned& nloc, unsigned& nx) {
    const unsigned G = gridDim.x * gridDim.y * gridDim.z;
    unsigned sum, cnt, mine, sp = 0u;
    for (;;) {
        sum = 0u; cnt = 0u; mine = 0u;
#pragma unroll
        for (unsigned j = 0; j < 16; ++j) { const unsigned c = xb_ld(&bar[XB_XCNT(j)]); sum += c; cnt += (c > 0u) ? 1u : 0u; mine = (j == x) ? c : mine; }
        if (sum == G) break;
        __builtin_amdgcn_s_sleep(1);
        if ((++sp & 255u) == 0u) { if (xb_ld(&bar[XB_TMO])) break; if (sp > XB_SPIN_CAP) { atomicAdd(&bar[XB_TMO], 1u); break; } }
    }
    nloc = mine > 0u ? mine : 1u; nx = cnt > 0u ? cnt : 1u;
}

__device__ __forceinline__ void xcd_barrier(const XcdBarrier& b) {
    asm volatile("s_waitcnt vmcnt(0)" ::: "memory");
    __syncthreads();
    if (threadIdx.x == 0) {
        unsigned* bar = b.bar;
        __builtin_amdgcn_s_waitcnt(0);
        unsigned nloc = b.st[0], nx = b.st[1];
        if (nloc == 0u) { xcd_barrier_complete(bar, b.x, nloc, nx); b.st[0] = nloc; b.st[1] = nx; }
        const unsigned old = xb_add(&bar[XB_XSUB(b.x)], 1u);
        const unsigned gen = old / nloc;
        if (old + 1u == (gen + 1u) * nloc) {
            __builtin_amdgcn_fence(__ATOMIC_RELEASE, "agent");
            asm volatile("s_waitcnt vmcnt(0)" ::: "memory");
            const unsigned og = xb_add(&bar[XB_TOP], 1u);
            const unsigned tg = og / nx;
            if (og + 1u == (tg + 1u) * nx) xb_add(&bar[XB_TOPGEN], 1u);
            else XB_SPIN(xb_ld(&bar[XB_TOPGEN]) == tg, bar);
            __builtin_amdgcn_fence(__ATOMIC_ACQUIRE, "agent");
            xb_add(&bar[XB_XGEN(b.x)], 1u);
            asm volatile("s_waitcnt vmcnt(0)" ::: "memory");
        } else {
            XB_SPIN(xb_ld(&bar[XB_XGEN(b.x)]) == gen, bar);
            __builtin_amdgcn_fence(__ATOMIC_ACQUIRE, "agent");
            asm volatile("s_waitcnt vmcnt(0)" ::: "memory");
        }
    }
    __syncthreads();
}


__device__ __forceinline__ void grid_bar(unsigned* ctr, unsigned target) {
    asm volatile("s_waitcnt vmcnt(0) lgkmcnt(0)" ::: "memory");
    __syncthreads();
    if (threadIdx.x == 0) {
        __builtin_amdgcn_fence(__ATOMIC_RELEASE, "agent");
        asm volatile("s_waitcnt vmcnt(0)" ::: "memory");
        __hip_atomic_fetch_add(ctr, 1u, __ATOMIC_RELAXED, __HIP_MEMORY_SCOPE_AGENT);
        while (__hip_atomic_load(ctr, __ATOMIC_RELAXED, __HIP_MEMORY_SCOPE_AGENT) < target) __builtin_amdgcn_s_sleep(2);
        __builtin_amdgcn_fence(__ATOMIC_ACQUIRE, "agent");
        asm volatile("s_waitcnt vmcnt(0)" ::: "memory");
    }
    __syncthreads();
}
__global__ void __launch_bounds__(512) mega(Params p) {
    extern __shared__ __attribute__((aligned(16))) unsigned char lds_raw[];
    LAS unsigned char* L = (LAS unsigned char*)lds_raw;
    const int G = gridDim.x, bid = blockIdx.x, tid = ltid();
    int ph = 0;
#define PHASE_ON (ph >= p.ph_lo && ph < p.ph_hi)
#define SEAM() do { if (ph >= p.ph_lo && ph + 1 < p.ph_hi) { for (int rep_ = 0; rep_ < REP_SYNC; ++rep_) { xcd_barrier(xbar); } } PROBE_TICK(); ++ph; } while (0)
    unsigned nbar = 0;
#if PROBE_POS > -10
    unsigned long long t_prev = __builtin_amdgcn_s_memrealtime(), t_acc = 0;
#define PROBE_TICK() do { const unsigned long long t_now = __builtin_amdgcn_s_memrealtime(); const int pos_ = ph < 2 ? -1 - ph : (ph - 2) % 11; if (pos_ == PROBE_POS) t_acc += t_now - t_prev; t_prev = t_now; } while (0)
#else
#define PROBE_TICK() do {} while (0)
#endif
    unsigned* ctl = (unsigned*)(p.ws + WS_CTL);
    volatile LAS unsigned* xst = (volatile LAS unsigned*)(L + LDS_BYTES - 32);
    if (tid == 0) { xst[0] = 0u; xst[1] = 0u; }
    __syncthreads();
    XcdBarrier xbar = xcd_barrier_post(ctl + 1024, xst);
    float* MOD = (float*)(p.ws + WS_MOD);
    bf16_t* XN = (bf16_t*)(p.ws + WS_XN); bf16_t* PROJ = (bf16_t*)(p.ws + WS_PROJ);
    if (EN_P0 && PHASE_ON) for (int rep = 0; rep < REP_P0; ++rep) phase0(p, L);
    SEAM();
    if (PHASE_ON) { const Batch B0 = make_batch(p, 0); norm_mod_rows(p, B0, B0.x, p.norm1_g, 0, 1024, XN); }
    SEAM();
    for (int b = 0; b < 3; ++b) {
        const Batch B = make_batch(p, b);
        const int cbase = b == 0 ? 0 : 8 + (b - 1) * 4;
        if (EN_G1 && PHASE_ON) for (int rep = 0; rep < REP_G1; ++rep) { pg8::Gemm g{XN, (const bf16_t*)(p.ws + WS_WIN), TB, NPROJ, 1024}; pg8::StaticOrder S; S.init(TB, NPROJ, G, bid); EpiBf16S E{PROJ, NPROJ}; pg8::gemm_phase<EpiBf16S, pg8::StaticOrder>(L, g, S, E); }
        SEAM();
        if (EN_PREP && PHASE_ON) for (int rep = 0; rep < REP_P3; ++rep) { const int nit = (TB >> 6) * 4; for (int it = bid; it < nit; it += G) prep_item(p, B, it, L); }
        SEAM();
        if (PHASE_ON) {
            const int lgVS = b == 0 ? 0 : 1; const int nscan = (B.nseq * 16) << lgVS, natt = B.nseq * 24 * (B.L >> 7);
            LAS int* slot = (LAS int*)(L + LDS_BYTES - 16);
            for (;;) {
                if (tid == 0) *slot = (int)atomicAdd(ctl + 64 * b, 1u);
                __syncthreads();
                const int idx = *slot;
                __syncthreads();
                if (idx >= nscan + natt) break;
                if (idx < nscan) { if (EN_SCAN) for (int rep = 0; rep < REP_SCAN; ++rep) scan_chain(p, B, idx >> lgVS, idx & ((1 << lgVS) - 1), lgVS, L); } else { if (EN_ATT) for (int rep = 0; rep < REP_ATT; ++rep) attn_item(p, B, idx - nscan, L); }
            }
        }
        SEAM();
        if (EN_POST && PHASE_ON) for (int rep = 0; rep < REP_P5; ++rep) post_mixer(p, B);
        SEAM();
        if (EN_G2 && PHASE_ON) {
            bf16_t* MERGED = (bf16_t*)(p.ws + WS_QKVD + (size_t)TB * 1536 * 2);
            pg8::Gemm g{(const bf16_t*)(p.ws + WS_QKVD), (const bf16_t*)(p.ws + WS_WA), TB, 1024, 1536}; pg8::StaticOrder S; S.init(TB, 1024, G, bid); EpiMerge E{PROJ + C_GA, PROJ + C_GD, NPROJ, MERGED}; pg8::gemm_phase<EpiMerge, pg8::StaticOrder>(L, g, S, E);
        }
        SEAM();
        if (EN_G3 && PHASE_ON) { const bf16_t* MERGED = (const bf16_t*)(p.ws + WS_QKVD + (size_t)TB * 1536 * 2);
            pg8::Gemm g{MERGED, (const bf16_t*)(p.ws + WS_WO), TB, 1024, 1024}; pg8::StaticOrder S; S.init(TB, 1024, G, bid); EpiResid E{B.x, B.out, MOD + 2048, B.lgL, cbase}; pg8::gemm_phase<EpiResid, pg8::StaticOrder>(L, g, S, E); }
        SEAM();
        if (PHASE_ON) for (int rep = 0; rep < REP_P9; ++rep) norm_mod_rows(p, B, B.out, p.norm2_g, 3072, 4096, XN);
        SEAM();
        if (EN_G4 && PHASE_ON) {
            pg8::StaticOrder S; S.init(65 * 256, NUP, G, bid);
            for (int i = 0; ; ++i) { pg8::Unit u; if (!S.next(i, u)) break;
                const int rowstart = 254 * u.pm - 1;
                pg8::Gemm g{XN + (ptrdiff_t)rowstart * 1024, (const bf16_t*)(p.ws + WS_WUP), 256, NUP, 1024};
                OneUnit S1{pg8::Unit{0, u.pn}};
                EpiConvFfn E{(bf16_t*)(p.ws + WS_PROJ + (size_t)TB * NUP * 2), p.ffn_conv_w, p.ffn_conv_b, rowstart, B.L};
                pg8::gemm_phase<EpiConvFfn, OneUnit>(L, g, S1, E); }
        }
        SEAM();
        if (EN_G5 && PHASE_ON) { pg8::Gemm g{(const bf16_t*)(p.ws + WS_PROJ + (size_t)TB * NUP * 2), (const bf16_t*)(p.ws + WS_WDN), TB, 1024, DFF}; pg8::StaticOrder S; S.init(TB, 1024, G, bid);
            EpiResid E{B.out, B.out, MOD + 5120, B.lgL, cbase}; pg8::gemm_phase<EpiResid, pg8::StaticOrder>(L, g, S, E); }
        SEAM();
        if (PHASE_ON) { final_norm_rows(B.out, p.norm_f_g); if (b < 2) { const Batch Bn = make_batch(p, b + 1); norm_mod_rows(p, Bn, Bn.x, p.norm1_g, 0, 1024, XN); } }
        SEAM();
    }
#if PROBE_POS > -10
    if (bid == 0 && tid == 0) { const unsigned long long t0 = __builtin_amdgcn_s_memrealtime(); while (__builtin_amdgcn_s_memrealtime() - t0 < 4ull * t_acc) __builtin_amdgcn_s_sleep(8); }
#endif
}
constexpr int N_PHASES = 2 + 3 * 10;

#ifndef MULTI_LAUNCH
#define MULTI_LAUNCH 0
#endif
extern "C" void kernel_launch(void* const* d_in, const int* in_sizes, int n_in, void* d_out, int out_size, void* d_ws, size_t ws_size, hipStream_t stream) {
    static int grid = 0;
    if (grid == 0) {
        if (n_in != 21 || ws_size < WS_END) { fprintf(stderr, "kernel_launch: need 21 inputs and %zu bytes of workspace (got %d, %zu)\n", (size_t)WS_END, n_in, ws_size); grid = -1; return; }
        int dev = 0, cus = 0, per_cu = 0;
        hipGetDevice(&dev); hipDeviceGetAttribute(&cus, hipDeviceAttributeMultiprocessorCount, dev);
        if (hipFuncSetAttribute((const void*)mega, hipFuncAttributeMaxDynamicSharedMemorySize, LDS_BYTES) != hipSuccess) { fprintf(stderr, "kernel_launch: hipFuncSetAttribute failed\n"); grid = -1; return; }
        if (hipOccupancyMaxActiveBlocksPerMultiprocessor(&per_cu, (const void*)mega, 512, LDS_BYTES) != hipSuccess || per_cu < 1) { fprintf(stderr, "kernel_launch: occupancy query says %d blocks/CU\n", per_cu); grid = -1; return; }
        grid = cus;
    }
    if (grid < 0) return;
    hipMemsetAsync((char*)d_ws + WS_CTL, 0, 20480, stream);
    Params p{};
    const float** pp = (const float**)&p;
    for (int i = 0; i < 21; ++i) pp[i] = (const float*)d_in[i];
    p.out = (float*)d_out; p.ws = (unsigned char*)d_ws;
#if MULTI_LAUNCH
    for (int ph = 0; ph < N_PHASES; ++ph) { p.ph_lo = ph; p.ph_hi = ph + 1; hipLaunchKernelGGL(mega, dim3(grid), dim3(512), LDS_BYTES, stream, p); }
#else
    p.ph_lo = 0; p.ph_hi = N_PHASES;
    void* args[] = {&p};
    hipError_t e = hipLaunchCooperativeKernel((const void*)mega, dim3(grid), dim3(512), args, LDS_BYTES, stream);
    if (e != hipSuccess) fprintf(stderr, "cooperative launch failed: %s (grid %d)\n", hipGetErrorString(e), grid);
#endif
}
```
